# Optimizing an MI355X kernel written in HIP

```python
import math
import jax, jax.numpy as jnp
from jax import lax
import numpy as np

D_MODEL = 2048
BATCH = 2
SEQ = 4096
DEPTH = 2

D_MIX = D_MODEL
RW_WIDTH = D_MIX // 2
RW_HEAD = 64
RW_HEADS = RW_WIDTH // RW_HEAD
RW_DECAY_LORA = 64
RW_AAA_LORA = 64
RW_MV_LORA = 32
RW_GATE_LORA = 160
RW_GN_EPS = 64e-5
RW_COLS_FIRST = 3 * RW_WIDTH + RW_DECAY_LORA + RW_AAA_LORA + RW_GATE_LORA
RW_COLS_REST = RW_COLS_FIRST + RW_MV_LORA
DA_WIDTH = D_MIX - RW_WIDTH
DA_HD = 64
DA_HEADS = DA_WIDTH // (2 * DA_HD)
DA_COLS = 3 * DA_WIDTH
ROPE_DIMS = DA_HD // 4
ROPE_THETA = 500000.0
Q_BLOCK = 128
N_IN_FIRST = RW_COLS_FIRST + DA_COLS
N_IN_REST = RW_COLS_REST + DA_COLS
N_GROUPS = 4
EXP_PER_GROUP = 8
N_EXPERTS = N_GROUPS * EXP_PER_GROUP
TOP_K_IN_GROUP = 2
D_EXPERT = D_MODEL // 4
PLE_DIM = 256
EPS = 1e-6
NEG_INF = -1e30

kernel_name = "hymba_rwkv7_diffattn_hiermoe"


def rms_norm(x, g, eps=EPS):
    xf = x.astype(jnp.float32)
    y = xf * lax.rsqrt(jnp.mean(xf * xf, axis=-1, keepdims=True) + eps)
    return (y * g.astype(jnp.float32)).astype(x.dtype)


def rope_partial(x, cos, sin):
    half = ROPE_DIMS // 2
    c = cos[None, :, None, None, :]
    s = sin[None, :, None, None, :]
    x1 = x[..., :half]
    x2 = x[..., half:ROPE_DIMS]
    return jnp.concatenate([x1 * c - x2 * s, x2 * c + x1 * s, x[..., ROPE_DIMS:]], axis=-1)


def wkv7_scan(r, w, k, v, a, b):
    B, T, H, N = r.shape

    def step(S, inp):
        r_t, w_t, k_t, v_t, a_t, b_t = inp
        sa = jnp.einsum('bhvk,bhk->bhv', S, a_t)
        S = S * w_t[:, :, None, :] + sa[..., None] * b_t[:, :, None, :] + v_t[..., None] * k_t[:, :, None, :]
        return S, jnp.einsum('bhvk,bhk->bhv', S, r_t)

    xs = tuple(jnp.moveaxis(t, 1, 0) for t in (r, w, k, v, a, b))
    S0 = jnp.zeros((B, H, N, N), jnp.float32)
    _, ys = lax.scan(step, S0, xs)
    return jnp.moveaxis(ys, 0, 1)


def rwkv7_time_mix(proj, mu, w0, w2, a0, a2, g2, k_k, k_a, r_k, gn_g, gn_b, v_first, v0, v2):
    B, T, _ = proj.shape
    C, H, N = RW_WIDTH, RW_HEADS, RW_HEAD
    f32 = jnp.float32
    pf = proj.astype(f32)
    prev = jnp.pad(pf, ((0, 0), (1, 0), (0, 0)))[:, :-1, :]
    xs = pf + (prev - pf) * mu.astype(f32)
    o = 3 * C
    r, k, v = xs[..., :C], xs[..., C:2 * C], xs[..., 2 * C:o]
    wl = xs[..., o:o + RW_DECAY_LORA]; o += RW_DECAY_LORA
    al = xs[..., o:o + RW_AAA_LORA]; o += RW_AAA_LORA
    gl = xs[..., o:o + RW_GATE_LORA]; o += RW_GATE_LORA
    w = -jax.nn.softplus(-(w0.astype(f32) + jnp.tanh(wl) @ w2.astype(f32))) - 0.5
    decay = jnp.exp(-jnp.exp(w))
    if v_first is None:
        v_first = v
    else:
        vl = xs[..., o:o + RW_MV_LORA]
        v = v + (v_first - v) * jax.nn.sigmoid(v0.astype(f32) + vl @ v2.astype(f32))
    a = jax.nn.sigmoid(a0.astype(f32) + al @ a2.astype(f32))
    g = jax.nn.sigmoid(gl) @ g2.astype(f32)
    kk = (k * k_k.astype(f32)).reshape(B, T, H, N)
    kk = kk / jnp.maximum(jnp.sqrt(jnp.sum(kk * kk, axis=-1, keepdims=True)), 1e-12)
    k = k * (1.0 + (a - 1.0) * k_a.astype(f32))
    rh, kh, vh = r.reshape(B, T, H, N), k.reshape(B, T, H, N), v.reshape(B, T, H, N)
    ah = a.reshape(B, T, H, N)
    y = wkv7_scan(rh, decay.reshape(B, T, H, N), kh, vh, -kk, kk * ah)
    mean = jnp.mean(y, axis=-1, keepdims=True)
    var = jnp.mean(jnp.square(y - mean), axis=-1, keepdims=True)
    yn = ((y - mean) * lax.rsqrt(var + RW_GN_EPS)).reshape(B, T, C) * gn_g.astype(f32) + gn_b.astype(f32)
    bonus = (jnp.sum(rh * kh * r_k.astype(f32), axis=-1, keepdims=True) * vh).reshape(B, T, C)
    out = (yn + bonus) * g
    return out.astype(proj.dtype), v_first


def diff_attention(q, k, v, q_g, k_g, lq1, lk1, lq2, lk2, subln_g, lambda_init, cos, sin):
    B, T, H, _, hd = q.shape
    q = rope_partial(rms_norm(q, q_g), cos, sin)
    k = rope_partial(rms_norm(k, k_g), cos, sin)
    f32 = jnp.float32
    lam = (jnp.exp(jnp.sum(lq1.astype(f32) * lk1.astype(f32))) -
           jnp.exp(jnp.sum(lq2.astype(f32) * lk2.astype(f32))) + lambda_init)
    scale = hd ** -0.5
    nb = T // Q_BLOCK
    q_blocks = jnp.moveaxis(q.reshape(B, nb, Q_BLOCK, H, 2, hd), 1, 0)
    starts = jnp.arange(nb, dtype=jnp.int32) * Q_BLOCK
    k_pos = jnp.arange(T, dtype=jnp.int32)

    def block_fn(args):
        qb, start = args
        s = jnp.einsum('bqhcd,bkhcd->bhcqk', qb, k, preferred_element_type=f32) * scale
        q_pos = start + jnp.arange(Q_BLOCK, dtype=jnp.int32)
        mask = k_pos[None, :] <= q_pos[:, None]
        pr = jax.nn.softmax(jnp.where(mask, s, NEG_INF), axis=-1)
        attn = pr[:, :, 0] - lam * pr[:, :, 1]
        return jnp.einsum('bhqk,bkhe->bqhe', attn.astype(v.dtype), v)

    out = lax.map(block_fn, (q_blocks, starts))
    out = jnp.moveaxis(out, 0, 1).reshape(B, T, H, 2 * hd)
    out = rms_norm(out, subln_g) * (1.0 - lambda_init)
    return out.reshape(B, T, H * 2 * hd)


def hier_moe(x, wr_group, br_group, wr_expert, br_expert, w_gate, w_up, w_down):
    B, T, D = x.shape
    n = B * T
    xt = x.reshape(n, D)
    f32 = jnp.float32
    lg = (xt @ wr_group + br_group).astype(f32)
    pg = jax.nn.softmax(lg, axis=-1)
    gp, grp = lax.top_k(pg, 1)
    le = (xt @ wr_expert + br_expert).astype(f32).reshape(n, N_GROUPS, EXP_PER_GROUP)
    le_sel = jnp.take_along_axis(le, grp[:, :, None], axis=1)[:, 0]
    pe = jax.nn.softmax(le_sel, axis=-1)
    top_p, top_i = lax.top_k(pe, TOP_K_IN_GROUP)
    top_p = top_p / jnp.sum(top_p, axis=-1, keepdims=True)
    expert_idx = grp * EXP_PER_GROUP + top_i
    weight = gp * top_p
    combine = jnp.sum(jax.nn.one_hot(expert_idx, N_EXPERTS, dtype=f32) * weight[..., None], axis=1)
    combine = combine.astype(x.dtype)
    y = jnp.zeros((n, D), x.dtype)
    for gi in range(N_GROUPS):
        sl = slice(gi * EXP_PER_GROUP, (gi + 1) * EXP_PER_GROUP)
        hg = jax.nn.silu(jnp.einsum('nd,edf->enf', xt, w_gate[sl])) * jnp.einsum('nd,edf->enf', xt, w_up[sl])
        hg = hg * combine[:, sl].T[:, :, None]
        y = y + jnp.einsum('enf,efd->nd', hg, w_down[sl])
    return y.reshape(B, T, D)


def setup_inputs(seed: int = 0) -> dict:
    key = jax.random.key(seed)
    ks = iter(jax.random.split(key, 48))
    f32 = jnp.float32

    def nrm(shape, scale):
        return jax.random.normal(next(ks), shape, f32) * scale

    def gain(shape):
        return 1.0 + nrm(shape, 0.02)

    L, Lr = DEPTH, DEPTH - 1
    C = RW_WIDTH
    return {
        "x": nrm((BATCH, SEQ, D_MODEL), 1.0),
        "p": nrm((DEPTH, BATCH, SEQ, PLE_DIM), 1.0),
        "ln1_g": gain((L, D_MODEL)),
        "ln2_g": gain((L, D_MODEL)),
        "w_in_first": nrm((D_MODEL, N_IN_FIRST), D_MODEL ** -0.5),
        "w_in_rest": nrm((Lr, D_MODEL, N_IN_REST), D_MODEL ** -0.5),
        "mu_first": jax.random.uniform(next(ks), (RW_COLS_FIRST,), f32),
        "mu_rest": jax.random.uniform(next(ks), (Lr, RW_COLS_REST), f32),
        "rw_w0": jax.random.uniform(next(ks), (L, C), f32, -6.0, -1.0),
        "rw_w2": nrm((L, RW_DECAY_LORA, C), 0.5 * RW_DECAY_LORA ** -0.5),
        "rw_a0": nrm((L, C), 0.1),
        "rw_a2": nrm((L, RW_AAA_LORA, C), RW_AAA_LORA ** -0.5),
        "rw_g2": nrm((L, RW_GATE_LORA, C), RW_GATE_LORA ** -0.5),
        "rw_v0": nrm((Lr, C), 0.1),
        "rw_v2": nrm((Lr, RW_MV_LORA, C), RW_MV_LORA ** -0.5),
        "rw_k_k": 0.85 + nrm((L, C), 0.02),
        "rw_k_a": gain((L, C)),
        "rw_r_k": nrm((L, RW_HEADS, RW_HEAD), 0.1),
        "rw_gn_g": gain((L, C)),
        "rw_gn_b": nrm((L, C), 0.01),
        "da_q_g": gain((L, DA_HD)),
        "da_k_g": gain((L, DA_HD)),
        "da_lq1": nrm((L, DA_HD), 0.1),
        "da_lk1": nrm((L, DA_HD), 0.1),
        "da_lq2": nrm((L, DA_HD), 0.1),
        "da_lk2": nrm((L, DA_HD), 0.1),
        "da_subln_g": gain((L, 2 * DA_HD)),
        "w_out": nrm((L, D_MIX, D_MODEL), D_MIX ** -0.5),
        "moe_wr_group": nrm((L, D_MODEL, N_GROUPS), D_MODEL ** -0.5),
        "moe_br_group": nrm((L, N_GROUPS), 0.01),
        "moe_wr_expert": nrm((L, D_MODEL, N_EXPERTS), D_MODEL ** -0.5),
        "moe_br_expert": nrm((L, N_EXPERTS), 0.01),
        "moe_w_gate": nrm((L, N_EXPERTS, D_MODEL, D_EXPERT), D_MODEL ** -0.5),
        "moe_w_up": nrm((L, N_EXPERTS, D_MODEL, D_EXPERT), D_MODEL ** -0.5),
        "moe_w_down": nrm((L, N_EXPERTS, D_EXPERT, D_MODEL), D_EXPERT ** -0.5),
        "ple_w_gate": nrm((L, D_MODEL, D_MODEL), D_MODEL ** -0.5),
        "ple_b_gate": nrm((L, D_MODEL), 0.01),
        "ple_w_proj": nrm((L, PLE_DIM, D_MODEL), PLE_DIM ** -0.5),
    }


def reference(x, p, ln1_g, ln2_g, w_in_first, w_in_rest, mu_first, mu_rest, rw_w0, rw_w2, rw_a0, rw_a2,
              rw_g2, rw_v0, rw_v2, rw_k_k, rw_k_a, rw_r_k, rw_gn_g, rw_gn_b, da_q_g, da_k_g, da_lq1, da_lk1,
              da_lq2, da_lk2, da_subln_g, w_out, moe_wr_group, moe_br_group, moe_wr_expert, moe_br_expert,
              moe_w_gate, moe_w_up, moe_w_down, ple_w_gate, ple_b_gate, ple_w_proj):
    B, T, _ = x.shape
    pos = jnp.arange(T, dtype=jnp.float32)
    inv_freq = ROPE_THETA ** (-(jnp.arange(0, ROPE_DIMS, 2, dtype=jnp.float32) / ROPE_DIMS))
    ang = pos[:, None] * inv_freq[None, :]
    cos = jnp.cos(ang).astype(x.dtype)
    sin = jnp.sin(ang).astype(x.dtype)

    h = x
    v_first = None
    for i in range(DEPTH):
        xn = rms_norm(h, ln1_g[i])
        if i == 0:
            proj = xn @ w_in_first
            n_rw, mu, v0, v2 = RW_COLS_FIRST, mu_first, None, None
        else:
            proj = xn @ w_in_rest[i - 1]
            n_rw, mu, v0, v2 = RW_COLS_REST, mu_rest[i - 1], rw_v0[i - 1], rw_v2[i - 1]
        y_rw, v_first = rwkv7_time_mix(proj[..., :n_rw], mu, rw_w0[i], rw_w2[i], rw_a0[i], rw_a2[i],
                                       rw_g2[i], rw_k_k[i], rw_k_a[i], rw_r_k[i], rw_gn_g[i], rw_gn_b[i],
                                       v_first, v0, v2)
        da = proj[..., n_rw:]
        q = da[..., :DA_WIDTH].reshape(B, T, DA_HEADS, 2, DA_HD)
        k = da[..., DA_WIDTH:2 * DA_WIDTH].reshape(B, T, DA_HEADS, 2, DA_HD)
        v = da[..., 2 * DA_WIDTH:].reshape(B, T, DA_HEADS, 2 * DA_HD)
        lambda_init = 0.8 - 0.6 * math.exp(-0.3 * i)
        y_da = diff_attention(q, k, v, da_q_g[i], da_k_g[i], da_lq1[i], da_lk1[i], da_lq2[i], da_lk2[i],
                              da_subln_g[i], lambda_init, cos, sin)
        h = h + jnp.concatenate([y_rw, y_da], axis=-1) @ w_out[i]
        h = h + hier_moe(rms_norm(h, ln2_g[i]), moe_wr_group[i], moe_br_group[i], moe_wr_expert[i],
                         moe_br_expert[i], moe_w_gate[i], moe_w_up[i], moe_w_down[i])
        h = h + jax.nn.sigmoid(h @ ple_w_gate[i] + ple_b_gate[i]) * (p[i] @ ple_w_proj[i])
    return h
```

```cpp
#include <hip/hip_runtime.h>
#include <hip/hip_bf16.h>
#include <cstdio>
#include <cstdint>
namespace pg8 {
#define PG8_LAS __attribute__((address_space(3)))
typedef unsigned short bf16_t;
typedef short bf16x8 __attribute__((ext_vector_type(8)));
typedef float f32x4 __attribute__((ext_vector_type(4)));
typedef unsigned u32x4 __attribute__((ext_vector_type(4)));
constexpr int BM = 256, BK = 64, HALF = 128, HTB = HALF * BK * 2  , STAGE_BYTES = 8 * HTB, NXCD = 8, WGM = 8;

__host__ __device__ __forceinline__ int lds_byte(int r, int c) { const int st = (r >> 4) * 2 + (c >> 5), rr = r & 15, cc = c & 31, ob = rr * 64 + cc * 2; return st * 1024 + (ob ^ (((ob >> 9) & 1) << 5)); }
__host__ __device__ __forceinline__ void stage_rc(int b, int& R, int& C) { const int st = b / 1024, sb = b % 1024, swz = sb ^ (((sb >> 9) & 1) << 5); R = (st >> 1) * 16 + swz / 64; C = (st & 1) * 32 + (swz % 64) / 2; }
__host__ __device__ __forceinline__ int perm32(int rho) { const int n = rho >> 4, i = rho & 15; return 8 * (i >> 2) + 4 * n + (i & 3); }

struct Unit { int pm, pn; };
struct Gemm { const bf16_t* A; const bf16_t* Bt; int M, N, K; };

struct StaticOrder {
    int nM, nN, nwg, G, c;
    __host__ __device__ void init(int M, int N, int G_, int c_) { nM = M / BM; nN = N / BM; nwg = nM * nN; G = G_; c = c_; }
    __host__ __device__ bool next(int i, Unit& u) const {
        const long L = (long)i * G + c; if (L >= nwg) return false;
        int wgid = (int)L; { const int q = nwg / NXCD, r = nwg % NXCD, xcd = wgid % NXCD, off = wgid / NXCD; wgid = (xcd < r ? xcd * (q + 1) : r * (q + 1) + (xcd - r) * q) + off; }
        const int nig = WGM * nN, gid = wgid / nig, fm = gid * WGM, gsz = (nM - fm) < WGM ? (nM - fm) : WGM;
        u.pm = fm + ((wgid % nig) % gsz); u.pn = (wgid % nig) / gsz; return true;
    }
    __device__ __forceinline__ void a_ready(const Unit&) const {}
    __device__ __forceinline__ void done(const Unit&) const {}
    __device__ __forceinline__ const char* aptr(const Gemm& g, const Unit& u, size_t tstep) const { return (const char*)g.A + (size_t)u.pm * tstep; }
    __device__ __forceinline__ const char* bptr(const Gemm& g, const Unit& u, size_t tstep) const { return (const char*)g.Bt + (size_t)u.pn * tstep; }
};
__device__ __forceinline__ unsigned cvt_pk_bf16(float lo, float hi) { unsigned r; asm volatile("v_cvt_pk_bf16_f32 %0, %1, %2" : "=v"(r) : "v"(lo), "v"(hi)); return r; }
typedef float f32x2 __attribute__((ext_vector_type(2)));


__device__ __forceinline__ u32x4 pack8(const f32x4& v0, const f32x4& v1) { u32x4 w; w.x = cvt_pk_bf16(v0[0], v0[1]); w.y = cvt_pk_bf16(v0[2], v0[3]); w.z = cvt_pk_bf16(v1[0], v1[1]); w.w = cvt_pk_bf16(v1[2], v1[3]); return w; }
__device__ __forceinline__ float bf_lo(unsigned u) { return __builtin_bit_cast(float, u << 16); }
__device__ __forceinline__ float bf_hi(unsigned u) { return __builtin_bit_cast(float, u & 0xffff0000u); }

struct EpiBf16s {
    static constexpr bool PERM = true, AFTER_DRAIN = false;
    bf16_t* O; int ldc;
    __device__ __forceinline__ void operator()(const f32x4 (&acc)[2][2][4][2], const Unit& u, int wr, int wc, int fr, int fq) const {
        const int row0 = u.pm * BM + wr * 64 + fr, col0 = u.pn * BM + wc * 32 + 8 * fq;
#pragma unroll
        for (int ai = 0; ai < 2; ++ai)
#pragma unroll
            for (int m = 0; m < 4; ++m) { bf16_t* rowp = O + (size_t)(row0 + ai * HALF + m * 16) * ldc + col0;
#pragma unroll
                for (int bj = 0; bj < 2; ++bj) *(u32x4*)(rowp + bj * HALF) = pack8(acc[ai][bj][m][0], acc[ai][bj][m][1]); }
    }
};
struct EpiProj {
    static constexpr bool PERM = true, AFTER_DRAIN = false;
    bf16_t* O; int ldc; const float* part;
    __device__ __forceinline__ void operator()(const f32x4 (&acc)[2][2][4][2], const Unit& u, int wr, int wc, int fr, int fq) const {
        const int row0 = u.pm * BM + wr * 64 + fr, col0 = u.pn * BM + wc * 32 + 8 * fq;
#pragma unroll
        for (int ai = 0; ai < 2; ++ai)
#pragma unroll
            for (int m = 0; m < 4; ++m) { const int row = row0 + ai * HALF + m * 16;
                const f32x4* pp = (const f32x4*)(part + (size_t)row * 32); f32x4 s = pp[0];
#pragma unroll
                for (int j = 1; j < 8; ++j) s = s + pp[j];
                const float rs = rsqrtf(((s[0] + s[1]) + (s[2] + s[3])) * (1.0f / 2048.0f) + 1e-6f);
                bf16_t* rowp = O + (size_t)row * ldc + col0;
#pragma unroll
                for (int bj = 0; bj < 2; ++bj) *(u32x4*)(rowp + bj * HALF) = pack8(acc[ai][bj][m][0] * rs, acc[ai][bj][m][1] * rs); }
    }
};
struct EpiResid {
    static constexpr bool PERM = true, AFTER_DRAIN = false;
    const float* hin; float* hout; bf16_t* hb;
    __device__ __forceinline__ void operator()(const f32x4 (&acc)[2][2][4][2], const Unit& u, int wr, int wc, int fr, int fq) const {
        const int row0 = u.pm * BM + wr * 64 + fr, col0 = u.pn * BM + wc * 32 + 8 * fq;
#pragma unroll
        for (int ai = 0; ai < 2; ++ai)
#pragma unroll
            for (int m = 0; m < 4; ++m) { const size_t ro = (size_t)(row0 + ai * HALF + m * 16) * 2048 + col0;
#pragma unroll
                for (int bj = 0; bj < 2; ++bj) { const f32x4 a0 = *(const f32x4*)(hin + ro + bj * HALF), a1 = *(const f32x4*)(hin + ro + bj * HALF + 4);
                    const f32x4 r0 = a0 + acc[ai][bj][m][0], r1 = a1 + acc[ai][bj][m][1];
                    *(f32x4*)(hout + ro + bj * HALF) = r0; *(f32x4*)(hout + ro + bj * HALF + 4) = r1; *(u32x4*)(hb + ro + bj * HALF) = pack8(r0, r1); } }
    }
};
struct EpiPLE {
    static constexpr bool PERM = true, AFTER_DRAIN = false;
    float* h; bf16_t* hb; const bf16_t* pp; const float* bg; float* part;
    __device__ __forceinline__ void operator()(const f32x4 (&acc)[2][2][4][2], const Unit& u, int wr, int wc, int fr, int fq) const {
        const int row0 = u.pm * BM + wr * 64 + fr, col0 = u.pn * BM + wc * 32 + 8 * fq;
        f32x4 bv[2][2];
#pragma unroll
        for (int bj = 0; bj < 2; ++bj) { bv[bj][0] = *(const f32x4*)(bg + col0 + bj * HALF); bv[bj][1] = *(const f32x4*)(bg + col0 + bj * HALF + 4); }
#pragma unroll
        for (int ai = 0; ai < 2; ++ai)
#pragma unroll
            for (int m = 0; m < 4; ++m) { const int row = row0 + ai * HALF + m * 16; const size_t ro = (size_t)row * 2048 + col0; float ss = 0.f;
#pragma unroll
                for (int bj = 0; bj < 2; ++bj) { const f32x4 a0 = *(const f32x4*)(h + ro + bj * HALF), a1 = *(const f32x4*)(h + ro + bj * HALF + 4);
                    const u32x4 pw = *(const u32x4*)(pp + ro + bj * HALF);
                    const f32x4 p0 = (f32x4){bf_lo(pw.x), bf_hi(pw.x), bf_lo(pw.y), bf_hi(pw.y)}, p1 = (f32x4){bf_lo(pw.z), bf_hi(pw.z), bf_lo(pw.w), bf_hi(pw.w)};
                    const f32x4 z0 = acc[ai][bj][m][0] + bv[bj][0], z1 = acc[ai][bj][m][1] + bv[bj][1]; f32x4 r0, r1;
#pragma unroll
                    for (int j = 0; j < 4; ++j) { r0[j] = a0[j] + p0[j] / (1.0f + __expf(-z0[j])); r1[j] = a1[j] + p1[j] / (1.0f + __expf(-z1[j])); ss += r0[j] * r0[j] + r1[j] * r1[j]; }
                    *(f32x4*)(h + ro + bj * HALF) = r0; *(f32x4*)(h + ro + bj * HALF + 4) = r1; *(u32x4*)(hb + ro + bj * HALF) = pack8(r0, r1); }
                ss += __shfl_xor(ss, 16); ss += __shfl_xor(ss, 32);
                if (part != nullptr && fq == 0) part[(size_t)row * 32 + u.pn * 4 + wc] = ss; }
    }
};
struct EpiGLU {
    static constexpr bool PERM = true, AFTER_DRAIN = false;
    bf16_t* HG; const float* srs; const float* swt;
    __device__ __forceinline__ void operator()(const f32x4 (&acc)[2][2][4][2], const Unit& u, int wr, int wc, int fr, int fq) const {
        const int row0 = u.pm * BM + wr * 64 + fr, col0 = u.pn * HALF + wc * 32 + 8 * fq;
#pragma unroll
        for (int ai = 0; ai < 2; ++ai)
#pragma unroll
            for (int m = 0; m < 4; ++m) { const int row = row0 + ai * HALF + m * 16; const float rs = srs[row], wt = swt[row]; f32x4 o0, o1;
#pragma unroll
                for (int j = 0; j < 4; ++j) { const float g0 = acc[ai][0][m][0][j] * rs, g1 = acc[ai][0][m][1][j] * rs, u0 = acc[ai][1][m][0][j] * rs, u1 = acc[ai][1][m][1][j] * rs;
                    o0[j] = g0 / (1.0f + __expf(-g0)) * u0 * wt; o1[j] = g1 / (1.0f + __expf(-g1)) * u1 * wt; }
                *(u32x4*)(HG + (size_t)row * 512 + col0) = pack8(o0, o1); }
    }
};
struct MoeOrder {
    int lg, nunits, G, c; const PG8_LAS int* tile_e; int NE;
    __device__ __forceinline__ void init(int ntiles, int lg_, int G_, int c_) { lg = lg_; nunits = ntiles << lg_; G = G_; c = c_; }
    __device__ __forceinline__ bool next(int i, Unit& u) const { const int L = i * G + c; if (L >= nunits) return false; u.pm = L >> lg; u.pn = L & ((1 << lg) - 1); return true; }
    __device__ __forceinline__ void a_ready(const Unit&) const {}
    __device__ __forceinline__ void done(const Unit&) const {}
    __device__ __forceinline__ const char* aptr(const Gemm& g, const Unit& u, size_t tstep) const { return (const char*)g.A + (size_t)u.pm * tstep; }
    __device__ __forceinline__ const char* bptr(const Gemm& g, const Unit& u, size_t tstep) const { const int e = __builtin_amdgcn_readfirstlane(tile_e[u.pm]); return (const char*)g.Bt + ((size_t)e * NE + (size_t)u.pn * BM) * (size_t)g.K * 2; }
};

template <class Epi, class Sched, bool ALIGN_EPI = false, bool SP2 = false>
__device__ __forceinline__ void gemm_phase(PG8_LAS unsigned char* lds, const Gemm g, const Sched& S, const Epi& E) {
    int tid_ = threadIdx.x; asm volatile("" : "+v"(tid_)); const int tid = tid_, wid = __builtin_amdgcn_readfirstlane(tid >> 6), lane = tid & 63, wr = wid >> 2, wc = wid & 3, fr = lane & 15, fq = lane >> 4;
    const int K = g.K, nt = K / BK;
    unsigned voffA[2], voffB[2];
#pragma unroll
    for (int i = 0; i < 2; ++i) { int R, C; stage_rc(tid * 16 + i * 8192, R, C); const int Rb = Epi::PERM ? ((R & ~31) + perm32(R & 31)) : R;
        voffA[i] = (unsigned)(R * K + C) * 2u; voffB[i] = (unsigned)(Rb * K + C) * 2u; }
    const size_t kstep = (size_t)(BK * 2);
    const size_t hstep = (size_t)HALF * K * 2;
    const size_t tstep = 2 * hstep;
    const unsigned ldsw = (unsigned)wid * 1024u;
    const int aoff = lds_byte(wr * 64 + fr, fq * 8), boff = lds_byte(wc * 32 + fr, fq * 8);
#define PG8_SA(b, h) (((b) * 2 + (h)) * HTB)
#define PG8_SB(b, h) ((4 + (b) * 2 + (h)) * HTB)
#define PG8_STAGE(bufoff, gbase, voff) do { _Pragma("unroll") for (int _i = 0; _i < 2; ++_i) \
        __builtin_amdgcn_global_load_lds((const unsigned*)((const char*)(gbase) + (voff)[_i]), (PG8_LAS unsigned*)(lds + (bufoff) + ldsw + _i * 8192), 16, 0, 0); } while (0)
#define PG8_LDA(dst, b, h) do { _Pragma("unroll") for (int m = 0; m < 4; ++m) _Pragma("unroll") for (int k = 0; k < 2; ++k) dst[m][k] = *(const PG8_LAS bf16x8*)(lds + PG8_SA(b, h) + aoff + m * 2048 + k * 1024); } while (0)
#define PG8_LDB(dst, b, h) do { _Pragma("unroll") for (int n = 0; n < 2; ++n) _Pragma("unroll") for (int k = 0; k < 2; ++k) dst[n][k] = *(const PG8_LAS bf16x8*)(lds + PG8_SB(b, h) + boff + n * 2048 + k * 1024); } while (0)
#define PG8_MMA(ai, bj, At, Bt) do { __builtin_amdgcn_s_setprio(1); _Pragma("unroll") for (int m = 0; m < 4; ++m) _Pragma("unroll") for (int n = 0; n < 2; ++n) _Pragma("unroll") for (int k = 0; k < 2; ++k) \
        acc[ai][bj][m][n] = __builtin_amdgcn_mfma_f32_16x16x32_bf16(Bt[n][k], At[m][k], acc[ai][bj][m][n], 0, 0, 0); __builtin_amdgcn_s_setprio(0); } while (0)
#define PG8_WAIT_V(n) asm volatile("s_waitcnt vmcnt(" #n ")" ::: "memory")
#define PG8_WAIT_L(n) asm volatile("s_waitcnt lgkmcnt(" #n ")" ::: "memory")
#define PG8_BAR __builtin_amdgcn_s_barrier()
#define PG8_SCHED __builtin_amdgcn_sched_barrier(0)
    Unit cur, nxt; int ui = 0;
    if (!S.next(0, cur)) return;
    f32x4 acc[2][2][4][2];
#pragma unroll
    for (int a = 0; a < 2; ++a)
#pragma unroll
        for (int b = 0; b < 2; ++b)
#pragma unroll
            for (int m = 0; m < 4; ++m)
#pragma unroll
                for (int n = 0; n < 2; ++n) acc[a][b][m][n] = (f32x4){0.f, 0.f, 0.f, 0.f};
    bf16x8 At[4][2], B0[2][2], B1[2][2];
    const char* cA = S.aptr(g, cur, tstep); const char* cB = S.bptr(g, cur, tstep);
    S.a_ready(cur);
    if constexpr (SP2) {
        PG8_STAGE(PG8_SB(0, 0), cB, voffB); PG8_STAGE(PG8_SB(0, 1), cB + hstep, voffB); PG8_STAGE(PG8_SA(0, 0), cA, voffA); PG8_STAGE(PG8_SA(0, 1), cA + hstep, voffA);
        if (wr == 1) PG8_BAR;
        PG8_WAIT_V(2); PG8_BAR;
        PG8_STAGE(PG8_SB(1, 0), cB + kstep, voffB); PG8_STAGE(PG8_SA(1, 0), cA + kstep, voffA); PG8_STAGE(PG8_SB(1, 1), cB + hstep + kstep, voffB);
        PG8_WAIT_V(6); PG8_BAR;
    } else {
        PG8_STAGE(PG8_SB(0, 0), cB, voffB); PG8_STAGE(PG8_SA(0, 0), cA, voffA); PG8_STAGE(PG8_SB(0, 1), cB + hstep, voffB); PG8_STAGE(PG8_SA(0, 1), cA + hstep, voffA);
        if (wr == 1) PG8_BAR;
        PG8_WAIT_V(4); PG8_BAR;
        PG8_STAGE(PG8_SB(1, 0), cB + kstep, voffB); PG8_STAGE(PG8_SA(1, 0), cA + kstep, voffA); PG8_STAGE(PG8_SB(1, 1), cB + hstep + kstep, voffB);
        PG8_WAIT_V(6); PG8_BAR;
    }
    for (;;) {
        const bool has_next = S.next(ui + 1, nxt);
        const char* nA = has_next ? S.aptr(g, nxt, tstep) : cA; const char* nB = has_next ? S.bptr(g, nxt, tstep) : cB;
        for (int t = 0; t < nt; t += 2) {
            const bool last = (t == nt - 2);
            const char* a1 = cA + (size_t)(t + 1) * kstep;
            const char* a2 = last ? nA : cA + (size_t)(t + 2) * kstep; const char* b2 = last ? nB : cB + (size_t)(t + 2) * kstep;
            const char* a3 = a2 + kstep; const char* b3 = b2 + kstep;
            if (last && has_next) S.a_ready(nxt);
            if constexpr (SP2) {
            PG8_LDB(B0, 0, 0); PG8_LDB(B1, 0, 1); PG8_SCHED; PG8_LDA(At, 0, 0); PG8_STAGE(PG8_SA(1, 1), a1 + hstep, voffA);
            PG8_WAIT_V(8); PG8_WAIT_L(0); PG8_BAR; PG8_MMA(0, 0, At, B0); PG8_MMA(0, 1, At, B1); PG8_BAR; PG8_SCHED;
            PG8_LDA(At, 0, 1); PG8_STAGE(PG8_SB(0, 0), b2, voffB); PG8_STAGE(PG8_SB(0, 1), b2 + hstep, voffB); PG8_STAGE(PG8_SA(0, 0), a2, voffA);
            PG8_WAIT_V(8); PG8_WAIT_L(0); PG8_BAR; PG8_MMA(1, 0, At, B0); PG8_MMA(1, 1, At, B1); PG8_BAR; PG8_SCHED;
            PG8_LDB(B0, 1, 0); PG8_LDB(B1, 1, 1); PG8_SCHED; PG8_LDA(At, 1, 0); PG8_STAGE(PG8_SA(0, 1), a2 + hstep, voffA);
            PG8_WAIT_V(8); PG8_WAIT_L(0); PG8_BAR; PG8_MMA(0, 0, At, B0); PG8_MMA(0, 1, At, B1); PG8_BAR; PG8_SCHED;
            PG8_LDA(At, 1, 1); PG8_STAGE(PG8_SB(1, 0), b3, voffB); PG8_STAGE(PG8_SB(1, 1), b3 + hstep, voffB); PG8_STAGE(PG8_SA(1, 0), a3, voffA);
            PG8_WAIT_V(8); PG8_WAIT_L(0); PG8_BAR; PG8_MMA(1, 0, At, B0); PG8_MMA(1, 1, At, B1); PG8_BAR; PG8_SCHED;
            } else {
            PG8_LDB(B0, 0, 0); PG8_SCHED; PG8_LDA(At, 0, 0); PG8_STAGE(PG8_SA(1, 1), a1 + hstep, voffA);
            PG8_WAIT_L(8); PG8_BAR; PG8_WAIT_L(0); PG8_MMA(0, 0, At, B0); PG8_BAR; PG8_SCHED;
            PG8_LDB(B1, 0, 1); PG8_STAGE(PG8_SB(0, 0), b2, voffB);
            PG8_BAR; PG8_WAIT_L(0); PG8_MMA(0, 1, At, B1); PG8_BAR;
            PG8_LDA(At, 0, 1); PG8_STAGE(PG8_SA(0, 0), a2, voffA);
            PG8_BAR; PG8_WAIT_L(0); PG8_MMA(1, 0, At, B0); PG8_BAR; PG8_SCHED;
            PG8_STAGE(PG8_SB(0, 1), b2 + hstep, voffB);
            PG8_WAIT_V(6); PG8_BAR; PG8_MMA(1, 1, At, B1); PG8_BAR;
            PG8_LDB(B0, 1, 0); PG8_SCHED; PG8_LDA(At, 1, 0); PG8_STAGE(PG8_SA(0, 1), a2 + hstep, voffA);
            PG8_WAIT_L(8); PG8_BAR; PG8_WAIT_L(0); PG8_MMA(0, 0, At, B0); PG8_BAR; PG8_SCHED;
            PG8_LDB(B1, 1, 1); PG8_STAGE(PG8_SB(1, 0), b3, voffB);
            PG8_BAR; PG8_WAIT_L(0); PG8_MMA(0, 1, At, B1); PG8_BAR;
            PG8_LDA(At, 1, 1); PG8_STAGE(PG8_SA(1, 0), a3, voffA);
            PG8_BAR; PG8_WAIT_L(0); PG8_MMA(1, 0, At, B0); PG8_BAR; PG8_SCHED;
            PG8_STAGE(PG8_SB(1, 1), b3 + hstep, voffB);
            PG8_WAIT_V(6); PG8_BAR; PG8_MMA(1, 1, At, B1); PG8_BAR;
            }
        }
        if constexpr (ALIGN_EPI) { if (wr == 0) PG8_BAR; }
        if constexpr (!Epi::AFTER_DRAIN) { E(acc, cur, wr, wc, fr, fq); S.done(cur); }
        if (!has_next) break;
#pragma unroll
        for (int a = 0; a < 2; ++a)
#pragma unroll
            for (int b = 0; b < 2; ++b)
#pragma unroll
                for (int m = 0; m < 4; ++m)
#pragma unroll
                    for (int n = 0; n < 2; ++n) acc[a][b][m][n] = (f32x4){0.f, 0.f, 0.f, 0.f};
        cur = nxt; cA = nA; cB = nB; ++ui;
        if constexpr (ALIGN_EPI) { if (wr == 1) PG8_BAR; }
    }
    PG8_WAIT_V(0);
    if constexpr (!ALIGN_EPI) { if (wr == 0) PG8_BAR; }
    PG8_BAR;
    if constexpr (Epi::AFTER_DRAIN) { E.fused(acc, cur, wr, wc, fr, fq, lds, wid, lane); S.done(cur); }
#undef PG8_SA
#undef PG8_SB
#undef PG8_STAGE
#undef PG8_LDA
#undef PG8_LDB
#undef PG8_MMA
#undef PG8_WAIT_V
#undef PG8_WAIT_L
#undef PG8_BAR
#undef PG8_SCHED
}
}


#define PG8_SP2 true
#define PG8_ALIGN true
#include <hip/hip_bf16.h>
#include <cmath>
namespace attn_body {
using bf16=__hip_bfloat16;
using bf16x8=__attribute__((ext_vector_type(8)))short;
using s16x4=__attribute__((ext_vector_type(4)))short;
using f32x16=__attribute__((ext_vector_type(16)))float;
using u32x4=__attribute__((ext_vector_type(4)))unsigned;
constexpr int BATCH=2,NHEAD=16,SEQ=4096,D=64,DM=6656,DMO=1024;
constexpr int NW=8,QBLK=32,QB=QBLK*NW,KVBLK=64,NQB=SEQ/QB;
constexpr int ATTN_PITCH=DM, ATTN_UNIT_ROWS=QB;
__device__ __forceinline__ int crow(int r,int hi){return (r&3)+8*(r>>2)+4*hi;}
#define SBAR() __builtin_amdgcn_sched_barrier(0)
__device__ __forceinline__ void cmask(f32x16&p0,f32x16&p1,int jb,int qrel,int hi){
  const float NEG=-INFINITY; int kb=64*jb+4*hi;
  #pragma unroll
  for(int r=0;r<16;++r){int kv=kb+(r&3)+8*(r>>2); if(kv>qrel)p0[r]=NEG; if(kv+32>qrel)p1[r]=NEG;}
}

constexpr int NSLOT=3, SLOTB=8192;
constexpr int LDS_K=0, LDS_V=NSLOT*SLOTB, LDS_WS=2*NSLOT*SLOTB, LDS_OST=LDS_WS+NW*64*4, LDS_BYTES=LDS_OST+NW*4096;
constexpr float C2=0.125f*1.4426950408889634f;
__device__ __forceinline__ void glds16(const void*gsrc,unsigned lds_dst){unsigned keep;
  asm volatile("s_mov_b32 %0, m0\n\ts_mov_b32 m0, %2\n\ts_nop 0\n\tglobal_load_lds_dwordx4 %1, off\n\ts_mov_b32 m0, %0":"=&s"(keep):"v"(gsrc),"s"(lds_dst):"memory");}
__device__ __forceinline__ float max3f(float a,float b,float c){float r;asm("v_max3_f32 %0, %1, %2, %3":"=v"(r):"v"(a),"v"(b),"v"(c));return r;}
__device__ __forceinline__ float max2f(float a,float b){float r;asm("v_max_f32_e32 %0, %1, %2":"=v"(r):"v"(a),"v"(b));return r;}
__device__ __forceinline__ float fadd_s(float a,float b){float r;asm("v_add_f32_e32 %0, %1, %2":"=v"(r):"v"(a),"v"(b));return r;}
__device__ __forceinline__ float fsub_s(float a,float b){float r;asm("v_sub_f32_e32 %0, %1, %2":"=v"(r):"v"(a),"v"(b));return r;}
typedef float f32x2_t __attribute__((ext_vector_type(2))); typedef __bf16 bf16x2_t __attribute__((ext_vector_type(2)));
__device__ __forceinline__ unsigned cvtpk_s(float lo,float hi){f32x2_t v={lo,hi};bf16x2_t b=__builtin_convertvector(v,bf16x2_t);return __builtin_bit_cast(unsigned,b);}
#define WAIT_BAR(N) asm volatile("s_waitcnt vmcnt(" #N ") lgkmcnt(0)\n\ts_barrier":::"memory")

__device__ __forceinline__ void qkt(f32x16&p0,f32x16&p1,const char*Kslot,const bf16x8*qr,const f32x16&negm,int r32,int hi){
  const char*kb=Kslot+hi*1024+r32*16;
  #pragma unroll
  for(int d0=0;d0<4;++d0){
    const bf16x8 b0=*reinterpret_cast<const bf16x8*>(kb+d0*2048);
    const bf16x8 b1=*reinterpret_cast<const bf16x8*>(kb+d0*2048+512);
    if(d0==0){p0=__builtin_amdgcn_mfma_f32_32x32x16_bf16(b0,qr[0],negm,0,0,0);p1=__builtin_amdgcn_mfma_f32_32x32x16_bf16(b1,qr[0],negm,0,0,0);}
    else{p0=__builtin_amdgcn_mfma_f32_32x32x16_bf16(b0,qr[d0],p0,0,0,0);p1=__builtin_amdgcn_mfma_f32_32x32x16_bf16(b1,qr[d0],p1,0,0,0);}}
}
typedef __attribute__((address_space(3))) const char* lds_cptr;
typedef short v4i16_t __attribute__((ext_vector_type(4)));
__device__ __forceinline__ void kload8(bf16x8*kf,lds_cptr kp){
  kf[0]=*(const __attribute__((address_space(3))) bf16x8*)(kp);      kf[1]=*(const __attribute__((address_space(3))) bf16x8*)(kp+512);
  kf[2]=*(const __attribute__((address_space(3))) bf16x8*)(kp+2048); kf[3]=*(const __attribute__((address_space(3))) bf16x8*)(kp+2560);
  kf[4]=*(const __attribute__((address_space(3))) bf16x8*)(kp+4096); kf[5]=*(const __attribute__((address_space(3))) bf16x8*)(kp+4608);
  kf[6]=*(const __attribute__((address_space(3))) bf16x8*)(kp+6144); kf[7]=*(const __attribute__((address_space(3))) bf16x8*)(kp+6656);
}
__device__ __forceinline__ void kload2(bf16x8*kf,lds_cptr kp,int j){ kf[2*j]=*(const __attribute__((address_space(3))) bf16x8*)(kp+j*2048); kf[2*j+1]=*(const __attribute__((address_space(3))) bf16x8*)(kp+j*2048+512); }
__device__ __forceinline__ s16x4 vtr(lds_cptr p){ return __builtin_bit_cast(s16x4,__builtin_amdgcn_ds_read_tr16_b64_v4i16((__attribute__((address_space(3))) v4i16_t*)p)); }
__device__ __forceinline__ float rowmax(const f32x16&p0,const f32x16&p1){
  float a=max3f(p0[0],p0[1],p1[0]),b=max3f(p0[2],p0[3],p1[1]);a=max3f(a,p1[2],p1[3]);
  #pragma unroll
  for(int r=4;r<16;r+=4){a=max3f(a,p0[r],p0[r+1]);b=max3f(b,p0[r+2],p0[r+3]);a=max3f(a,p1[r],p1[r+1]);b=max3f(b,p1[r+2],p1[r+3]);}
  const float m=max2f(a,b);
  auto rr=__builtin_amdgcn_permlane32_swap(__float_as_uint(m),__float_as_uint(m),false,false);
  return max2f(__uint_as_float(rr[0]),__uint_as_float(rr[1]));
}
__device__ __forceinline__ void pv(f32x16*o,int vb,bf16x8 pa0,bf16x8 pa1,bf16x8 pa2,bf16x8 pa3){
  #pragma unroll
  for(int d0=0;d0<2;++d0){s16x4 lo[4],hi[4];
    #pragma unroll
    for(int ks=0;ks<4;++ks){
      asm volatile("ds_read_b64_tr_b16 %0,%1 offset:%c2":"=&v"(lo[ks]):"v"(vb),"i"(d0*4096+ks*1024):"memory");
      asm volatile("ds_read_b64_tr_b16 %0,%1 offset:%c2":"=&v"(hi[ks]):"v"(vb),"i"(d0*4096+ks*1024+512):"memory");}
    asm volatile("s_waitcnt lgkmcnt(0)":::"memory");SBAR();
    #define PK(k) (bf16x8){lo[k][0],lo[k][1],lo[k][2],lo[k][3],hi[k][0],hi[k][1],hi[k][2],hi[k][3]}
    o[d0]=__builtin_amdgcn_mfma_f32_32x32x16_bf16(pa0,PK(0),o[d0],0,0,0);
    o[d0]=__builtin_amdgcn_mfma_f32_32x32x16_bf16(pa1,PK(1),o[d0],0,0,0);
    o[d0]=__builtin_amdgcn_mfma_f32_32x32x16_bf16(pa2,PK(2),o[d0],0,0,0);
    o[d0]=__builtin_amdgcn_mfma_f32_32x32x16_bf16(pa3,PK(3),o[d0],0,0,0);
    #undef PK
  }
}

#ifndef ATTN_STORE16
#define ATTN_STORE16(p,v) (*(u32x4*)(p)=(v))
#endif
template<int THRL> __device__ __forceinline__ void attn_unit(int b,int qb,const bf16*Q,const bf16*__restrict__ K,const bf16*__restrict__ V,bf16*O,char*shm){
  int tid_=threadIdx.x; asm volatile("":"+v"(tid_)); const int tid=tid_,lane=tid&63,r32=lane&31,hi=lane>>5; const int wid=__builtin_amdgcn_readfirstlane(tid>>6);
  const long rowbase=(long)b*SEQ; const int q0=qb*QB;
  const bf16*Qw=Q+(rowbase+q0+wid*QBLK)*DM;
  const bf16*Kh=K+rowbase*DM,*Vh=V+rowbase*DM;
  const unsigned lds0=(unsigned)(uintptr_t)shm;
  float*wsf=(float*)(shm+LDS_WS)+wid*64;
  const bf16*ksrc=Kh+(long)lane*DM+wid*8;
  const bf16*vsrc=Vh+(long)(16*(wid&3)+(lane>>2))*DM+(wid>>2)*32+(lane&3)*8;
  const unsigned kdst=lds0+LDS_K+wid*1024, vdst=lds0+LDS_V+wid*1024;
  #define DMA_K(t,slot) glds16(ksrc+(long)(t)*KVBLK*DM,(unsigned)__builtin_amdgcn_readfirstlane(kdst+(slot)))
  #define DMA_V(t,slot) glds16(vsrc+(long)(t)*KVBLK*DM,(unsigned)__builtin_amdgcn_readfirstlane(vdst+(slot)))
  const int vb0=(int)(lds0+LDS_V)+((lane>>4)&1)*32+(lane&3)*8+(4*hi+((lane&15)>>2))*64;
  const char*Kbase=shm+LDS_K; bf16x8 kf[8];
  const lds_cptr shm3=(lds_cptr)shm; const lds_cptr kp0=shm3+LDS_K+hi*1024+r32*16; const lds_cptr vp0=shm3+LDS_V+((lane>>4)&1)*32+(lane&3)*8+(4*hi+((lane&15)>>2))*64;
  const int NT=(q0+QB)/KVBLK;
  DMA_K(0,0);DMA_V(0,0);DMA_K(1,SLOTB);
  bf16x8 qr[4];
  #pragma unroll
  for(int d0=0;d0<4;++d0)qr[d0]=*reinterpret_cast<const bf16x8*>(&Qw[(long)r32*DM+d0*16+hi*8]);
  float mhat=0.f,l_reg=0.f;f32x16 o[2];o[0]=f32x16{};o[1]=f32x16{};f32x16 negm=f32x16{};asm volatile("":"+v"(negm));
  const int qrel=wid*QBLK+r32;
  #define CMASK(P0,P1,t) do{int jb_=(t)-(NT-4); if(jb_>=0)cmask(P0,P1,jb_,qrel,hi);}while(0)
  bool resc=false;
  #define START(P0,P1) do{ const float rm=rowmax(P0,P1); resc=false; \
    { const float dl=rm; mhat=fadd_s(mhat,dl); \
      _Pragma("unroll") for(int r=0;r<16;++r){P0[r]=fsub_s(P0[r],dl);P1[r]=fsub_s(P1[r],dl);} \
      _Pragma("unroll") for(int r=0;r<16;++r)negm[r]=-mhat; asm volatile("":"+v"(negm)); } \
    _Pragma("unroll") for(int r=0;r<16;++r)P0[r]=__builtin_amdgcn_exp2f(P0[r]); }while(0)
  #define RESC() do{ if(resc){ asm volatile("s_waitcnt lgkmcnt(0)":::"memory"); \
      _Pragma("unroll") for(int d_=0;d_<2;++d_) _Pragma("unroll") for(int r=0;r<16;++r)o[d_][r]*=wsf[crow(r,hi)]; } }while(0)
  f32x16 pA0,pA1,pB0,pB1;
  int sl_prev=0,sl_cur=0,sl_next=SLOTB;
  #define ROT() do{sl_prev=sl_cur;sl_cur=sl_next;sl_next=(sl_next==(NSLOT-1)*SLOTB)?0:sl_next+SLOTB;}while(0)
  DMA_K(2,2*SLOTB);
  WAIT_BAR(3);
  qkt(pA0,pA1,Kbase,qr,negm,r32,hi);asm volatile("s_nop 15\n\ts_nop 7":"+v"(pA0),"+v"(pA1));CMASK(pA0,pA1,0);
  START(pA0,pA1);
  _Pragma("unroll") for(int r=0;r<16;++r)pA1[r]=__builtin_amdgcn_exp2f(pA1[r]);
  WAIT_BAR(0);
  DMA_K(3,0);DMA_V(1,SLOTB);
  ROT();
  kload8(kf,kp0+sl_cur);
  WAIT_BAR(2);
  s16x4 vlo[8],vhi[8]; u32x4 pw0,pw1,pw2,pw3;
  #define PKW(P,B) cvtpk_s(P[B],P[B+1])
  #define PAF(k) __builtin_bit_cast(bf16x8,pw##k)
  #define VFR(i) (bf16x8){vlo[i][0],vlo[i][1],vlo[i][2],vlo[i][3],vhi[i][0],vhi[i][1],vhi[i][2],vhi[i][3]}
  #define PIN(x) asm volatile("":"+v"(x))
  #define MX3(a,b,c) __builtin_fmaxf(__builtin_fmaxf((a),(b)),(c))
  #define GAPA(MF,A0,A1,A2,A3,W0,W1,PW) do{ MF; sacc+=A0; sacc+=A1; sacc+=A2; sacc+=A3; PIN(sacc); W0; W1; PIN(PW); SBAR(); }while(0)
  #define EX(v) __builtin_amdgcn_exp2f(v)
  #define GAPB(MF,X,B) do{ MF; X[B]=EX(X[B]); X[B+1]=EX(X[B+1]); X[B+2]=EX(X[B+2]); X[B+3]=EX(X[B+3]); PIN(X); SBAR(); }while(0)
  #define VRD(i) do{ vlo[i]=vtr(vp_+(((i)>>2)*4096+((i)&3)*1024)); vhi[i]=vtr(vp_+(((i)>>2)*4096+((i)&3)*1024+512)); }while(0)
  #define KRD(G,j) do{ if(G){ kload2(kf,kp0+sl_next,j); SBAR(); } }while(0)
  #define STEP(C0,C1,P0,P1,t,GK,GV,GL) do{ SBAR(); \
    const lds_cptr vp_=vp0+sl_prev; \
    VRD(0); SBAR(); float sacc=(P0[0]+P0[1]); \
    GAPA(C0=__builtin_amdgcn_mfma_f32_32x32x16_bf16(kf[0],qr[0],negm,0,0,0), P0[2],P0[3],P0[4],P0[5],     pw0[0]=PKW(P0,0), pw0[1]=PKW(P0,2), pw0); \
    VRD(4); SBAR(); GAPA(C1=__builtin_amdgcn_mfma_f32_32x32x16_bf16(kf[1],qr[0],negm,0,0,0), P0[6],P0[7],P0[8],P0[9],     pw0[2]=PKW(P0,4), pw0[3]=PKW(P0,6), pw0); \
    VRD(1); SBAR(); GAPA(C0=__builtin_amdgcn_mfma_f32_32x32x16_bf16(kf[2],qr[1],C0,0,0,0),   P0[10],P0[11],P0[12],P0[13], pw1[0]=PKW(P0,8), pw1[1]=PKW(P0,10), pw1); \
    VRD(5); SBAR(); GAPA(C1=__builtin_amdgcn_mfma_f32_32x32x16_bf16(kf[3],qr[1],C1,0,0,0),   P0[14],P0[15],P1[0],P1[1],   pw1[2]=PKW(P0,12),pw1[3]=PKW(P0,14), pw1); \
    VRD(2); SBAR(); GAPA(C0=__builtin_amdgcn_mfma_f32_32x32x16_bf16(kf[4],qr[2],C0,0,0,0),   P1[2],P1[3],P1[4],P1[5],     pw2[0]=PKW(P1,0), pw2[1]=PKW(P1,2), pw2); \
    VRD(6); SBAR(); GAPA(C1=__builtin_amdgcn_mfma_f32_32x32x16_bf16(kf[5],qr[2],C1,0,0,0),   P1[6],P1[7],P1[8],P1[9],     pw2[2]=PKW(P1,4), pw2[3]=PKW(P1,6), pw2); \
    VRD(3); SBAR(); GAPA(C0=__builtin_amdgcn_mfma_f32_32x32x16_bf16(kf[6],qr[3],C0,0,0,0),   P1[10],P1[11],P1[12],P1[13], pw3[0]=PKW(P1,8), pw3[1]=PKW(P1,10), pw3); \
    VRD(7); SBAR(); GAPA(C1=__builtin_amdgcn_mfma_f32_32x32x16_bf16(kf[7],qr[3],C1,0,0,0),   P1[14],P1[15],0.f,0.f,       pw3[2]=PKW(P1,12),pw3[3]=PKW(P1,14), pw3); \
    l_reg+=sacc; \
    if(GK){DMA_K((t)+3,sl_cur);} if(GV){DMA_V((t)+1,sl_next);} \
    CMASK(C0,C1,t); \
    { float a=MX3(C0[0],C0[1],C1[0]),b=MX3(C0[2],C0[3],C1[1]); a=MX3(a,C1[2],C1[3]); \
      _Pragma("unroll") for(int r=4;r<16;r+=4){a=MX3(a,C0[r],C0[r+1]);b=MX3(b,C0[r+2],C0[r+3]);a=MX3(a,C1[r],C1[r+1]);b=MX3(b,C1[r+2],C1[r+3]);} \
      float rm=__builtin_fmaxf(a,b); { auto rr=__builtin_amdgcn_permlane32_swap(__float_as_uint(rm),__float_as_uint(rm),false,false); rm=__builtin_fmaxf(__uint_as_float(rr[0]),__uint_as_float(rr[1])); } \
      resc=false; \
      if(__builtin_expect(__any(rm>(float)THRL),0)){ const float dl=__builtin_fmaxf(rm,0.f); mhat+=dl; \
        _Pragma("unroll") for(int r=0;r<16;++r){C0[r]-=dl;C1[r]-=dl;} \
        _Pragma("unroll") for(int r=0;r<16;++r)negm[r]=-mhat; asm volatile("":"+v"(negm)); \
        const float f=__builtin_amdgcn_exp2f(-dl); l_reg*=f; if(hi==0)wsf[r32]=f; resc=true; } } \
    SBAR(); \
    GAPB(o[0]=__builtin_amdgcn_mfma_f32_32x32x16_bf16(PAF(0),VFR(0),o[0],0,0,0), C0,0); \
    GAPB(o[1]=__builtin_amdgcn_mfma_f32_32x32x16_bf16(PAF(0),VFR(4),o[1],0,0,0), C0,4); \
    KRD(GL,0); GAPB(o[0]=__builtin_amdgcn_mfma_f32_32x32x16_bf16(PAF(1),VFR(1),o[0],0,0,0), C0,8); \
    KRD(GL,1); GAPB(o[1]=__builtin_amdgcn_mfma_f32_32x32x16_bf16(PAF(1),VFR(5),o[1],0,0,0), C0,12); \
    KRD(GL,2); GAPB(o[0]=__builtin_amdgcn_mfma_f32_32x32x16_bf16(PAF(2),VFR(2),o[0],0,0,0), C1,0); \
    KRD(GL,3); GAPB(o[1]=__builtin_amdgcn_mfma_f32_32x32x16_bf16(PAF(2),VFR(6),o[1],0,0,0), C1,4); \
    GAPB(o[0]=__builtin_amdgcn_mfma_f32_32x32x16_bf16(PAF(3),VFR(3),o[0],0,0,0), C1,8); \
    GAPB(o[1]=__builtin_amdgcn_mfma_f32_32x32x16_bf16(PAF(3),VFR(7),o[1],0,0,0), C1,12); \
    }while(0)
  int t=1;
  #undef CMASK
  #define CMASK(P0,P1,t) do{}while(0)
  for(;t+5<NT;t+=2){
    STEP(pB0,pB1,pA0,pA1,t,true,true,true);     WAIT_BAR(2); RESC(); ROT();
    STEP(pA0,pA1,pB0,pB1,t+1,true,true,true);   WAIT_BAR(2); RESC(); ROT();
  }
  #undef CMASK
  #define CMASK(P0,P1,t) do{int jb_=(t)-(NT-4); if(jb_>=0)cmask(P0,P1,jb_,qrel,hi);}while(0)
  #define ENDW(tt) do{ if((tt)+3<NT){WAIT_BAR(2);} else if((tt)+2<NT){WAIT_BAR(1);} else {WAIT_BAR(0);} }while(0)
  for(;t+1<NT;t+=2){
    STEP(pB0,pB1,pA0,pA1,t,(t+3<NT),(t+1<NT),(t+1<NT));       ENDW(t);   RESC(); ROT();
    STEP(pA0,pA1,pB0,pB1,t+1,(t+4<NT),(t+2<NT),(t+2<NT));     ENDW(t+1); RESC(); ROT();
  }
  STEP(pB0,pB1,pA0,pA1,NT-1,false,false,false); RESC();
  { float sacc=pB0[0]+pB0[1]; _Pragma("unroll") for(int r=2;r<16;++r)sacc+=pB0[r]; _Pragma("unroll") for(int r=0;r<16;++r)sacc+=pB1[r]; l_reg+=sacc;
    pw0=(u32x4){PKW(pB0,0),PKW(pB0,2),PKW(pB0,4),PKW(pB0,6)};pw1=(u32x4){PKW(pB0,8),PKW(pB0,10),PKW(pB0,12),PKW(pB0,14)};pw2=(u32x4){PKW(pB1,0),PKW(pB1,2),PKW(pB1,4),PKW(pB1,6)};pw3=(u32x4){PKW(pB1,8),PKW(pB1,10),PKW(pB1,12),PKW(pB1,14)};
    SBAR(); pv(o,vb0+sl_cur,PAF(0),PAF(1),PAF(2),PAF(3)); }
  #undef PKW
  #undef PAF
  #undef VFR
  #undef PIN
  #undef MX3
  #undef GAPA
  #undef GAPB
  #undef EX
  #undef VRD
  #undef KRD
  #undef STEP
  #undef ENDW
  {auto rr=__builtin_amdgcn_permlane32_swap(__float_as_uint(l_reg),__float_as_uint(l_reg),false,false);l_reg=__uint_as_float(rr[0])+__uint_as_float(rr[1]);}
  if(hi==0)wsf[32+r32]=l_reg;asm volatile("s_waitcnt lgkmcnt(0)":::"memory");
  float rli[16];
  #pragma unroll
  for(int r=0;r<16;++r)rli[r]=__builtin_amdgcn_rcpf(wsf[32+crow(r,hi)]);
  bf16*Ow=O+(rowbase+q0+wid*QBLK)*DMO;
  { bf16*stg=(bf16*)(shm+LDS_OST)+wid*2048;
    #pragma unroll
    for(int r=0;r<16;++r){const int orow=crow(r,hi);
      #pragma unroll
      for(int d0=0;d0<2;++d0)stg[orow*64+d0*32+r32]=__float2bfloat16(o[d0][r]*rli[r]);}
    asm volatile("s_waitcnt lgkmcnt(0)":::"memory");
    #pragma unroll
    for(int i=0;i<4;++i){const int row=i*8+(lane>>3),ch=lane&7; const u32x4 v=*(const u32x4*)(stg+row*64+ch*8); ATTN_STORE16(Ow+(long)row*DMO+ch*8,v);} }
  asm volatile("s_waitcnt lgkmcnt(0)\n\ts_barrier":::"memory");
  #undef DMA_K
  #undef DMA_V
  #undef CMASK
  #undef START
  #undef RESC
  #undef ROT
}
constexpr int ATTN_LDS_BYTES=LDS_BYTES;
#undef SBAR
#undef WAIT_BAR
}


constexpr int NWAVES = 8;
constexpr int NB = 2, T = 4096, NTOK = NB * T, D = 2048, C = 1024, NH = 16, HD = 64;
constexpr int PPITCH = 6656;
constexpr int PC_R = 0, PC_K = 1024, PC_V = 2048, PC_L = 3072, PC_Q = 3584, PC_KA = 4608, PC_VA = 5632;
constexpr int LK = 384;
constexpr int NEXP = 32, DEXP = 512, RMAX = 24576;
constexpr int NPH_LAYER = 13, NPHASES = 1 + 2 * NPH_LAYER;

constexpr size_t MiB = 1u << 20, KiB = 1u << 10;
constexpr size_t WS_CTL = 0, CTL_ZERO_BYTES = 1 * MiB;
constexpr size_t WS_ROPE = 1 * MiB;
constexpr size_t WS_PART = WS_ROPE + 256 * KiB;
constexpr size_t WS_TOKE = WS_PART + 1 * MiB;
constexpr size_t WS_TOKW = WS_TOKE + 64 * KiB;
constexpr size_t WS_TOKR = WS_TOKW + 64 * KiB;
constexpr size_t WS_TOKS = WS_TOKR + 64 * KiB;
constexpr size_t WS_RSTD2 = WS_TOKS + 64 * KiB;
constexpr size_t WS_CNT = WS_RSTD2 + 32 * KiB;
constexpr size_t WS_SRS = WS_CNT + 32 * KiB;
constexpr size_t WS_SWT = WS_SRS + 96 * KiB;
constexpr size_t WS_BONUS = WS_SWT + 96 * KiB;
constexpr size_t WS_SMALL_END = WS_BONUS + 512 * KiB;
static_assert(WS_SMALL_END <= 4 * MiB, "small tables");
constexpr size_t WS_HBA = 4 * MiB, WS_HBB = WS_HBA + 32 * MiB;
constexpr size_t WS_VFIRST = WS_HBB + 32 * MiB;
constexpr size_t WS_PB = WS_VFIRST + 32 * MiB;
constexpr size_t WS_WIN = WS_PB + 8 * MiB;
constexpr size_t WS_WOUT = WS_WIN + 52 * MiB;
constexpr size_t WS_WPG = WS_WOUT + 16 * MiB;
constexpr size_t WS_WPP = WS_WPG + 16 * MiB;
constexpr size_t WS_WL2 = WS_WPP + 2 * MiB;
constexpr size_t WS_WGU = WS_WL2 + 6 * MiB;
constexpr size_t WS_WD = WS_WGU + 128 * MiB;
constexpr size_t WS_PROJ = WS_WD + 64 * MiB;
constexpr size_t WS_LORAA = WS_PROJ + 104 * MiB;
constexpr size_t WS_LORAO = WS_LORAA + 6 * MiB;
constexpr size_t WS_OB = WS_LORAO + 64 * MiB;
constexpr size_t WS_CONCAT = WS_OB + 32 * MiB;
constexpr size_t WS_PPB = WS_CONCAT + 32 * MiB;
constexpr size_t WS_SCAN = WS_PPB + 32 * MiB;
constexpr size_t WS_Y = WS_SCAN + 192 * MiB;
constexpr size_t WS_ASORT = WS_SCAN;
constexpr size_t WS_HG = WS_ASORT + 96 * MiB;
constexpr size_t WS_OSLOT = WS_HG + 24 * MiB;
constexpr size_t WS_END = WS_SCAN + 224 * MiB;
static_assert(WS_OSLOT + 96 * MiB <= WS_END, "MoE overlay fits the scan region");
constexpr int CW_BAR = 4096;

constexpr int RING_OFF = 0, RING_BYTES = 131072;
constexpr int LDSCTL_OFF = RING_BYTES, MISC_OFF = LDSCTL_OFF + 320;
constexpr int META_OFF = LDSCTL_OFF + 1024;
constexpr int LDS_BYTES = 147456;
static_assert(attn_body::ATTN_LDS_BYTES <= RING_BYTES, "attention scratch fits the ring");

#define GAS __attribute__((address_space(1)))
#define LAS __attribute__((address_space(3)))
typedef unsigned short bf16;
typedef unsigned v4u __attribute__((ext_vector_type(4)));
typedef unsigned v2u __attribute__((ext_vector_type(2)));
typedef float f32x4 __attribute__((ext_vector_type(4)));
typedef GAS unsigned gu32;
#define RLX_AGENT __ATOMIC_RELAXED, __HIP_MEMORY_SCOPE_AGENT
#define LDS_WAIT() asm volatile("s_waitcnt lgkmcnt(0)" ::: "memory")
__device__ __forceinline__ unsigned f2bf(float f) { unsigned u = __builtin_bit_cast(unsigned, f); return (u + 0x7fffu + ((u >> 16) & 1u)) >> 16; }
__device__ __forceinline__ unsigned pk2(float lo, float hi) { return f2bf(lo) | (f2bf(hi) << 16); }
__device__ __forceinline__ float bflo(unsigned u) { return __builtin_bit_cast(float, u << 16); }
__device__ __forceinline__ float bfhi(unsigned u) { return __builtin_bit_cast(float, u & 0xffff0000u); }
__device__ __forceinline__ float sigmoidf_(float x) { return 1.0f / (1.0f + __expf(-x)); }

#define XB_TMO      128
#define XB_XCNT(j)  (256  + 64 * (j))
#define XB_XSUB(j)  (1280 + 64 * (j))
#define XB_XGEN(j)  (2304 + 64 * (j))
#define XB_TOP      3328
#define XB_TOPGEN   3392
#define XCD_BAR_WORDS 3456
#define XB_SPIN_CAP (1u << 18)

__device__ __forceinline__ unsigned xb_ld(unsigned* p)              { return __hip_atomic_load(p, __ATOMIC_RELAXED, __HIP_MEMORY_SCOPE_AGENT); }
__device__ __forceinline__ unsigned xb_add(unsigned* p, unsigned v) { return __hip_atomic_fetch_add(p, v, __ATOMIC_RELAXED, __HIP_MEMORY_SCOPE_AGENT); }
__device__ __forceinline__ unsigned xb_xcc_id() { return (unsigned)__builtin_amdgcn_s_getreg((3 << 11) | 20) & 0xFu; }
#define XB_SPIN(cond, bar) do { unsigned _sp = 0; while (cond) { __builtin_amdgcn_s_sleep(1); \
    if ((++_sp & 255u) == 0u) { if (xb_ld(&(bar)[XB_TMO])) break; if (_sp > XB_SPIN_CAP) { atomicAdd(&(bar)[XB_TMO], 1u); break; } } } } while (0)

struct XcdBarrier {
    unsigned* bar; unsigned x;
    volatile LAS unsigned* st;
};

__device__ __forceinline__ XcdBarrier xcd_barrier_post(unsigned* bar, volatile LAS unsigned* st) {
    XcdBarrier b; b.bar = bar; b.x = xb_xcc_id(); b.st = st;
    if (threadIdx.x == 0) (void)xb_add(&bar[XB_XCNT(b.x)], 1u);
    return b;
}
__device__ __forceinline__ void xcd_barrier_complete(unsigned* bar, unsigned x, unsigned& nloc, unsigned& nx) {
    const unsigned G = gridDim.x * gridDim.y * gridDim.z;
    unsigned sum, cnt, mine, sp = 0u;
    for (;;) {
        sum = 0u; cnt = 0u; mine = 0u;
#pragma unroll
        for (unsigned j = 0; j < 16; ++j) { const unsigned c = xb_ld(&bar[XB_XCNT(j)]); sum += c; cnt += (c > 0u) ? 1u : 0u; mine = (j == x) ? c : mine; }
        if (sum == G) break;
        __builtin_amdgcn_s_sleep(1);
        if ((++sp & 255u) == 0u) { if (xb_ld(&bar[XB_TMO])) break; if (sp > XB_SPIN_CAP) { atomicAdd(&bar[XB_TMO], 1u); break; } }
    }
    nloc = mine > 0u ? mine : 1u; nx = cnt > 0u ? cnt : 1u;
}

__device__ __forceinline__ void xcd_barrier(const XcdBarrier& b) {
    asm volatile("s_waitcnt vmcnt(0)" ::: "memory");
    __syncthreads();
    if (threadIdx.x == 0) {
        unsigned* bar = b.bar;
        __builtin_amdgcn_s_waitcnt(0);
        unsigned nloc = b.st[0], nx = b.st[1];
        if (nloc == 0u) { xcd_barrier_complete(bar, b.x, nloc, nx); b.st[0] = nloc; b.st[1] = nx; }
        const unsigned old = xb_add(&bar[XB_XSUB(b.x)], 1u);
        const unsigned gen = old / nloc;
        if (old + 1u == (gen + 1u) * nloc) {
            __builtin_amdgcn_fence(__ATOMIC_RELEASE, "agent");
            asm volatile("s_waitcnt vmcnt(0)" ::: "memory");
            const unsigned og = xb_add(&bar[XB_TOP], 1u);
            const unsigned tg = og / nx;
            if (og + 1u == (tg + 1u) * nx) xb_add(&bar[XB_TOPGEN], 1u);
            else XB_SPIN(xb_ld(&bar[XB_TOPGEN]) == tg, bar);
            __builtin_amdgcn_fence(__ATOMIC_ACQUIRE, "agent");
            xb_add(&bar[XB_XGEN(b.x)], 1u);
            asm volatile("s_waitcnt vmcnt(0)" ::: "memory");
        } else {
            XB_SPIN(xb_ld(&bar[XB_XGEN(b.x)]) == gen, bar);
            __builtin_amdgcn_fence(__ATOMIC_ACQUIRE, "agent");
            asm volatile("s_waitcnt vmcnt(0)" ::: "memory");
        }
    }
    __syncthreads();
}


__device__ __forceinline__ int fresh_tid() { int t = threadIdx.x; asm volatile("" : "+v"(t)); return t; }
struct Frame {
    LAS unsigned char* lds;
    int tid, lane, wave, vcu, G;
    unsigned char* ws;
};
extern __shared__ __attribute__((aligned(16))) unsigned char lds_dyn[];
__device__ __forceinline__ Frame mk_frame(unsigned char* ws) {
    Frame F; F.lds = (LAS unsigned char*)lds_dyn; F.tid = fresh_tid(); F.lane = F.tid & 63; F.wave = __builtin_amdgcn_readfirstlane(F.tid >> 6);
    F.G = gridDim.x; { const int bx = blockIdx.x; F.vcu = (F.G % 8 == 0) ? (bx % 8) * (F.G / 8) + bx / 8 : bx; }
    F.ws = ws; return F;
}
template <int CTRL, int RM> __device__ __forceinline__ float dpp_get(float v) { return __int_as_float(__builtin_amdgcn_update_dpp(0, __float_as_int(v), CTRL, RM, 0xf, false)); }
__device__ __forceinline__ float wave_total63(float v) {
    v += dpp_get<0xB1, 0xf>(v);
    v += dpp_get<0x4E, 0xf>(v);
    v += dpp_get<0x141, 0xf>(v);
    v += dpp_get<0x140, 0xf>(v);
    v += dpp_get<0x142, 0xa>(v);
    v += dpp_get<0x143, 0xc>(v);
    return v;
}
__device__ __forceinline__ float wave_bcast63(float v) { return __int_as_float(__builtin_amdgcn_readlane(__float_as_int(v), 63)); }
__device__ __forceinline__ float red16(float v) { v += __shfl_xor(v, 1); v += __shfl_xor(v, 2); v += __shfl_xor(v, 4); v += __shfl_xor(v, 8); return v; }
__device__ __forceinline__ float red32(float v) { v = red16(v); v += __shfl_xor(v, 16); return v; }
__device__ __forceinline__ float red64(float v) { v = red32(v); v += __shfl_xor(v, 32); return v; }

__device__ __forceinline__ void transpose_item(const float* W, int ldw, int k0, int n0, bf16* WT, int Kd, int drow, const float* gain, LAS float* scr, int lane) {
#pragma unroll 8
    for (int i = 0; i < 32; ++i) { const int kk = 2 * i + (lane >> 5); float v = W[(size_t)(k0 + kk) * ldw + n0 + (lane & 31)]; if (gain) v *= gain[k0 + kk]; scr[kk * 33 + (lane & 31)] = v; }
    LDS_WAIT(); asm volatile("" ::: "memory");
    const int c = lane & 7;
#pragma unroll
    for (int j = 0; j < 4; ++j) { const int n = (lane >> 3) + 8 * j; const LAS float* s = scr + (8 * c) * 33 + n;
        v4u o; o.x = pk2(s[0 * 33], s[1 * 33]); o.y = pk2(s[2 * 33], s[3 * 33]); o.z = pk2(s[4 * 33], s[5 * 33]); o.w = pk2(s[6 * 33], s[7 * 33]);
        *(GAS v4u*)(WT + (size_t)(drow + n) * Kd + k0 + 8 * c) = o; }
    LDS_WAIT(); asm volatile("" ::: "memory");
}
__device__ __forceinline__ void conv_plain(Frame& F, const float* W, int ldw, int K, int n_lo, int nblk, bf16* WT, int drow0, const float* gain) {
    LAS float* scr = (LAS float*)(F.lds + RING_OFF + F.wave * 16384);
    const int gw = F.vcu * NWAVES + F.wave, NGW = F.G * NWAVES, nit = (K / 64) * nblk;
    for (int it = gw; it < nit; it += NGW) { const int kb = it / nblk, nb = it % nblk; transpose_item(W, ldw, 64 * kb, n_lo + 32 * nb, WT, K, drow0 + 32 * nb, gain, scr, F.lane); }
}
__device__ __forceinline__ void zero_rows(Frame& F, bf16* WT, int K, int r0, int r1) {
    const size_t n16 = (size_t)(r1 - r0) * K / 8; GAS v4u* p = (GAS v4u*)(WT + (size_t)r0 * K);
    for (size_t i = (size_t)F.vcu * 512 + F.tid; i < n16; i += (size_t)F.G * 512) p[i] = (v4u){0u, 0u, 0u, 0u};
}
__device__ __forceinline__ void conv_moe(Frame& F, const float* wg, const float* wu, const float* wd, const float* gain, bf16* WGU, bf16* WD) {
    LAS float* scr = (LAS float*)(F.lds + RING_OFF + F.wave * 16384);
    const int gw = F.vcu * NWAVES + F.wave, NGW = F.G * NWAVES;
    for (int it = gw; it < 32 * 1536; it += NGW) {
        const int e = it / 1536, r = it % 1536;
        if (r < 1024) { const int up = r >> 9, q = r & 511, kb = q >> 4, nb = q & 15;
            const float* W = (up ? wu : wg) + (size_t)e * 2048 * 512;
            transpose_item(W, 512, 64 * kb, 32 * nb, WGU + (size_t)e * 1024 * 2048, 2048, (nb >> 2) * 256 + up * 128 + (nb & 3) * 32, gain, scr, F.lane);
        } else { const int q = r - 1024, kb = q >> 6, nb = q & 63;
            transpose_item(wd + (size_t)e * 512 * 2048, 2048, 64 * kb, 32 * nb, WD + (size_t)e * 2048 * 512, 512, 32 * nb, nullptr, scr, F.lane); }
    }
}

struct Args { const float* in[38]; float* out; unsigned char* ws; int ph_lo, ph_hi; };
typedef const __attribute__((address_space(4))) Args* ArgP;
__device__ __forceinline__ ArgP get_args() { ArgP p = (ArgP)__builtin_amdgcn_kernarg_segment_ptr(); asm volatile("" : "+s"(p)); return p; }

__device__ __forceinline__ void p0_prologue(Frame& F, ArgP A) {
    unsigned char* ws = F.ws;
    const int gt = F.vcu * 512 + F.tid, NGT = F.G * 512;
    const int gw = F.vcu * NWAVES + F.wave, NGW = F.G * NWAVES;
    { float* rope = (float*)(ws + WS_ROPE);
      for (int i = gt; i < T * 8; i += NGT) { const int t = i >> 3, j = i & 7; const float inv = powf(500000.0f, -((float)(2 * j) / 16.0f)); const float ang = (float)t * inv;
          rope[t * 16 + j] = cosf(ang); rope[t * 16 + 8 + j] = sinf(ang); } }
    { const float* x = A->in[0]; bf16* hb = (bf16*)(ws + WS_HBA); float* part = (float*)(ws + WS_PART);
      for (int m = gw; m < NTOK; m += NGW) { const GAS f32x4* xr = (const GAS f32x4*)(x + (size_t)m * D); GAS v2u* o = (GAS v2u*)(hb + (size_t)m * D); float ss = 0.f;
#pragma unroll
          for (int j = 0; j < 8; ++j) { const f32x4 v = xr[F.lane + 64 * j]; ss += (v[0] * v[0] + v[1] * v[1]) + (v[2] * v[2] + v[3] * v[3]); o[F.lane + 64 * j] = (v2u){pk2(v[0], v[1]), pk2(v[2], v[3])}; }
          ss = red64(ss);
          if (F.lane < 32) part[(size_t)m * 32 + F.lane] = (F.lane == 0) ? ss : 0.f; } }
    { const GAS f32x4* p = (const GAS f32x4*)A->in[1]; GAS v2u* o = (GAS v2u*)(ws + WS_PB);
      for (int i = gt; i < 2 * NTOK * 256 / 4; i += NGT) { const f32x4 v = p[i]; o[i] = (v2u){pk2(v[0], v[1]), pk2(v[2], v[3])}; } }
    { bf16* wl2 = (bf16*)(ws + WS_WL2);
      for (int i = gt; i < 2 * 4096 * LK; i += NGT) { const int l = i / (4096 * LK), r = i % (4096 * LK), c = r / LK, j = r % LK, seg = c >> 10, cc = c & 1023; float v = 0.f;
          if (seg == 0 && j < 64) v = A->in[9][(size_t)l * 64 * 1024 + (size_t)j * 1024 + cc];
          else if (seg == 1 && j >= 64 && j < 128) v = A->in[11][(size_t)l * 64 * 1024 + (size_t)(j - 64) * 1024 + cc];
          else if (seg == 2 && j >= 128 && j < 288) v = A->in[12][(size_t)l * 160 * 1024 + (size_t)(j - 128) * 1024 + cc];
          else if (seg == 3 && j >= 288 && j < 320 && l == 1) v = A->in[14][(size_t)(j - 288) * 1024 + cc];
          wl2[i] = (bf16)f2bf(v); } }
    { bf16* w0 = (bf16*)(ws + WS_WIN); bf16* w1 = w0 + (size_t)PPITCH * D;
      conv_plain(F, A->in[4], 6432, D, 0, 3360 / 32, w0, 0, A->in[2]);
      conv_plain(F, A->in[4], 6432, D, 3360, 3072 / 32, w0, 3584, A->in[2]);
      zero_rows(F, w0, D, 3360, 3584);
      conv_plain(F, A->in[5], 6464, D, 0, 3392 / 32, w1, 0, A->in[2] + D);
      conv_plain(F, A->in[5], 6464, D, 3392, 3072 / 32, w1, 3584, A->in[2] + D);
      zero_rows(F, w1, D, 3392, 3584); }
    for (int l = 0; l < 2; ++l) {
        conv_plain(F, A->in[27] + (size_t)l * D * D, D, D, 0, D / 32, (bf16*)(ws + WS_WOUT) + (size_t)l * D * D, 0, nullptr);
        conv_plain(F, A->in[35] + (size_t)l * D * D, D, D, 0, D / 32, (bf16*)(ws + WS_WPG) + (size_t)l * D * D, 0, nullptr);
        conv_plain(F, A->in[37] + (size_t)l * 256 * D, D, 256, 0, D / 32, (bf16*)(ws + WS_WPP) + (size_t)l * D * 256, 0, nullptr);
    }
    conv_moe(F, A->in[32], A->in[33], A->in[34], A->in[3], (bf16*)(ws + WS_WGU), (bf16*)(ws + WS_WD));
}

__device__ __forceinline__ void prep1_phase(Frame& F, ArgP A, int layer) {
    unsigned char* ws = F.ws; bf16* proj = (bf16*)(ws + WS_PROJ); bf16* la = (bf16*)(ws + WS_LORAA);
    const float* mu = layer ? A->in[7] : A->in[6];
    const int gt = F.vcu * 512 + F.tid, NGT = F.G * 512;
    for (int i = gt; i < NTOK * (LK / 2); i += NGT) { const int m = i / (LK / 2), j = (i % (LK / 2)) * 2; float o0 = 0.f, o1 = 0.f;
        if (j < (layer ? 320 : 288)) { const unsigned cur = *(const GAS unsigned*)(proj + (size_t)m * PPITCH + PC_L + j);
            const unsigned prv = (m & (T - 1)) ? *(const GAS unsigned*)(proj + (size_t)(m - 1) * PPITCH + PC_L + j) : 0u;
            const float c0 = bflo(cur), c1 = bfhi(cur), q0 = bflo(prv), q1 = bfhi(prv);
            o0 = c0 + (q0 - c0) * mu[3072 + j]; o1 = c1 + (q1 - c1) * mu[3072 + j + 1];
            if (j < 64) { o0 = tanhf(o0); o1 = tanhf(o1); } else if (j >= 128 && j < 288) { o0 = sigmoidf_(o0); o1 = sigmoidf_(o1); } }
        *(GAS unsigned*)(la + (size_t)m * LK + j) = pk2(o0, o1); }
    const float* qg = A->in[20] + layer * 64; const float* kg = A->in[21] + layer * 64; const float* rope = (const float*)(ws + WS_ROPE);
    const int gw = F.vcu * NWAVES + F.wave, NGW = F.G * NWAVES, sub = F.lane & 15;
    for (int m = gw; m < NTOK; m += NGW) { const int t = m & (T - 1);
#pragma unroll 2
        for (int j = 0; j < 8; ++j) { const int grp = j * 4 + (F.lane >> 4); const bool isq = grp < 16;
            bf16* p = proj + (size_t)m * PPITCH + (isq ? PC_Q + grp * 64 : PC_KA + (grp - 16) * 64) + sub * 4;
            const v2u raw = *(const GAS v2u*)p; float x[4] = {bflo(raw.x), bfhi(raw.x), bflo(raw.y), bfhi(raw.y)};
            const float ss = red16(x[0] * x[0] + x[1] * x[1] + x[2] * x[2] + x[3] * x[3]); const float rs = rsqrtf(ss * (1.0f / 64.0f) + 1e-6f);
            const float* g = isq ? qg : kg;
#pragma unroll
            for (int e = 0; e < 4; ++e) x[e] = x[e] * rs * g[sub * 4 + e];
            float y[4];
#pragma unroll
            for (int e = 0; e < 4; ++e) { const float other = __shfl_xor(x[e], 2); const int ri = (sub & 1) * 4 + e; const float cs = rope[t * 16 + ri], sn = rope[t * 16 + 8 + ri];
                y[e] = (sub < 2) ? (x[e] * cs - other * sn) : ((sub < 4) ? (x[e] * cs + other * sn) : x[e]); }
            const float sc = isq ? attn_body::C2 : 1.0f;
            *(GAS v2u*)p = (v2u){pk2(y[0] * sc, y[1] * sc), pk2(y[2] * sc, y[3] * sc)}; } }
}

__device__ __forceinline__ f32x4 ld_bf4(const bf16* p) { const v2u r = *(const GAS v2u*)p; return (f32x4){bflo(r.x), bfhi(r.x), bflo(r.y), bfhi(r.y)}; }
__device__ __forceinline__ void prep2_phase(Frame& F, ArgP A, int layer) {
    unsigned char* ws = F.ws; const bf16* proj = (const bf16*)(ws + WS_PROJ); const bf16* lo = (const bf16*)(ws + WS_LORAO);
    float* SA = (float*)(ws + WS_SCAN); float* SW = SA + (size_t)NTOK * C; float* SB = SW + (size_t)NTOK * C; float* SK = SB + (size_t)NTOK * C; float* SR = SK + (size_t)NTOK * C; float* SV = SR + (size_t)NTOK * C;
    float* vfirst = (float*)(ws + WS_VFIRST); float* bonus = (float*)(ws + WS_BONUS);
    const float* mu = layer ? A->in[7] : A->in[6];
    const float* w0 = A->in[8] + layer * C; const float* a0 = A->in[10] + layer * C; const float* v0 = A->in[13]; const float* kk_ = A->in[15] + layer * C; const float* ka_ = A->in[16] + layer * C; const float* rk_ = A->in[17] + layer * C;
    const int gw = F.vcu * NWAVES + F.wave, NGW = F.G * NWAVES;
    for (int m = gw; m < NTOK; m += NGW) { const bool hp = (m & (T - 1)) != 0; const bf16* pr = proj + (size_t)m * PPITCH; const bf16* pq = pr - PPITCH;
#pragma unroll 1
        for (int j = 0; j < 4; ++j) { const int c0 = j * 256 + F.lane * 4; const f32x4 z = (f32x4){0.f, 0.f, 0.f, 0.f};
            const f32x4 r_c = ld_bf4(pr + PC_R + c0), k_c = ld_bf4(pr + PC_K + c0), v_c = ld_bf4(pr + PC_V + c0);
            const f32x4 r_p = hp ? ld_bf4(pq + PC_R + c0) : z, k_p = hp ? ld_bf4(pq + PC_K + c0) : z, v_p = hp ? ld_bf4(pq + PC_V + c0) : z;
            const f32x4 xr = r_c + (r_p - r_c) * *(const f32x4*)(mu + c0), xk = k_c + (k_p - k_c) * *(const f32x4*)(mu + 1024 + c0), xv = v_c + (v_p - v_c) * *(const f32x4*)(mu + 2048 + c0);
            const f32x4 lw = ld_bf4(lo + (size_t)m * 4096 + c0), la = ld_bf4(lo + (size_t)m * 4096 + 1024 + c0), lv = ld_bf4(lo + (size_t)m * 4096 + 3072 + c0);
            const f32x4 w0v = *(const f32x4*)(w0 + c0), a0v = *(const f32x4*)(a0 + c0), kkv = *(const f32x4*)(kk_ + c0), kav = *(const f32x4*)(ka_ + c0), rkv = *(const f32x4*)(rk_ + c0);
            f32x4 dec, av, vv, kkn, k2; float ssq = 0.f, bs = 0.f;
            f32x4 vf = z, v0v = z; if (layer) { vf = *(const f32x4*)(vfirst + (size_t)m * C + c0); v0v = *(const f32x4*)(v0 + c0); }
#pragma unroll
            for (int e = 0; e < 4; ++e) { const float zz = -(w0v[e] + lw[e]); const float sp = fmaxf(zz, 0.f) + log1pf(__expf(-fabsf(zz))); const float w = -sp - 0.5f; dec[e] = __expf(-__expf(w));
                av[e] = sigmoidf_(a0v[e] + la[e]);
                vv[e] = layer ? xv[e] + (vf[e] - xv[e]) * sigmoidf_(v0v[e] + lv[e]) : xv[e];
                kkn[e] = xk[e] * kkv[e]; ssq += kkn[e] * kkn[e];
                k2[e] = xk[e] * (1.0f + (av[e] - 1.0f) * kav[e]); bs += xr[e] * k2[e] * rkv[e]; }
            ssq = red16(ssq); bs = red16(bs); const float inv = 1.0f / fmaxf(sqrtf(ssq), 1e-12f);
            f32x4 sa, sb;
#pragma unroll
            for (int e = 0; e < 4; ++e) { const float kn = kkn[e] * inv; sa[e] = -kn; sb[e] = kn * av[e]; }
            const size_t o = (size_t)m * C + c0;
            *(f32x4*)(SA + o) = sa; *(f32x4*)(SW + o) = dec; *(f32x4*)(SB + o) = sb; *(f32x4*)(SK + o) = k2; *(f32x4*)(SR + o) = xr; *(f32x4*)(SV + o) = vv;
            if (!layer) *(f32x4*)(vfirst + o) = xv;
            if ((F.lane & 15) == 0) bonus[(size_t)m * 16 + j * 4 + (F.lane >> 4)] = bs; } }
}

__device__ __forceinline__ void scan_phase(Frame& F) {
    unsigned char* ws = F.ws;
    const float* SA = (const float*)(ws + WS_SCAN); const float* SW = SA + (size_t)NTOK * C; const float* SB = SW + (size_t)NTOK * C; const float* SK = SB + (size_t)NTOK * C; const float* SR = SK + (size_t)NTOK * C; const float* SV = SR + (size_t)NTOK * C;
    float* Y = (float*)(ws + WS_Y);
    constexpr int TC = 32, VEC = TC * 64, BUFSZ = 5 * VEC + TC * 8;
    LAS float* L = (LAS float*)(F.lds + RING_OFF);
    const int li = F.tid >> 4, lq = F.tid & 15, lane = F.lane, wid = F.wave;
    for (int u = F.vcu; u < 256; u += F.G) {
        const int bh = u >> 3, oct = u & 7, b = bh >> 4, h = bh & 15; const size_t m0 = (size_t)b * T; const int col0 = h * 64, v0 = oct * 8;
        float S = 0.f;
        f32x4 ra, rw, rb, rk, rr; float rv = 0.f;
#define SC_LOAD(t0) do { const size_t so = (m0 + (t0) + li) * C + col0 + lq * 4; ra = *(const f32x4*)(SA + so); rw = *(const f32x4*)(SW + so); rb = *(const f32x4*)(SB + so); rk = *(const f32x4*)(SK + so); rr = *(const f32x4*)(SR + so); \
            if (F.tid < 256) rv = SV[(m0 + (t0) + (F.tid >> 3)) * C + col0 + v0 + (F.tid & 7)]; } while (0)
#define SC_WRITE(bi) do { LAS float* Bf = L + (bi) * BUFSZ; const int o = li * 64 + lq * 4; *(LAS f32x4*)(Bf + o) = ra; *(LAS f32x4*)(Bf + VEC + o) = rw; *(LAS f32x4*)(Bf + 2 * VEC + o) = rb; *(LAS f32x4*)(Bf + 3 * VEC + o) = rk; *(LAS f32x4*)(Bf + 4 * VEC + o) = rr; \
            if (F.tid < 256) Bf[5 * VEC + F.tid] = rv; } while (0)
        SC_LOAD(0); SC_WRITE(0); __syncthreads();
        for (int ch = 0; ch < T / TC; ++ch) {
            if (ch + 1 < T / TC) SC_LOAD((ch + 1) * TC);
            const LAS float* Bf = L + (ch & 1) * BUFSZ; float yacc = 0.f;
#pragma unroll 4
            for (int i = 0; i < TC; ++i) {
                const float a = Bf[i * 64 + lane], w = Bf[VEC + i * 64 + lane], bb = Bf[2 * VEC + i * 64 + lane], kk = Bf[3 * VEC + i * 64 + lane], r = Bf[4 * VEC + i * 64 + lane], vv = Bf[5 * VEC + i * 8 + wid];
                const float sa = wave_bcast63(wave_total63(S * a));
                S = fmaf(vv, kk, fmaf(sa, bb, S * w));
                const float y = wave_bcast63(wave_total63(S * r));
                yacc = (lane == i) ? y : yacc;
            }
            if (lane < TC) Y[(m0 + (size_t)ch * TC + lane) * C + col0 + v0 + wid] = yacc;
            if (ch + 1 < T / TC) SC_WRITE((ch + 1) & 1);
            __syncthreads();
        }
#undef SC_LOAD
#undef SC_WRITE
    }
}

__device__ __forceinline__ void attn_phase_all(Frame& F, char* ldsc) {
    unsigned char* ws = F.ws; const attn_body::bf16* proj = (const attn_body::bf16*)(ws + WS_PROJ); attn_body::bf16* ob = (attn_body::bf16*)(ws + WS_OB);
    const int per = (F.G == 256) ? 4 : 0;
    for (int i = 0;; ++i) { int inst, qb;
        if (per) { if (i >= 4) break; const int s = F.vcu & 3; inst = F.vcu >> 2; qb = (i == 0) ? 15 - s : (i == 1) ? 8 + s : (i == 2) ? 7 - s : s; }
        else { const int L = i * F.G + F.vcu; if (L >= 1024) break; inst = L >> 4; qb = 15 - (L & 15); }
        const int b = inst >> 5, h = (inst >> 2) & 7, c = (inst >> 1) & 1, e = inst & 1;
        attn_body::attn_unit<8>(b, qb, proj + PC_Q + h * 128 + c * 64, proj + PC_KA + h * 128 + c * 64, proj + PC_VA + h * 128 + e * 64, ob + (size_t)c * NTOK * 1024 + h * 128 + e * 64, ldsc);
    }
}

__device__ __forceinline__ void post_phase(Frame& F, ArgP A, int layer) {
    unsigned char* ws = F.ws; const float* Y = (const float*)(ws + WS_Y); const float* SV = (const float*)(ws + WS_SCAN) + (size_t)5 * NTOK * C; const bf16* lo = (const bf16*)(ws + WS_LORAO);
    const float* bonus = (const float*)(ws + WS_BONUS); bf16* cc = (bf16*)(ws + WS_CONCAT); const bf16* ob = (const bf16*)(ws + WS_OB);
    const float* gng = A->in[18] + layer * C; const float* gnb = A->in[19] + layer * C; const float* sg = A->in[26] + layer * 128;
    const float lam_init = layer ? (0.8f - 0.6f * 0.74081822068171788f) : 0.2f;
    const float s1 = red64(A->in[22][layer * 64 + F.lane] * A->in[23][layer * 64 + F.lane]), s2 = red64(A->in[24][layer * 64 + F.lane] * A->in[25][layer * 64 + F.lane]);
    const float lam = expf(s1) - expf(s2) + lam_init;
    const int gw = F.vcu * NWAVES + F.wave, NGW = F.G * NWAVES;
    for (int m = gw; m < NTOK; m += NGW) {
#pragma unroll 1
        for (int j = 0; j < 4; ++j) { const int c0 = j * 256 + F.lane * 4; const size_t o = (size_t)m * C + c0;
            const f32x4 y = *(const f32x4*)(Y + o); const float mean = red16((y[0] + y[1]) + (y[2] + y[3])) * (1.0f / 64.0f);
            const f32x4 d = y - mean; const float var = red16((d[0] * d[0] + d[1] * d[1]) + (d[2] * d[2] + d[3] * d[3])) * (1.0f / 64.0f); const float rs = rsqrtf(var + 64e-5f);
            const f32x4 g = ld_bf4(lo + (size_t)m * 4096 + 2048 + c0), v = *(const f32x4*)(SV + o), gg = *(const f32x4*)(gng + c0), gb = *(const f32x4*)(gnb + c0);
            const float bs = bonus[(size_t)m * 16 + j * 4 + (F.lane >> 4)]; float r[4];
#pragma unroll
            for (int e = 0; e < 4; ++e) r[e] = (d[e] * rs * gg[e] + gb[e] + bs * v[e]) * g[e];
            *(GAS v2u*)(cc + (size_t)m * 2048 + c0) = (v2u){pk2(r[0], r[1]), pk2(r[2], r[3])}; }
#pragma unroll 1
        for (int j = 0; j < 4; ++j) { const int hd = j * 2 + (F.lane >> 5), e0 = (F.lane & 31) * 4; const size_t o = (size_t)m * 1024 + hd * 128 + e0;
            const f32x4 o0 = ld_bf4(ob + o), o1 = ld_bf4(ob + (size_t)NTOK * 1024 + o); const f32x4 d = o0 - o1 * lam;
            const float ss = red32((d[0] * d[0] + d[1] * d[1]) + (d[2] * d[2] + d[3] * d[3])); const float rs = rsqrtf(ss * (1.0f / 128.0f) + 1e-6f) * (1.0f - lam_init);
            const f32x4 gv = *(const f32x4*)(sg + e0);
            *(GAS v2u*)(cc + (size_t)m * 2048 + 1024 + hd * 128 + e0) = (v2u){pk2(d[0] * rs * gv[0], d[1] * rs * gv[1]), pk2(d[2] * rs * gv[2], d[3] * rs * gv[3])}; }
    }
}

__device__ __forceinline__ void router_phase(Frame& F, ArgP A, int layer, const float* hcur) {
    unsigned char* ws = F.ws;
    const float* g2 = A->in[3] + layer * D; const float* wrg = A->in[28] + (size_t)layer * D * 4; const float* brg = A->in[29] + layer * 4; const float* wre = A->in[30] + (size_t)layer * D * 32; const float* bre = A->in[31] + layer * 32;
    int* toke = (int*)(ws + WS_TOKE); float* tokw = (float*)(ws + WS_TOKW); int* tokr = (int*)(ws + WS_TOKR); float* rstd2 = (float*)(ws + WS_RSTD2); int* cnt = (int*)(ws + WS_CNT);
    LAS float* hs = (LAS float*)(F.lds + RING_OFF);
    LAS float* wsm = (LAS float*)(F.lds + RING_OFF + 33024);
    LAS float* red = (LAS float*)(F.lds + RING_OFF);
    LAS float* lg = (LAS float*)(F.lds + RING_OFF + 80 * 1024);
    const int tok = F.tid & 31, ks = F.tid >> 5;
    for (int tile = F.vcu; tile < NTOK / 32; tile += F.G) { const int m0 = tile * 32;
        float acc[36]; float ssq = 0.f;
#pragma unroll
        for (int c = 0; c < 36; ++c) acc[c] = 0.f;
#pragma unroll 1
        for (int kc = 0; kc < 8; ++kc) { const int k0 = kc * 256;
            __syncthreads();
#pragma unroll
            for (int q = 0; q < 4; ++q) { const int idx = F.tid + 512 * q, tr = idx >> 6, c4 = idx & 63; const f32x4 v = *(const f32x4*)(hcur + (size_t)(m0 + tr) * D + k0 + c4 * 4);
                LAS float* d = hs + tr * 257 + c4 * 4; d[0] = v[0]; d[1] = v[1]; d[2] = v[2]; d[3] = v[3]; }
#pragma unroll 1
            for (int q = 0; q < 18; ++q) { const int idx = F.tid + 512 * q, k = idx / 36, c = idx % 36; const float gk = g2[k0 + k];
                wsm[idx] = gk * ((c < 4) ? wrg[(size_t)(k0 + k) * 4 + c] : wre[(size_t)(k0 + k) * 32 + (c - 4)]); }
            __syncthreads();
#pragma unroll 4
            for (int kk = 0; kk < 16; ++kk) { const int k = ks * 16 + kk; const float xv = hs[tok * 257 + k]; ssq += xv * xv;
#pragma unroll
                for (int c4 = 0; c4 < 9; ++c4) { const f32x4 w4 = *(const LAS f32x4*)(wsm + k * 36 + c4 * 4);
                    acc[c4 * 4 + 0] += xv * w4[0]; acc[c4 * 4 + 1] += xv * w4[1]; acc[c4 * 4 + 2] += xv * w4[2]; acc[c4 * 4 + 3] += xv * w4[3]; } }
        }
        __syncthreads();
#pragma unroll
        for (int c = 0; c < 36; ++c) red[(ks * 32 + tok) * 37 + c] = acc[c];
        red[(ks * 32 + tok) * 37 + 36] = ssq;
        __syncthreads();
        for (int c = ks; c < 37; c += 16) { float s = 0.f;
#pragma unroll
            for (int q = 0; q < 16; ++q) s += red[(q * 32 + tok) * 37 + c];
            lg[tok * 40 + c] = s; }
        __syncthreads();
        if (F.wave == 0) { const bool act = F.lane < 32; const int tk = F.lane & 31; const int m = m0 + tk;
            const float rs = rsqrtf(lg[tk * 40 + 36] * (1.0f / 2048.0f) + 1e-6f);
            float l0 = lg[tk * 40 + 0] * rs + brg[0], l1 = lg[tk * 40 + 1] * rs + brg[1], l2 = lg[tk * 40 + 2] * rs + brg[2], l3 = lg[tk * 40 + 3] * rs + brg[3];
            int grp = 0; float lm = l0; if (l1 > lm) { lm = l1; grp = 1; } if (l2 > lm) { lm = l2; grp = 2; } if (l3 > lm) { lm = l3; grp = 3; }
            const float gp = 1.0f / (__expf(l0 - lm) + __expf(l1 - lm) + __expf(l2 - lm) + __expf(l3 - lm));
            int i1 = 0, i2 = 0; float b1 = -3.0e38f, b2 = -3.0e38f;
#pragma unroll
            for (int q = 0; q < 8; ++q) { const float v = lg[tk * 40 + 4 + grp * 8 + q] * rs + bre[grp * 8 + q];
                if (v > b1) { b2 = b1; i2 = i1; b1 = v; i1 = q; } else if (v > b2) { b2 = v; i2 = q; } }
            const float ex = __expf(b2 - b1); const float p1 = 1.0f / (1.0f + ex), p2 = ex / (1.0f + ex);
            const int e1 = grp * 8 + i1, e2 = grp * 8 + i2; int r1 = 0, r2 = 0, mycnt = 0;
            const unsigned long long lt = (1ull << tk) - 1ull;
#pragma unroll 1
            for (int e = 0; e < 32; ++e) { const unsigned long long bm = __ballot(act && (e1 == e || e2 == e)) & 0xffffffffull;
                if (e1 == e) r1 = __popcll(bm & lt); if (e2 == e) r2 = __popcll(bm & lt); if (tk == e) mycnt = __popcll(bm); }
            if (act) { toke[m * 2] = e1; toke[m * 2 + 1] = e2; tokw[m * 2] = gp * p1; tokw[m * 2 + 1] = gp * p2; tokr[m * 2] = r1; tokr[m * 2 + 1] = r2; rstd2[m] = rs; cnt[tile * 32 + tk] = mycnt; }
        }
    }
}

__device__ __forceinline__ void moe_meta(Frame& F, int mytile) {
    LAS int* meta = (LAS int*)(F.lds + META_OFF); LAS int* poff = meta, *tot = meta + 33, *base = meta + 65, *tile_e = meta + 97, *ntl = meta + 193; LAS int* tmp = meta + 256;
    const int* cnt = (const int*)(F.ws + WS_CNT);
    __syncthreads();
    { const int e = F.tid & 31, p = F.tid >> 5; int t = 0, bs = 0;
#pragma unroll 4
      for (int q = 0; q < 16; ++q) { const int b = p * 16 + q; const int c = cnt[b * 32 + e]; t += c; bs += (b < mytile) ? c : 0; }
      tmp[p * 32 + e] = t; tmp[512 + p * 32 + e] = bs; }
    __syncthreads();
    if (F.tid < 32) { int t = 0, bs = 0; for (int p = 0; p < 16; ++p) { t += tmp[p * 32 + F.tid]; bs += tmp[512 + p * 32 + F.tid]; } tot[F.tid] = t; base[F.tid] = bs; }
    __syncthreads();
    if (F.tid == 0) { int o = 0, nt = 0; for (int e = 0; e < 32; ++e) { poff[e] = o; const int np = (tot[e] + 255) >> 8; for (int q = 0; q < np; ++q) tile_e[nt++] = e; o += np * 256; } poff[32] = o; *ntl = nt; }
    __syncthreads();
}
__device__ __forceinline__ void gather_phase(Frame& F, const bf16* hbsrc) {
    unsigned char* ws = F.ws; LAS int* meta = (LAS int*)(F.lds + META_OFF); LAS int* poff = meta, *base = meta + 65;
    const int* toke = (const int*)(ws + WS_TOKE); const float* tokw = (const float*)(ws + WS_TOKW); const int* tokr = (const int*)(ws + WS_TOKR); const float* rstd2 = (const float*)(ws + WS_RSTD2);
    int* toks = (int*)(ws + WS_TOKS); float* srs = (float*)(ws + WS_SRS); float* swt = (float*)(ws + WS_SWT); bf16* asort = (bf16*)(ws + WS_ASORT);
    for (int tile = F.vcu; tile < NTOK / 32; tile += F.G) {
        moe_meta(F, tile);
        for (int q = 0; q < 8; ++q) { const int tk = F.wave * 4 + (q >> 1), j = q & 1, m = tile * 32 + tk; const int e = toke[m * 2 + j]; const int slot = poff[e] + base[e] + tokr[m * 2 + j];
            const GAS v4u* src = (const GAS v4u*)(hbsrc + (size_t)m * D); GAS v4u* dst = (GAS v4u*)(asort + (size_t)slot * D);
#pragma unroll
            for (int p = 0; p < 4; ++p) dst[F.lane + 64 * p] = src[F.lane + 64 * p];
            if (F.lane == 0) { toks[m * 2 + j] = slot; srs[slot] = rstd2[m]; swt[slot] = tokw[m * 2 + j]; } }
    }
}
__device__ __forceinline__ void combine_phase(Frame& F, float* h, bf16* hbdst) {
    unsigned char* ws = F.ws; const int* toks = (const int*)(ws + WS_TOKS); const bf16* os = (const bf16*)(ws + WS_OSLOT);
    const int gw = F.vcu * NWAVES + F.wave, NGW = F.G * NWAVES;
    for (int m = gw; m < NTOK; m += NGW) { const int s0 = toks[m * 2], s1 = toks[m * 2 + 1];
#pragma unroll
        for (int p = 0; p < 4; ++p) { const int c0 = (F.lane + 64 * p) * 8; const v4u a = *(const GAS v4u*)(os + (size_t)s0 * D + c0), b = *(const GAS v4u*)(os + (size_t)s1 * D + c0);
            float* hp = h + (size_t)m * D + c0; f32x4 h0 = *(const f32x4*)hp, h1 = *(const f32x4*)(hp + 4);
            h0[0] += bflo(a.x) + bflo(b.x); h0[1] += bfhi(a.x) + bfhi(b.x); h0[2] += bflo(a.y) + bflo(b.y); h0[3] += bfhi(a.y) + bfhi(b.y);
            h1[0] += bflo(a.z) + bflo(b.z); h1[1] += bfhi(a.z) + bfhi(b.z); h1[2] += bflo(a.w) + bflo(b.w); h1[3] += bfhi(a.w) + bfhi(b.w);
            *(f32x4*)hp = h0; *(f32x4*)(hp + 4) = h1;
            *(GAS v4u*)(hbdst + (size_t)m * D + c0) = (v4u){pk2(h0[0], h0[1]), pk2(h0[2], h0[3]), pk2(h1[0], h1[1]), pk2(h1[2], h1[3])}; } }
}

#ifndef PHMASK
#define PHMASK 0x3FFF
#endif
#define PHBIT(k) ((k) == 0 ? 0 : (((k) - 1) % NPH_LAYER) + 1)
#define IN(k) (lo <= (k) && (k) < hi && ((PHMASK >> PHBIT(k)) & 1))
#define SEAM(k) do { if (IN(k) && IN((k) + 1)) { ArgP A_ = get_args(); XcdBarrier b_; b_.bar = (unsigned*)(A_->ws + WS_CTL) + CW_BAR; b_.x = xb_xcc_id(); b_.st = (volatile LAS unsigned*)((LAS unsigned char*)lds_dyn + MISC_OFF) + 8; xcd_barrier(b_); } } while (0)
#define PHASE_BEGIN ArgP A = get_args(); unsigned char* ws = A->ws; Frame F = mk_frame(ws);

template <int layer> __device__ __forceinline__ void run_layer(const int lo, const int hi) {
        const int pb = 1 + layer * NPH_LAYER;
        if (IN(pb + 0)) { PHASE_BEGIN bf16* hb_in = (bf16*)(ws + (layer ? WS_HBB : WS_HBA));
            pg8::Gemm g{hb_in, (const bf16*)(ws + WS_WIN) + (size_t)layer * PPITCH * D, NTOK, PPITCH, D}; pg8::StaticOrder S; S.init(NTOK, PPITCH, F.G, (int)blockIdx.x);
            pg8::EpiProj E{(bf16*)(ws + WS_PROJ), PPITCH, (const float*)(ws + WS_PART)};
            pg8::gemm_phase<pg8::EpiProj, pg8::StaticOrder, PG8_ALIGN, PG8_SP2>(F.lds + RING_OFF, g, S, E); }
        SEAM(pb + 0);
        if (IN(pb + 1)) { PHASE_BEGIN prep1_phase(F, A, layer); }
        SEAM(pb + 1);
        if (IN(pb + 2)) { PHASE_BEGIN pg8::Gemm g{(const bf16*)(ws + WS_LORAA), (const bf16*)(ws + WS_WL2) + (size_t)layer * 4096 * LK, NTOK, 4096, LK}; pg8::StaticOrder S; S.init(NTOK, 4096, F.G, (int)blockIdx.x);
            pg8::EpiBf16s E{(bf16*)(ws + WS_LORAO), 4096};
            pg8::gemm_phase<pg8::EpiBf16s, pg8::StaticOrder, PG8_ALIGN, PG8_SP2>(F.lds + RING_OFF, g, S, E); }
        SEAM(pb + 2);
        if (IN(pb + 3)) { PHASE_BEGIN prep2_phase(F, A, layer); }
        SEAM(pb + 3);
#ifndef NOSCAN
        if (IN(pb + 4)) { PHASE_BEGIN scan_phase(F); __syncthreads(); }
#endif
#ifndef NOATTN
        if (IN(pb + 4)) { PHASE_BEGIN attn_phase_all(F, (char*)lds_dyn + RING_OFF); }
#endif
        SEAM(pb + 4);
        if (IN(pb + 5)) { PHASE_BEGIN post_phase(F, A, layer); }
        SEAM(pb + 5);
        if (IN(pb + 6)) { PHASE_BEGIN bf16* hb_mid = (bf16*)(ws + (layer ? WS_HBA : WS_HBB));
            pg8::Gemm g{(const bf16*)(ws + WS_CONCAT), (const bf16*)(ws + WS_WOUT) + (size_t)layer * D * D, NTOK, D, D}; pg8::StaticOrder S; S.init(NTOK, D, F.G, (int)blockIdx.x);
            pg8::EpiResid E{layer ? (const float*)A->out : A->in[0], A->out, hb_mid};
            pg8::gemm_phase<pg8::EpiResid, pg8::StaticOrder, PG8_ALIGN, PG8_SP2>(F.lds + RING_OFF, g, S, E); }
        SEAM(pb + 6);
        if (IN(pb + 7)) { PHASE_BEGIN router_phase(F, A, layer, A->out); }
        SEAM(pb + 7);
        if (IN(pb + 8)) { PHASE_BEGIN gather_phase(F, (const bf16*)(ws + (layer ? WS_HBA : WS_HBB))); __syncthreads(); }
        if (IN(pb + 8)) { PHASE_BEGIN
            pg8::Gemm g{(const bf16*)(ws + WS_PB) + (size_t)layer * NTOK * 256, (const bf16*)(ws + WS_WPP) + (size_t)layer * D * 256, NTOK, D, 256}; pg8::StaticOrder S; S.init(NTOK, D, F.G, (int)blockIdx.x);
            pg8::EpiBf16s E{(bf16*)(ws + WS_PPB), D};
            pg8::gemm_phase<pg8::EpiBf16s, pg8::StaticOrder, PG8_ALIGN, PG8_SP2>(F.lds + RING_OFF, g, S, E); }
        SEAM(pb + 8);
        if (IN(pb + 9)) { PHASE_BEGIN moe_meta(F, 0); LAS int* meta = (LAS int*)(F.lds + META_OFF); const int nt = __builtin_amdgcn_readfirstlane(meta[193]);
            pg8::Gemm g{(const bf16*)(ws + WS_ASORT), (const bf16*)(ws + WS_WGU), nt * 256, 1024, D}; pg8::MoeOrder S; S.init(nt, 2, F.G, F.vcu); S.tile_e = (const PG8_LAS int*)(meta + 97); S.NE = 1024;
            pg8::EpiGLU E{(bf16*)(ws + WS_HG), (const float*)(ws + WS_SRS), (const float*)(ws + WS_SWT)};
            pg8::gemm_phase<pg8::EpiGLU, pg8::MoeOrder, PG8_ALIGN, PG8_SP2>(F.lds + RING_OFF, g, S, E); }
        SEAM(pb + 9);
        if (IN(pb + 10)) { PHASE_BEGIN moe_meta(F, 0); LAS int* meta = (LAS int*)(F.lds + META_OFF); const int nt = __builtin_amdgcn_readfirstlane(meta[193]);
            pg8::Gemm g{(const bf16*)(ws + WS_HG), (const bf16*)(ws + WS_WD), nt * 256, D, DEXP}; pg8::MoeOrder S; S.init(nt, 3, F.G, F.vcu); S.tile_e = (const PG8_LAS int*)(meta + 97); S.NE = D;
            pg8::EpiBf16s E{(bf16*)(ws + WS_OSLOT), D};
            pg8::gemm_phase<pg8::EpiBf16s, pg8::MoeOrder, PG8_ALIGN, PG8_SP2>(F.lds + RING_OFF, g, S, E); }
        SEAM(pb + 10);
        if (IN(pb + 11)) { PHASE_BEGIN combine_phase(F, A->out, (bf16*)(ws + (layer ? WS_HBB : WS_HBA))); }
        if (IN(pb + 11) && layer == 0) { PHASE_BEGIN __syncthreads(); conv_moe(F, A->in[32] + (size_t)32 * 2048 * 512, A->in[33] + (size_t)32 * 2048 * 512, A->in[34] + (size_t)32 * 512 * 2048, A->in[3] + D, (bf16*)(ws + WS_WGU), (bf16*)(ws + WS_WD)); }
        SEAM(pb + 11);
        if (IN(pb + 12)) { PHASE_BEGIN bf16* hb_in = (bf16*)(ws + (layer ? WS_HBB : WS_HBA)); bf16* hb_mid = (bf16*)(ws + (layer ? WS_HBA : WS_HBB));
            pg8::Gemm g{hb_in, (const bf16*)(ws + WS_WPG) + (size_t)layer * D * D, NTOK, D, D}; pg8::StaticOrder S; S.init(NTOK, D, F.G, (int)blockIdx.x);
            pg8::EpiPLE E{A->out, hb_mid, (const bf16*)(ws + WS_PPB), A->in[36] + layer * D, layer ? (float*)nullptr : (float*)(ws + WS_PART)};
            pg8::gemm_phase<pg8::EpiPLE, pg8::StaticOrder, PG8_ALIGN, PG8_SP2>(F.lds + RING_OFF, g, S, E); }
        SEAM(pb + 12);
    }

__global__ void __launch_bounds__(NWAVES * 64, 2) mk_fwd(Args args_unused) {
    { LAS unsigned char* l = (LAS unsigned char*)lds_dyn; const int t0 = threadIdx.x;
      for (int u = t0; u < (LDS_BYTES - LDSCTL_OFF) / 4; u += NWAVES * 64) ((LAS unsigned*)(l + LDSCTL_OFF))[u] = 0u; }
    __syncthreads();
    int lo, hi; { ArgP A = get_args(); lo = A->ph_lo; hi = A->ph_hi; }
    if (hi - lo > 1) { ArgP A = get_args(); (void)xcd_barrier_post((unsigned*)(A->ws + WS_CTL) + CW_BAR, (volatile LAS unsigned*)((LAS unsigned char*)lds_dyn + MISC_OFF) + 8); }
    if (IN(0)) { PHASE_BEGIN p0_prologue(F, A); }
    SEAM(0);
    run_layer<0>(lo, hi);
    run_layer<1>(lo, hi);
#undef IN
#undef SEAM
}

#ifndef MK_PER_PHASE
#define MK_PER_PHASE 0
#endif
extern "C" void kernel_launch(void* const* d_in, const int* in_sizes, int n_in, void* d_out, int out_size, void* d_ws, size_t ws_size, hipStream_t stream) {
    static int grid = 0;
    if (grid == 0) {
        if (n_in != 38 || out_size != NTOK * D || ws_size < WS_END) { fprintf(stderr, "kernel_launch: unexpected shapes (n_in %d out %d ws %zu need %zu)\n", n_in, out_size, ws_size, (size_t)WS_END); grid = -1; return; }
        int dev = 0, cus = 0, per_cu = 0;
        if (hipGetDevice(&dev) != hipSuccess || hipDeviceGetAttribute(&cus, hipDeviceAttributeMultiprocessorCount, dev) != hipSuccess) { grid = -1; return; }
        if (hipFuncSetAttribute((const void*)mk_fwd, hipFuncAttributeMaxDynamicSharedMemorySize, LDS_BYTES) != hipSuccess) { grid = -1; return; }
        if (hipOccupancyMaxActiveBlocksPerMultiprocessor(&per_cu, (const void*)mk_fwd, NWAVES * 64, LDS_BYTES) != hipSuccess || per_cu < 1) fprintf(stderr, "kernel_launch: occupancy query says %d\n", per_cu);
        (void)hipGetLastError();
        grid = cus;
    }
    if (grid < 0) return;
    if (hipMemsetAsync((char*)d_ws + WS_CTL, 0, CTL_ZERO_BYTES, stream) != hipSuccess) return;
    Args a{};
    for (int i = 0; i < 38; ++i) a.in[i] = (const float*)d_in[i];
    a.out = (float*)d_out; a.ws = (unsigned char*)d_ws;
#if MK_PER_PHASE
    for (int ph = 0; ph < NPHASES; ++ph) { a.ph_lo = ph; a.ph_hi = ph + 1; hipLaunchKernelGGL(mk_fwd, dim3(grid), dim3(NWAVES * 64), LDS_BYTES, stream, a); }
#else
    a.ph_lo = 0; a.ph_hi = NPHASES;
    hipLaunchKernelGGL(mk_fwd, dim3(grid), dim3(NWAVES * 64), LDS_BYTES, stream, a);
#endif
}
```

```cpp
#include <hip/hip_runtime.h>
#include <hip/hip_bf16.h>
#include <cstdio>
#include <cstdint>
namespace pg8 {
#define PG8_LAS __attribute__((address_space(3)))
typedef unsigned short bf16_t;
typedef short bf16x8 __attribute__((ext_vector_type(8)));
typedef float f32x4 __attribute__((ext_vector_type(4)));
typedef unsigned u32x4 __attribute__((ext_vector_type(4)));
constexpr int BM = 256, BK = 64, HALF = 128, HTB = HALF * BK * 2  , STAGE_BYTES = 8 * HTB, NXCD = 8, WGM = 8;

__host__ __device__ __forceinline__ int lds_byte(int r, int c) { const int st = (r >> 4) * 2 + (c >> 5), rr = r & 15, cc = c & 31, ob = rr * 64 + cc * 2; return st * 1024 + (ob ^ (((ob >> 9) & 1) << 5)); }
__host__ __device__ __forceinline__ void stage_rc(int b, int& R, int& C) { const int st = b / 1024, sb = b % 1024, swz = sb ^ (((sb >> 9) & 1) << 5); R = (st >> 1) * 16 + swz / 64; C = (st & 1) * 32 + (swz % 64) / 2; }
__host__ __device__ __forceinline__ int perm32(int rho) { const int n = rho >> 4, i = rho & 15; return 8 * (i >> 2) + 4 * n + (i & 3); }

struct Unit { int pm, pn, ord; };
struct Gemm { const bf16_t* A; const bf16_t* Bt; int M, N, K, ld; };

struct StaticOrder {
    static constexpr bool GATHER = false;
    int nM, nN, nwg, G, c;
    __host__ __device__ void init(int M, int N, int G_, int c_) { nM = M / BM; nN = N / BM; nwg = nM * nN; G = G_; c = c_; }
    __host__ __device__ bool next(int i, Unit& u) const {
        const long L = (long)i * G + c; if (L >= nwg) return false;
        int wgid = (int)L; { const int q = nwg / NXCD, r = nwg % NXCD, xcd = wgid % NXCD, off = wgid / NXCD; wgid = (xcd < r ? xcd * (q + 1) : r * (q + 1) + (xcd - r) * q) + off; }
        const int nig = WGM * nN, gid = wgid / nig, fm = gid * WGM, gsz = (nM - fm) < WGM ? (nM - fm) : WGM;
        u.pm = fm + ((wgid % nig) % gsz); u.pn = (wgid % nig) / gsz; u.ord = i; return true;
    }
    __device__ __forceinline__ void a_ready(const Unit&) const {}
    __device__ __forceinline__ void done(const Unit&) const {}
    __device__ __forceinline__ const char* aptr(const Gemm& g, const Unit& u, size_t tstep) const { return (const char*)g.A + (size_t)u.pm * tstep; }
    __device__ __forceinline__ const char* bptr(const Gemm& g, const Unit& u, size_t tstep) const { return (const char*)g.Bt + (size_t)u.pn * tstep; }
};
__device__ __forceinline__ unsigned cvt_pk_bf16(float lo, float hi) { unsigned r; asm volatile("v_cvt_pk_bf16_f32 %0, %1, %2" : "=v"(r) : "v"(lo), "v"(hi)); return r; }
typedef float f32x2 __attribute__((ext_vector_type(2)));


__device__ __forceinline__ u32x4 pack8(const f32x4& v0, const f32x4& v1) { u32x4 w; w.x = cvt_pk_bf16(v0[0], v0[1]); w.y = cvt_pk_bf16(v0[2], v0[3]); w.z = cvt_pk_bf16(v1[0], v1[1]); w.w = cvt_pk_bf16(v1[2], v1[3]); return w; }
__device__ __forceinline__ float bf_lo(unsigned u) { return __builtin_bit_cast(float, u << 16); }
__device__ __forceinline__ float bf_hi(unsigned u) { return __builtin_bit_cast(float, u & 0xffff0000u); }

struct EpiBf16s {
    static constexpr bool PERM = true, AFTER_DRAIN = false;
    bf16_t* O; int ldc;
    __device__ __forceinline__ void operator()(const f32x4 (&acc)[2][2][4][2], const Unit& u, int wr, int wc, int fr, int fq) const {
        const int row0 = u.pm * BM + wr * 64 + fr, col0 = u.pn * BM + wc * 32 + 8 * fq;
#pragma unroll
        for (int ai = 0; ai < 2; ++ai)
#pragma unroll
            for (int m = 0; m < 4; ++m) { bf16_t* rowp = O + (size_t)(row0 + ai * HALF + m * 16) * ldc + col0;
#pragma unroll
                for (int bj = 0; bj < 2; ++bj) *(u32x4*)(rowp + bj * HALF) = pack8(acc[ai][bj][m][0], acc[ai][bj][m][1]); }
    }
};
struct EpiProj {
    static constexpr bool PERM = true, AFTER_DRAIN = false;
    bf16_t* O; int ldc; const PG8_LAS float* rstab; float* rstd_out;
    __device__ __forceinline__ void operator()(const f32x4 (&acc)[2][2][4][2], const Unit& u, int wr, int wc, int fr, int fq) const {
        const int row0 = u.pm * BM + wr * 64 + fr, col0 = u.pn * BM + wc * 32 + 8 * fq; const PG8_LAS float* tb = rstab + u.ord * BM + wr * 64 + fr;
#pragma unroll
        for (int ai = 0; ai < 2; ++ai)
#pragma unroll
            for (int m = 0; m < 4; ++m) { const int row = row0 + ai * HALF + m * 16;
                const float rs = tb[ai * HALF + m * 16];
                if (u.pn == 0 && wc == 0 && fq == 0) rstd_out[row] = rs;
                bf16_t* rowp = O + (size_t)row * ldc + col0;
#pragma unroll
                for (int bj = 0; bj < 2; ++bj) *(u32x4*)(rowp + bj * HALF) = pack8(acc[ai][bj][m][0] * rs, acc[ai][bj][m][1] * rs); }
    }
};
struct EpiResid {
    static constexpr bool PERM = true, AFTER_DRAIN = false;
    const float* hin32; const bf16_t* hinb; bf16_t* hb;
    __device__ __forceinline__ void operator()(const f32x4 (&acc)[2][2][4][2], const Unit& u, int wr, int wc, int fr, int fq) const {
        const int row0 = u.pm * BM + wr * 64 + fr, col0 = u.pn * BM + wc * 32 + 8 * fq;
#pragma unroll
        for (int ai = 0; ai < 2; ++ai) { f32x4 a[4][2][2];
            if (hin32) {
#pragma unroll
                for (int m = 0; m < 4; ++m) { const size_t ro = (size_t)(row0 + ai * HALF + m * 16) * 2048 + col0;
#pragma unroll
                    for (int bj = 0; bj < 2; ++bj) { a[m][bj][0] = *(const f32x4*)(hin32 + ro + bj * HALF); a[m][bj][1] = *(const f32x4*)(hin32 + ro + bj * HALF + 4); } }
            } else { u32x4 q[4][2];
#pragma unroll
                for (int m = 0; m < 4; ++m) { const size_t ro = (size_t)(row0 + ai * HALF + m * 16) * 2048 + col0;
#pragma unroll
                    for (int bj = 0; bj < 2; ++bj) q[m][bj] = *(const u32x4*)(hinb + ro + bj * HALF); }
#pragma unroll
                for (int m = 0; m < 4; ++m)
#pragma unroll
                    for (int bj = 0; bj < 2; ++bj) { const u32x4 w = q[m][bj]; a[m][bj][0] = (f32x4){bf_lo(w.x), bf_hi(w.x), bf_lo(w.y), bf_hi(w.y)}; a[m][bj][1] = (f32x4){bf_lo(w.z), bf_hi(w.z), bf_lo(w.w), bf_hi(w.w)}; } }
#pragma unroll
            for (int m = 0; m < 4; ++m) { const size_t ro = (size_t)(row0 + ai * HALF + m * 16) * 2048 + col0;
#pragma unroll
                for (int bj = 0; bj < 2; ++bj) *(u32x4*)(hb + ro + bj * HALF) = pack8(a[m][bj][0] + acc[ai][bj][m][0], a[m][bj][1] + acc[ai][bj][m][1]); } }
    }
};
struct EpiPLE {
    static constexpr bool PERM = true, AFTER_DRAIN = false;
    const bf16_t* hin; bf16_t* hb; float* out32; const bf16_t* pp; const float* bg; float* part;
    __device__ __forceinline__ void operator()(const f32x4 (&acc)[2][2][4][2], const Unit& u, int wr, int wc, int fr, int fq) const {
        const int row0 = u.pm * BM + wr * 64 + fr, col0 = u.pn * BM + wc * 32 + 8 * fq;
        f32x4 bv[2][2];
#pragma unroll
        for (int bj = 0; bj < 2; ++bj) { bv[bj][0] = *(const f32x4*)(bg + col0 + bj * HALF); bv[bj][1] = *(const f32x4*)(bg + col0 + bj * HALF + 4); }
#pragma unroll
        for (int ai = 0; ai < 2; ++ai)
#pragma unroll
            for (int mh = 0; mh < 2; ++mh) { u32x4 hw[2][2], pw[2][2];
#pragma unroll
                for (int mm = 0; mm < 2; ++mm) { const size_t ro = (size_t)(row0 + ai * HALF + (2 * mh + mm) * 16) * 2048 + col0;
#pragma unroll
                    for (int bj = 0; bj < 2; ++bj) { hw[mm][bj] = *(const u32x4*)(hin + ro + bj * HALF); pw[mm][bj] = *(const u32x4*)(pp + ro + bj * HALF); } }
#pragma unroll
                for (int mm = 0; mm < 2; ++mm) { const int m = 2 * mh + mm, row = row0 + ai * HALF + m * 16; const size_t ro = (size_t)row * 2048 + col0; float ss = 0.f;
#pragma unroll
                    for (int bj = 0; bj < 2; ++bj) { const u32x4 q = pw[mm][bj], g = hw[mm][bj];
                        const f32x4 p0 = (f32x4){bf_lo(q.x), bf_hi(q.x), bf_lo(q.y), bf_hi(q.y)}, p1 = (f32x4){bf_lo(q.z), bf_hi(q.z), bf_lo(q.w), bf_hi(q.w)};
                        const f32x4 a0 = (f32x4){bf_lo(g.x), bf_hi(g.x), bf_lo(g.y), bf_hi(g.y)}, a1 = (f32x4){bf_lo(g.z), bf_hi(g.z), bf_lo(g.w), bf_hi(g.w)};
                        const f32x4 z0 = acc[ai][bj][m][0] + bv[bj][0], z1 = acc[ai][bj][m][1] + bv[bj][1]; f32x4 r0, r1;
#pragma unroll
                        for (int j = 0; j < 4; ++j) { r0[j] = a0[j] + p0[j] / (1.0f + __expf(-z0[j])); r1[j] = a1[j] + p1[j] / (1.0f + __expf(-z1[j])); ss += r0[j] * r0[j] + r1[j] * r1[j]; }
                        if (out32) { *(f32x4*)(out32 + ro + bj * HALF) = r0; *(f32x4*)(out32 + ro + bj * HALF + 4) = r1; }
                        else *(u32x4*)(hb + ro + bj * HALF) = pack8(r0, r1); }
                    ss += __shfl_xor(ss, 16); ss += __shfl_xor(ss, 32);
                    if (part != nullptr && fq == 0) part[(size_t)row * 32 + u.pn * 4 + wc] = ss; } }
    }
};
struct EpiGLU {
    static constexpr bool PERM = true, AFTER_DRAIN = false;
    bf16_t* HG; const float* srs; const float* swt;
    __device__ __forceinline__ void operator()(const f32x4 (&acc)[2][2][4][2], const Unit& u, int wr, int wc, int fr, int fq) const {
        const int row0 = u.pm * BM + wr * 64 + fr, col0 = u.pn * HALF + wc * 32 + 8 * fq;
        float rsv[2][4], wtv[2][4];
#pragma unroll
        for (int ai = 0; ai < 2; ++ai)
#pragma unroll
            for (int m = 0; m < 4; ++m) { rsv[ai][m] = srs[row0 + ai * HALF + m * 16]; wtv[ai][m] = swt[row0 + ai * HALF + m * 16]; }
#pragma unroll
        for (int ai = 0; ai < 2; ++ai)
#pragma unroll
            for (int m = 0; m < 4; ++m) { const int row = row0 + ai * HALF + m * 16; const float rs = rsv[ai][m], wt = wtv[ai][m]; f32x4 o0, o1;
#pragma unroll
                for (int j = 0; j < 4; ++j) { const float g0 = acc[ai][0][m][0][j] * rs, g1 = acc[ai][0][m][1][j] * rs, u0 = acc[ai][1][m][0][j] * rs, u1 = acc[ai][1][m][1][j] * rs;
                    o0[j] = g0 / (1.0f + __expf(-g0)) * u0 * wt; o1[j] = g1 / (1.0f + __expf(-g1)) * u1 * wt; }
                *(u32x4*)(HG + (size_t)row * 512 + col0) = pack8(o0, o1); }
    }
};
struct WinMainOrder : StaticOrder {
    __device__ __forceinline__ bool next(int i, Unit& u) const { if (!StaticOrder::next(i, u)) return false; if (u.pn >= 12) u.pn += 2; return true; }
};
struct Lora2Order : StaticOrder {
    __device__ __forceinline__ const char* aptr(const Gemm& g, const Unit& u, size_t tstep) const { return (const char*)g.A + (size_t)u.pm * tstep + ((u.pn >= 8) ? 256 : 0); }
    __device__ __forceinline__ const char* bptr(const Gemm& g, const Unit& u, size_t tstep) const { return (const char*)g.Bt + (size_t)u.pn * tstep + ((u.pn >= 8) ? 256 : 0); }
};
struct WinLoraOrder {
    static constexpr bool GATHER = false;
    int G, c;
    __device__ __forceinline__ bool next(int i, Unit& u) const { const int L = i * G + c; if (L >= 256) return false; u.pm = L >> 3; u.pn = 12 + ((L >> 2) & 1) + 16 * (L & 3); u.ord = i; return true; }
    __device__ __forceinline__ void a_ready(const Unit&) const {}
    __device__ __forceinline__ void done(const Unit&) const {}
    __device__ __forceinline__ const char* aptr(const Gemm& g, const Unit& u, size_t tstep) const { return (const char*)g.A + (size_t)u.pm * tstep + (size_t)(u.pn >> 4) * 512 * 2; }
    __device__ __forceinline__ const char* bptr(const Gemm& g, const Unit& u, size_t tstep) const { return (const char*)g.Bt + (size_t)(u.pn & 15) * tstep + (size_t)(u.pn >> 4) * 512 * 2; }
};
struct EpiPartF32 {
    static constexpr bool PERM = true, AFTER_DRAIN = false;
    float* LP; int M;
    __device__ __forceinline__ void operator()(const f32x4 (&acc)[2][2][4][2], const Unit& u, int wr, int wc, int fr, int fq) const {
        const int ks = u.pn >> 4, t = (u.pn & 15) - 12; const int row0 = u.pm * BM + wr * 64 + fr, col0 = t * BM + wc * 32 + 8 * fq;
#pragma unroll
        for (int ai = 0; ai < 2; ++ai)
#pragma unroll
            for (int m = 0; m < 4; ++m) { float* rowp = LP + ((size_t)ks * M + row0 + ai * HALF + m * 16) * 512 + col0;
#pragma unroll
                for (int bj = 0; bj < 2; ++bj) { *(f32x4*)(rowp + bj * HALF) = acc[ai][bj][m][0]; *(f32x4*)(rowp + bj * HALF + 4) = acc[ai][bj][m][1]; } }
    }
};
template <bool GATHER_> struct MoeOrderT {
    static constexpr bool GATHER = GATHER_;
    int lg, nunits, G, c; const PG8_LAS int* tile_e; int NE; const int* slottok;
    __device__ __forceinline__ void init(int ntiles, int lg_, int G_, int c_) { lg = lg_; nunits = ntiles << lg_; G = G_; c = c_; }
    __device__ __forceinline__ bool next(int i, Unit& u) const { const int L = i * G + c; if (L >= nunits) return false; u.pm = L >> lg; u.pn = L & ((1 << lg) - 1); u.ord = i; return true; }
    __device__ __forceinline__ void a_ready(const Unit&) const {}
    __device__ __forceinline__ void done(const Unit&) const {}
    __device__ __forceinline__ const char* aptr(const Gemm& g, const Unit& u, size_t tstep) const { return GATHER_ ? (const char*)g.A : (const char*)g.A + (size_t)u.pm * tstep; }
    __device__ __forceinline__ void rowoffs(const Gemm& g, const Unit& u, const int (&R)[2], const int (&Cc)[2], unsigned (&vo)[2][2]) const {
#pragma unroll
        for (int h = 0; h < 2; ++h)
#pragma unroll
            for (int i = 0; i < 2; ++i) vo[h][i] = (unsigned)(slottok[u.pm * BM + h * HALF + R[i]] * g.ld + Cc[i]) * 2u; }
    __device__ __forceinline__ const char* bptr(const Gemm& g, const Unit& u, size_t tstep) const { const int e = __builtin_amdgcn_readfirstlane(tile_e[u.pm]); return (const char*)g.Bt + ((size_t)e * NE + (size_t)u.pn * BM) * (size_t)g.ld * 2; }
};
typedef MoeOrderT<false> MoeOrder; typedef MoeOrderT<true> MoeGatherOrder;

template <class Epi, class Sched, bool ALIGN_EPI = false, bool SP2 = false>
__device__ __forceinline__ void gemm_phase(PG8_LAS unsigned char* lds, const Gemm g, const Sched& S, const Epi& E) {
    int tid_ = threadIdx.x; asm volatile("" : "+v"(tid_)); const int tid = tid_, wid = __builtin_amdgcn_readfirstlane(tid >> 6), lane = tid & 63, wr = wid >> 2, wc = wid & 3, fr = lane & 15, fq = lane >> 4;
    const int K = g.ld, nt = g.K / BK;
    unsigned voffA[2], voffB[2]; int RA[2], CA[2];
#pragma unroll
    for (int i = 0; i < 2; ++i) { int R, C; stage_rc(tid * 16 + i * 8192, R, C); RA[i] = R; CA[i] = C; const int Rb = Epi::PERM ? ((R & ~31) + perm32(R & 31)) : R;
        voffA[i] = (unsigned)(R * K + C) * 2u; voffB[i] = (unsigned)(Rb * K + C) * 2u; }
    const size_t kstep = (size_t)(BK * 2);
    const size_t hstep = (size_t)HALF * K * 2;
    const size_t tstep = 2 * hstep;
    const size_t hstepA = Sched::GATHER ? 0 : hstep;
    unsigned cvo[2][2], nvo[2][2];
#pragma unroll
    for (int h_ = 0; h_ < 2; ++h_)
#pragma unroll
        for (int i = 0; i < 2; ++i) { cvo[h_][i] = voffA[i]; nvo[h_][i] = voffA[i]; }
    const unsigned ldsw = (unsigned)wid * 1024u;
    const int aoff = lds_byte(wr * 64 + fr, fq * 8), boff = lds_byte(wc * 32 + fr, fq * 8);
#define PG8_SA(b, h) (((b) * 2 + (h)) * HTB)
#define PG8_SB(b, h) ((4 + (b) * 2 + (h)) * HTB)
#define PG8_STAGE(bufoff, gbase, voff) do { _Pragma("unroll") for (int _i = 0; _i < 2; ++_i) \
        __builtin_amdgcn_global_load_lds((const unsigned*)((const char*)(gbase) + (voff)[_i]), (PG8_LAS unsigned*)(lds + (bufoff) + ldsw + _i * 8192), 16, 0, 0); } while (0)
#define PG8_LDA(dst, b, h) do { _Pragma("unroll") for (int m = 0; m < 4; ++m) _Pragma("unroll") for (int k = 0; k < 2; ++k) dst[m][k] = *(const PG8_LAS bf16x8*)(lds + PG8_SA(b, h) + aoff + m * 2048 + k * 1024); } while (0)
#define PG8_LDB(dst, b, h) do { _Pragma("unroll") for (int n = 0; n < 2; ++n) _Pragma("unroll") for (int k = 0; k < 2; ++k) dst[n][k] = *(const PG8_LAS bf16x8*)(lds + PG8_SB(b, h) + boff + n * 2048 + k * 1024); } while (0)
#define PG8_MMA(ai, bj, At, Bt) do { __builtin_amdgcn_s_setprio(1); _Pragma("unroll") for (int m = 0; m < 4; ++m) _Pragma("unroll") for (int n = 0; n < 2; ++n) _Pragma("unroll") for (int k = 0; k < 2; ++k) \
        acc[ai][bj][m][n] = __builtin_amdgcn_mfma_f32_16x16x32_bf16(Bt[n][k], At[m][k], acc[ai][bj][m][n], 0, 0, 0); __builtin_amdgcn_s_setprio(0); } while (0)
#define PG8_WAIT_V(n) asm volatile("s_waitcnt vmcnt(" #n ")" ::: "memory")
#define PG8_WAIT_L(n) asm volatile("s_waitcnt lgkmcnt(" #n ")" ::: "memory")
#define PG8_BAR __builtin_amdgcn_s_barrier()
#define PG8_SCHED __builtin_amdgcn_sched_barrier(0)
    Unit cur, nxt; int ui = 0;
    if (!S.next(0, cur)) return;
    f32x4 acc[2][2][4][2];
#pragma unroll
    for (int a = 0; a < 2; ++a)
#pragma unroll
        for (int b = 0; b < 2; ++b)
#pragma unroll
            for (int m = 0; m < 4; ++m)
#pragma unroll
                for (int n = 0; n < 2; ++n) acc[a][b][m][n] = (f32x4){0.f, 0.f, 0.f, 0.f};
    bf16x8 At[4][2], B0[2][2], B1[2][2];
    const char* cA = S.aptr(g, cur, tstep); const char* cB = S.bptr(g, cur, tstep);
    S.a_ready(cur);
    if constexpr (Sched::GATHER) S.rowoffs(g, cur, RA, CA, cvo);
    if constexpr (SP2) {
        PG8_STAGE(PG8_SB(0, 0), cB, voffB); PG8_STAGE(PG8_SB(0, 1), cB + hstep, voffB); PG8_STAGE(PG8_SA(0, 0), cA, cvo[0]); PG8_STAGE(PG8_SA(0, 1), cA + hstepA, cvo[1]);
        if (wr == 1) PG8_BAR;
        PG8_WAIT_V(2); PG8_BAR;
        PG8_STAGE(PG8_SB(1, 0), cB + kstep, voffB); PG8_STAGE(PG8_SA(1, 0), cA + kstep, cvo[0]); PG8_STAGE(PG8_SB(1, 1), cB + hstep + kstep, voffB);
        PG8_WAIT_V(6); PG8_BAR;
    } else {
        PG8_STAGE(PG8_SB(0, 0), cB, voffB); PG8_STAGE(PG8_SA(0, 0), cA, cvo[0]); PG8_STAGE(PG8_SB(0, 1), cB + hstep, voffB); PG8_STAGE(PG8_SA(0, 1), cA + hstepA, cvo[1]);
        if (wr == 1) PG8_BAR;
        PG8_WAIT_V(4); PG8_BAR;
        PG8_STAGE(PG8_SB(1, 0), cB + kstep, voffB); PG8_STAGE(PG8_SA(1, 0), cA + kstep, cvo[0]); PG8_STAGE(PG8_SB(1, 1), cB + hstep + kstep, voffB);
        PG8_WAIT_V(6); PG8_BAR;
    }
    for (;;) {
        const bool has_next = S.next(ui + 1, nxt);
        const char* nA = has_next ? S.aptr(g, nxt, tstep) : cA; const char* nB = has_next ? S.bptr(g, nxt, tstep) : cB;
        if constexpr (Sched::GATHER) { if (has_next) S.rowoffs(g, nxt, RA, CA, nvo); }
        for (int t = 0; t < nt; t += 2) {
            const bool last = (t == nt - 2);
            const char* a1 = cA + (size_t)(t + 1) * kstep;
            const char* a2 = last ? nA : cA + (size_t)(t + 2) * kstep; const char* b2 = last ? nB : cB + (size_t)(t + 2) * kstep;
            const char* a3 = a2 + kstep; const char* b3 = b2 + kstep;
            if (last && has_next) S.a_ready(nxt);
            const bool nx_ = Sched::GATHER && last && has_next;
            const unsigned v0s[2] = {nx_ ? nvo[0][0] : cvo[0][0], nx_ ? nvo[0][1] : cvo[0][1]}, v1s[2] = {nx_ ? nvo[1][0] : cvo[1][0], nx_ ? nvo[1][1] : cvo[1][1]};
            if constexpr (SP2) {
            PG8_LDB(B0, 0, 0); PG8_LDB(B1, 0, 1); PG8_SCHED; PG8_LDA(At, 0, 0); PG8_STAGE(PG8_SA(1, 1), a1 + hstepA, cvo[1]);
            PG8_WAIT_V(8); PG8_WAIT_L(0); PG8_BAR; PG8_MMA(0, 0, At, B0); PG8_MMA(0, 1, At, B1); PG8_BAR; PG8_SCHED;
            PG8_LDA(At, 0, 1); PG8_STAGE(PG8_SB(0, 0), b2, voffB); PG8_STAGE(PG8_SB(0, 1), b2 + hstep, voffB); PG8_STAGE(PG8_SA(0, 0), a2, v0s);
            PG8_WAIT_V(8); PG8_WAIT_L(0); PG8_BAR; PG8_MMA(1, 0, At, B0); PG8_MMA(1, 1, At, B1); PG8_BAR; PG8_SCHED;
            PG8_LDB(B0, 1, 0); PG8_LDB(B1, 1, 1); PG8_SCHED; PG8_LDA(At, 1, 0); PG8_STAGE(PG8_SA(0, 1), a2 + hstepA, v1s);
            PG8_WAIT_V(8); PG8_WAIT_L(0); PG8_BAR; PG8_MMA(0, 0, At, B0); PG8_MMA(0, 1, At, B1); PG8_BAR; PG8_SCHED;
            PG8_LDA(At, 1, 1); PG8_STAGE(PG8_SB(1, 0), b3, voffB); PG8_STAGE(PG8_SB(1, 1), b3 + hstep, voffB); PG8_STAGE(PG8_SA(1, 0), a3, v0s);
            PG8_WAIT_V(8); PG8_WAIT_L(0); PG8_BAR; PG8_MMA(1, 0, At, B0); PG8_MMA(1, 1, At, B1); PG8_BAR; PG8_SCHED;
            } else {
            PG8_LDB(B0, 0, 0); PG8_SCHED; PG8_LDA(At, 0, 0); PG8_STAGE(PG8_SA(1, 1), a1 + hstepA, cvo[1]);
            PG8_WAIT_L(8); PG8_BAR; PG8_WAIT_L(0); PG8_MMA(0, 0, At, B0); PG8_BAR; PG8_SCHED;
            PG8_LDB(B1, 0, 1); PG8_STAGE(PG8_SB(0, 0), b2, voffB);
            PG8_BAR; PG8_WAIT_L(0); PG8_MMA(0, 1, At, B1); PG8_BAR;
            PG8_LDA(At, 0, 1); PG8_STAGE(PG8_SA(0, 0), a2, v0s);
            PG8_BAR; PG8_WAIT_L(0); PG8_MMA(1, 0, At, B0); PG8_BAR; PG8_SCHED;
            PG8_STAGE(PG8_SB(0, 1), b2 + hstep, voffB);
            PG8_WAIT_V(6); PG8_BAR; PG8_MMA(1, 1, At, B1); PG8_BAR;
            PG8_LDB(B0, 1, 0); PG8_SCHED; PG8_LDA(At, 1, 0); PG8_STAGE(PG8_SA(0, 1), a2 + hstepA, v1s);
            PG8_WAIT_L(8); PG8_BAR; PG8_WAIT_L(0); PG8_MMA(0, 0, At, B0); PG8_BAR; PG8_SCHED;
            PG8_LDB(B1, 1, 1); PG8_STAGE(PG8_SB(1, 0), b3, voffB);
            PG8_BAR; PG8_WAIT_L(0); PG8_MMA(0, 1, At, B1); PG8_BAR;
            PG8_LDA(At, 1, 1); PG8_STAGE(PG8_SA(1, 0), a3, v0s);
            PG8_BAR; PG8_WAIT_L(0); PG8_MMA(1, 0, At, B0); PG8_BAR; PG8_SCHED;
            PG8_STAGE(PG8_SB(1, 1), b3 + hstep, voffB);
            PG8_WAIT_V(6); PG8_BAR; PG8_MMA(1, 1, At, B1); PG8_BAR;
            }
        }
        if constexpr (ALIGN_EPI) { if (wr == 0) PG8_BAR; }
        if constexpr (!Epi::AFTER_DRAIN) { E(acc, cur, wr, wc, fr, fq); S.done(cur); }
        if (!has_next) break;
#pragma unroll
        for (int a = 0; a < 2; ++a)
#pragma unroll
            for (int b = 0; b < 2; ++b)
#pragma unroll
                for (int m = 0; m < 4; ++m)
#pragma unroll
                    for (int n = 0; n < 2; ++n) acc[a][b][m][n] = (f32x4){0.f, 0.f, 0.f, 0.f};
        cur = nxt; cA = nA; cB = nB; ++ui;
#pragma unroll
        for (int h_ = 0; h_ < 2; ++h_)
#pragma unroll
            for (int i = 0; i < 2; ++i) cvo[h_][i] = nvo[h_][i];
        if constexpr (ALIGN_EPI) { if (wr == 1) PG8_BAR; }
    }
    PG8_WAIT_V(0);
    if constexpr (!ALIGN_EPI) { if (wr == 0) PG8_BAR; }
    PG8_BAR;
    if constexpr (Epi::AFTER_DRAIN) { E.fused(acc, cur, wr, wc, fr, fq, lds, wid, lane); S.done(cur); }
#undef PG8_SA
#undef PG8_SB
#undef PG8_STAGE
#undef PG8_LDA
#undef PG8_LDB
#undef PG8_MMA
#undef PG8_WAIT_V
#undef PG8_WAIT_L
#undef PG8_BAR
#undef PG8_SCHED
}
}


#define PG8_SP2 true
#define PG8_ALIGN true
#include <hip/hip_bf16.h>
#include <cmath>
namespace attn_body {
using bf16=__hip_bfloat16;
using bf16x8=__attribute__((ext_vector_type(8)))short;
using s16x4=__attribute__((ext_vector_type(4)))short;
using f32x16=__attribute__((ext_vector_type(16)))float;
using u32x4=__attribute__((ext_vector_type(4)))unsigned;
constexpr int BATCH=2,NHEAD=16,SEQ=4096,D=64,DM=6656,DMO=1024;
constexpr int NW=8,QBLK=32,QB=QBLK*NW,KVBLK=64,NQB=SEQ/QB;
constexpr int ATTN_PITCH=DM, ATTN_UNIT_ROWS=QB;
__device__ __forceinline__ int crow(int r,int hi){return (r&3)+8*(r>>2)+4*hi;}
#define SBAR() __builtin_amdgcn_sched_barrier(0)
__device__ __forceinline__ void cmask(f32x16&p0,f32x16&p1,int jb,int qrel,int hi){
  const float NEG=-INFINITY; int kb=64*jb+4*hi;
  #pragma unroll
  for(int r=0;r<16;++r){int kv=kb+(r&3)+8*(r>>2); if(kv>qrel)p0[r]=NEG; if(kv+32>qrel)p1[r]=NEG;}
}

constexpr int NSLOT=3, SLOTB=8192;
constexpr int LDS_K=0, LDS_V=NSLOT*SLOTB, LDS_WS=2*NSLOT*SLOTB, LDS_OST=LDS_WS+NW*64*4, LDS_BYTES=LDS_OST+NW*4096;
constexpr float C2=0.125f*1.4426950408889634f;
__device__ __forceinline__ void glds16(const void*gsrc,unsigned lds_dst){unsigned keep;
  asm volatile("s_mov_b32 %0, m0\n\ts_mov_b32 m0, %2\n\ts_nop 0\n\tglobal_load_lds_dwordx4 %1, off\n\ts_mov_b32 m0, %0":"=&s"(keep):"v"(gsrc),"s"(lds_dst):"memory");}
__device__ __forceinline__ float max3f(float a,float b,float c){float r;asm("v_max3_f32 %0, %1, %2, %3":"=v"(r):"v"(a),"v"(b),"v"(c));return r;}
__device__ __forceinline__ float max2f(float a,float b){float r;asm("v_max_f32_e32 %0, %1, %2":"=v"(r):"v"(a),"v"(b));return r;}
__device__ __forceinline__ float fadd_s(float a,float b){float r;asm("v_add_f32_e32 %0, %1, %2":"=v"(r):"v"(a),"v"(b));return r;}
__device__ __forceinline__ float fsub_s(float a,float b){float r;asm("v_sub_f32_e32 %0, %1, %2":"=v"(r):"v"(a),"v"(b));return r;}
typedef float f32x2_t __attribute__((ext_vector_type(2))); typedef __bf16 bf16x2_t __attribute__((ext_vector_type(2)));
__device__ __forceinline__ unsigned cvtpk_s(float lo,float hi){f32x2_t v={lo,hi};bf16x2_t b=__builtin_convertvector(v,bf16x2_t);return __builtin_bit_cast(unsigned,b);}
#define WAIT_BAR(N) asm volatile("s_waitcnt vmcnt(" #N ") lgkmcnt(0)\n\ts_barrier":::"memory")

__device__ __forceinline__ void qkt(f32x16&p0,f32x16&p1,const char*Kslot,const bf16x8*qr,const f32x16&negm,int r32,int hi){
  const char*kb=Kslot+hi*1024+r32*16;
  #pragma unroll
  for(int d0=0;d0<4;++d0){
    const bf16x8 b0=*reinterpret_cast<const bf16x8*>(kb+d0*2048);
    const bf16x8 b1=*reinterpret_cast<const bf16x8*>(kb+d0*2048+512);
    if(d0==0){p0=__builtin_amdgcn_mfma_f32_32x32x16_bf16(b0,qr[0],negm,0,0,0);p1=__builtin_amdgcn_mfma_f32_32x32x16_bf16(b1,qr[0],negm,0,0,0);}
    else{p0=__builtin_amdgcn_mfma_f32_32x32x16_bf16(b0,qr[d0],p0,0,0,0);p1=__builtin_amdgcn_mfma_f32_32x32x16_bf16(b1,qr[d0],p1,0,0,0);}}
}
typedef __attribute__((address_space(3))) const char* lds_cptr;
typedef short v4i16_t __attribute__((ext_vector_type(4)));
__device__ __forceinline__ void kload8(bf16x8*kf,lds_cptr kp){
  kf[0]=*(const __attribute__((address_space(3))) bf16x8*)(kp);      kf[1]=*(const __attribute__((address_space(3))) bf16x8*)(kp+512);
  kf[2]=*(const __attribute__((address_space(3))) bf16x8*)(kp+2048); kf[3]=*(const __attribute__((address_space(3))) bf16x8*)(kp+2560);
  kf[4]=*(const __attribute__((address_space(3))) bf16x8*)(kp+4096); kf[5]=*(const __attribute__((address_space(3))) bf16x8*)(kp+4608);
  kf[6]=*(const __attribute__((address_space(3))) bf16x8*)(kp+6144); kf[7]=*(const __attribute__((address_space(3))) bf16x8*)(kp+6656);
}
__device__ __forceinline__ void kload2(bf16x8*kf,lds_cptr kp,int j){ kf[2*j]=*(const __attribute__((address_space(3))) bf16x8*)(kp+j*2048); kf[2*j+1]=*(const __attribute__((address_space(3))) bf16x8*)(kp+j*2048+512); }
__device__ __forceinline__ s16x4 vtr(lds_cptr p){ return __builtin_bit_cast(s16x4,__builtin_amdgcn_ds_read_tr16_b64_v4i16((__attribute__((address_space(3))) v4i16_t*)p)); }
__device__ __forceinline__ float rowmax(const f32x16&p0,const f32x16&p1){
  float a=max3f(p0[0],p0[1],p1[0]),b=max3f(p0[2],p0[3],p1[1]);a=max3f(a,p1[2],p1[3]);
  #pragma unroll
  for(int r=4;r<16;r+=4){a=max3f(a,p0[r],p0[r+1]);b=max3f(b,p0[r+2],p0[r+3]);a=max3f(a,p1[r],p1[r+1]);b=max3f(b,p1[r+2],p1[r+3]);}
  const float m=max2f(a,b);
  auto rr=__builtin_amdgcn_permlane32_swap(__float_as_uint(m),__float_as_uint(m),false,false);
  return max2f(__uint_as_float(rr[0]),__uint_as_float(rr[1]));
}
__device__ __forceinline__ void pv(f32x16*o,int vb,bf16x8 pa0,bf16x8 pa1,bf16x8 pa2,bf16x8 pa3){
  #pragma unroll
  for(int d0=0;d0<2;++d0){s16x4 lo[4],hi[4];
    #pragma unroll
    for(int ks=0;ks<4;++ks){
      asm volatile("ds_read_b64_tr_b16 %0,%1 offset:%c2":"=&v"(lo[ks]):"v"(vb),"i"(d0*4096+ks*1024):"memory");
      asm volatile("ds_read_b64_tr_b16 %0,%1 offset:%c2":"=&v"(hi[ks]):"v"(vb),"i"(d0*4096+ks*1024+512):"memory");}
    asm volatile("s_waitcnt lgkmcnt(0)":::"memory");SBAR();
    #define PK(k) (bf16x8){lo[k][0],lo[k][1],lo[k][2],lo[k][3],hi[k][0],hi[k][1],hi[k][2],hi[k][3]}
    o[d0]=__builtin_amdgcn_mfma_f32_32x32x16_bf16(pa0,PK(0),o[d0],0,0,0);
    o[d0]=__builtin_amdgcn_mfma_f32_32x32x16_bf16(pa1,PK(1),o[d0],0,0,0);
    o[d0]=__builtin_amdgcn_mfma_f32_32x32x16_bf16(pa2,PK(2),o[d0],0,0,0);
    o[d0]=__builtin_amdgcn_mfma_f32_32x32x16_bf16(pa3,PK(3),o[d0],0,0,0);
    #undef PK
  }
}

#ifndef ATTN_STORE16
#define ATTN_STORE16(p,v) (*(u32x4*)(p)=(v))
#endif
template<int THRL> __device__ __forceinline__ void attn_unit(int b,int qb,const bf16*Q,const bf16*__restrict__ K,const bf16*__restrict__ V,bf16*O,char*shm){
  int tid_=threadIdx.x; asm volatile("":"+v"(tid_)); const int tid=tid_,lane=tid&63,r32=lane&31,hi=lane>>5; const int wid=__builtin_amdgcn_readfirstlane(tid>>6);
  const long rowbase=(long)b*SEQ; const int q0=qb*QB;
  const bf16*Qw=Q+(rowbase+q0+wid*QBLK)*DM;
  const bf16*Kh=K+rowbase*DM,*Vh=V+rowbase*DM;
  const unsigned lds0=(unsigned)(uintptr_t)shm;
  float*wsf=(float*)(shm+LDS_WS)+wid*64;
  const bf16*ksrc=Kh+(long)lane*DM+wid*8;
  const bf16*vsrc=Vh+(long)(16*(wid&3)+(lane>>2))*DM+(wid>>2)*32+(lane&3)*8;
  const unsigned kdst=lds0+LDS_K+wid*1024, vdst=lds0+LDS_V+wid*1024;
  #define DMA_K(t,slot) glds16(ksrc+(long)(t)*KVBLK*DM,(unsigned)__builtin_amdgcn_readfirstlane(kdst+(slot)))
  #define DMA_V(t,slot) glds16(vsrc+(long)(t)*KVBLK*DM,(unsigned)__builtin_amdgcn_readfirstlane(vdst+(slot)))
  const int vb0=(int)(lds0+LDS_V)+((lane>>4)&1)*32+(lane&3)*8+(4*hi+((lane&15)>>2))*64;
  const char*Kbase=shm+LDS_K; bf16x8 kf[8];
  const lds_cptr shm3=(lds_cptr)shm; const lds_cptr kp0=shm3+LDS_K+hi*1024+r32*16; const lds_cptr vp0=shm3+LDS_V+((lane>>4)&1)*32+(lane&3)*8+(4*hi+((lane&15)>>2))*64;
  const int NT=(q0+QB)/KVBLK;
  DMA_K(0,0);DMA_V(0,0);DMA_K(1,SLOTB);
  bf16x8 qr[4];
  #pragma unroll
  for(int d0=0;d0<4;++d0)qr[d0]=*reinterpret_cast<const bf16x8*>(&Qw[(long)r32*DM+d0*16+hi*8]);
  float mhat=0.f,l_reg=0.f;f32x16 o[2];o[0]=f32x16{};o[1]=f32x16{};f32x16 negm=f32x16{};asm volatile("":"+v"(negm));
  const int qrel=wid*QBLK+r32;
  #define CMASK(P0,P1,t) do{int jb_=(t)-(NT-4); if(jb_>=0)cmask(P0,P1,jb_,qrel,hi);}while(0)
  bool resc=false;
  #define START(P0,P1) do{ const float rm=rowmax(P0,P1); resc=false; \
    { const float dl=rm; mhat=fadd_s(mhat,dl); \
      _Pragma("unroll") for(int r=0;r<16;++r){P0[r]=fsub_s(P0[r],dl);P1[r]=fsub_s(P1[r],dl);} \
      _Pragma("unroll") for(int r=0;r<16;++r)negm[r]=-mhat; asm volatile("":"+v"(negm)); } \
    _Pragma("unroll") for(int r=0;r<16;++r)P0[r]=__builtin_amdgcn_exp2f(P0[r]); }while(0)
  #define RESC() do{ if(resc){ asm volatile("s_waitcnt lgkmcnt(0)":::"memory"); \
      _Pragma("unroll") for(int d_=0;d_<2;++d_) _Pragma("unroll") for(int r=0;r<16;++r)o[d_][r]*=wsf[crow(r,hi)]; } }while(0)
  f32x16 pA0,pA1,pB0,pB1;
  int sl_prev=0,sl_cur=0,sl_next=SLOTB;
  #define ROT() do{sl_prev=sl_cur;sl_cur=sl_next;sl_next=(sl_next==(NSLOT-1)*SLOTB)?0:sl_next+SLOTB;}while(0)
  DMA_K(2,2*SLOTB);
  WAIT_BAR(3);
  qkt(pA0,pA1,Kbase,qr,negm,r32,hi);asm volatile("s_nop 15\n\ts_nop 7":"+v"(pA0),"+v"(pA1));CMASK(pA0,pA1,0);
  START(pA0,pA1);
  _Pragma("unroll") for(int r=0;r<16;++r)pA1[r]=__builtin_amdgcn_exp2f(pA1[r]);
  WAIT_BAR(0);
  DMA_K(3,0);DMA_V(1,SLOTB);
  ROT();
  kload8(kf,kp0+sl_cur);
  WAIT_BAR(2);
  s16x4 vlo[8],vhi[8]; u32x4 pw0,pw1,pw2,pw3;
  #define PKW(P,B) cvtpk_s(P[B],P[B+1])
  #define PAF(k) __builtin_bit_cast(bf16x8,pw##k)
  #define VFR(i) (bf16x8){vlo[i][0],vlo[i][1],vlo[i][2],vlo[i][3],vhi[i][0],vhi[i][1],vhi[i][2],vhi[i][3]}
  #define PIN(x) asm volatile("":"+v"(x))
  #define MX3(a,b,c) __builtin_fmaxf(__builtin_fmaxf((a),(b)),(c))
  #define GAPA(MF,A0,A1,A2,A3,W0,W1,PW) do{ MF; sacc+=A0; sacc+=A1; sacc+=A2; sacc+=A3; PIN(sacc); W0; W1; PIN(PW); SBAR(); }while(0)
  #define EX(v) __builtin_amdgcn_exp2f(v)
  #define GAPB(MF,X,B) do{ MF; X[B]=EX(X[B]); X[B+1]=EX(X[B+1]); X[B+2]=EX(X[B+2]); X[B+3]=EX(X[B+3]); PIN(X); SBAR(); }while(0)
  #define VRD(i) do{ vlo[i]=vtr(vp_+(((i)>>2)*4096+((i)&3)*1024)); vhi[i]=vtr(vp_+(((i)>>2)*4096+((i)&3)*1024+512)); }while(0)
  #define KRD(G,j) do{ if(G){ kload2(kf,kp0+sl_next,j); SBAR(); } }while(0)
  #define STEP(C0,C1,P0,P1,t,GK,GV,GL) do{ SBAR(); \
    const lds_cptr vp_=vp0+sl_prev; \
    VRD(0); SBAR(); float sacc=(P0[0]+P0[1]); \
    GAPA(C0=__builtin_amdgcn_mfma_f32_32x32x16_bf16(kf[0],qr[0],negm,0,0,0), P0[2],P0[3],P0[4],P0[5],     pw0[0]=PKW(P0,0), pw0[1]=PKW(P0,2), pw0); \
    VRD(4); SBAR(); GAPA(C1=__builtin_amdgcn_mfma_f32_32x32x16_bf16(kf[1],qr[0],negm,0,0,0), P0[6],P0[7],P0[8],P0[9],     pw0[2]=PKW(P0,4), pw0[3]=PKW(P0,6), pw0); \
    VRD(1); SBAR(); GAPA(C0=__builtin_amdgcn_mfma_f32_32x32x16_bf16(kf[2],qr[1],C0,0,0,0),   P0[10],P0[11],P0[12],P0[13], pw1[0]=PKW(P0,8), pw1[1]=PKW(P0,10), pw1); \
    VRD(5); SBAR(); GAPA(C1=__builtin_amdgcn_mfma_f32_32x32x16_bf16(kf[3],qr[1],C1,0,0,0),   P0[14],P0[15],P1[0],P1[1],   pw1[2]=PKW(P0,12),pw1[3]=PKW(P0,14), pw1); \
    VRD(2); SBAR(); GAPA(C0=__builtin_amdgcn_mfma_f32_32x32x16_bf16(kf[4],qr[2],C0,0,0,0),   P1[2],P1[3],P1[4],P1[5],     pw2[0]=PKW(P1,0), pw2[1]=PKW(P1,2), pw2); \
    VRD(6); SBAR(); GAPA(C1=__builtin_amdgcn_mfma_f32_32x32x16_bf16(kf[5],qr[2],C1,0,0,0),   P1[6],P1[7],P1[8],P1[9],     pw2[2]=PKW(P1,4), pw2[3]=PKW(P1,6), pw2); \
    VRD(3); SBAR(); GAPA(C0=__builtin_amdgcn_mfma_f32_32x32x16_bf16(kf[6],qr[3],C0,0,0,0),   P1[10],P1[11],P1[12],P1[13], pw3[0]=PKW(P1,8), pw3[1]=PKW(P1,10), pw3); \
    VRD(7); SBAR(); GAPA(C1=__builtin_amdgcn_mfma_f32_32x32x16_bf16(kf[7],qr[3],C1,0,0,0),   P1[14],P1[15],0.f,0.f,       pw3[2]=PKW(P1,12),pw3[3]=PKW(P1,14), pw3); \
    l_reg+=sacc; \
    if(GK){DMA_K((t)+3,sl_cur);} if(GV){DMA_V((t)+1,sl_next);} \
    CMASK(C0,C1,t); \
    { float a=MX3(C0[0],C0[1],C1[0]),b=MX3(C0[2],C0[3],C1[1]); a=MX3(a,C1[2],C1[3]); \
      _Pragma("unroll") for(int r=4;r<16;r+=4){a=MX3(a,C0[r],C0[r+1]);b=MX3(b,C0[r+2],C0[r+3]);a=MX3(a,C1[r],C1[r+1]);b=MX3(b,C1[r+2],C1[r+3]);} \
      float rm=__builtin_fmaxf(a,b); { auto rr=__builtin_amdgcn_permlane32_swap(__float_as_uint(rm),__float_as_uint(rm),false,false); rm=__builtin_fmaxf(__uint_as_float(rr[0]),__uint_as_float(rr[1])); } \
      resc=false; \
      if(__builtin_expect(__any(rm>(float)THRL),0)){ const float dl=__builtin_fmaxf(rm,0.f); mhat+=dl; \
        _Pragma("unroll") for(int r=0;r<16;++r){C0[r]-=dl;C1[r]-=dl;} \
        _Pragma("unroll") for(int r=0;r<16;++r)negm[r]=-mhat; asm volatile("":"+v"(negm)); \
        const float f=__builtin_amdgcn_exp2f(-dl); l_reg*=f; if(hi==0)wsf[r32]=f; resc=true; } } \
    SBAR(); \
    GAPB(o[0]=__builtin_amdgcn_mfma_f32_32x32x16_bf16(PAF(0),VFR(0),o[0],0,0,0), C0,0); \
    GAPB(o[1]=__builtin_amdgcn_mfma_f32_32x32x16_bf16(PAF(0),VFR(4),o[1],0,0,0), C0,4); \
    KRD(GL,0); GAPB(o[0]=__builtin_amdgcn_mfma_f32_32x32x16_bf16(PAF(1),VFR(1),o[0],0,0,0), C0,8); \
    KRD(GL,1); GAPB(o[1]=__builtin_amdgcn_mfma_f32_32x32x16_bf16(PAF(1),VFR(5),o[1],0,0,0), C0,12); \
    KRD(GL,2); GAPB(o[0]=__builtin_amdgcn_mfma_f32_32x32x16_bf16(PAF(2),VFR(2),o[0],0,0,0), C1,0); \
    KRD(GL,3); GAPB(o[1]=__builtin_amdgcn_mfma_f32_32x32x16_bf16(PAF(2),VFR(6),o[1],0,0,0), C1,4); \
    GAPB(o[0]=__builtin_amdgcn_mfma_f32_32x32x16_bf16(PAF(3),VFR(3),o[0],0,0,0), C1,8); \
    GAPB(o[1]=__builtin_amdgcn_mfma_f32_32x32x16_bf16(PAF(3),VFR(7),o[1],0,0,0), C1,12); \
    }while(0)
  int t=1;
  #undef CMASK
  #define CMASK(P0,P1,t) do{}while(0)
  for(;t+5<NT;t+=2){
    STEP(pB0,pB1,pA0,pA1,t,true,true,true);     WAIT_BAR(2); RESC(); ROT();
    STEP(pA0,pA1,pB0,pB1,t+1,true,true,true);   WAIT_BAR(2); RESC(); ROT();
  }
  #undef CMASK
  #define CMASK(P0,P1,t) do{int jb_=(t)-(NT-4); if(jb_>=0)cmask(P0,P1,jb_,qrel,hi);}while(0)
  #define ENDW(tt) do{ if((tt)+3<NT){WAIT_BAR(2);} else if((tt)+2<NT){WAIT_BAR(1);} else {WAIT_BAR(0);} }while(0)
  for(;t+1<NT;t+=2){
    STEP(pB0,pB1,pA0,pA1,t,(t+3<NT),(t+1<NT),(t+1<NT));       ENDW(t);   RESC(); ROT();
    STEP(pA0,pA1,pB0,pB1,t+1,(t+4<NT),(t+2<NT),(t+2<NT));     ENDW(t+1); RESC(); ROT();
  }
  STEP(pB0,pB1,pA0,pA1,NT-1,false,false,false); RESC();
  { float sacc=pB0[0]+pB0[1]; _Pragma("unroll") for(int r=2;r<16;++r)sacc+=pB0[r]; _Pragma("unroll") for(int r=0;r<16;++r)sacc+=pB1[r]; l_reg+=sacc;
    pw0=(u32x4){PKW(pB0,0),PKW(pB0,2),PKW(pB0,4),PKW(pB0,6)};pw1=(u32x4){PKW(pB0,8),PKW(pB0,10),PKW(pB0,12),PKW(pB0,14)};pw2=(u32x4){PKW(pB1,0),PKW(pB1,2),PKW(pB1,4),PKW(pB1,6)};pw3=(u32x4){PKW(pB1,8),PKW(pB1,10),PKW(pB1,12),PKW(pB1,14)};
    SBAR(); pv(o,vb0+sl_cur,PAF(0),PAF(1),PAF(2),PAF(3)); }
  #undef PKW
  #undef PAF
  #undef VFR
  #undef PIN
  #undef MX3
  #undef GAPA
  #undef GAPB
  #undef EX
  #undef VRD
  #undef KRD
  #undef STEP
  #undef ENDW
  {auto rr=__builtin_amdgcn_permlane32_swap(__float_as_uint(l_reg),__float_as_uint(l_reg),false,false);l_reg=__uint_as_float(rr[0])+__uint_as_float(rr[1]);}
  if(hi==0)wsf[32+r32]=l_reg;asm volatile("s_waitcnt lgkmcnt(0)":::"memory");
  float rli[16];
  #pragma unroll
  for(int r=0;r<16;++r)rli[r]=__builtin_amdgcn_rcpf(wsf[32+crow(r,hi)]);
  bf16*Ow=O+(rowbase+q0+wid*QBLK)*DMO;
  { bf16*stg=(bf16*)(shm+LDS_OST)+wid*2048;
    #pragma unroll
    for(int r=0;r<16;++r){const int orow=crow(r,hi);
      #pragma unroll
      for(int d0=0;d0<2;++d0)stg[orow*64+d0*32+r32]=__float2bfloat16(o[d0][r]*rli[r]);}
    asm volatile("s_waitcnt lgkmcnt(0)":::"memory");
    #pragma unroll
    for(int i=0;i<4;++i){const int row=i*8+(lane>>3),ch=lane&7; const u32x4 v=*(const u32x4*)(stg+row*64+ch*8); ATTN_STORE16(Ow+(long)row*DMO+ch*8,v);} }
  asm volatile("s_waitcnt lgkmcnt(0)\n\ts_barrier":::"memory");
  #undef DMA_K
  #undef DMA_V
  #undef CMASK
  #undef START
  #undef RESC
  #undef ROT
}
constexpr int ATTN_LDS_BYTES=LDS_BYTES;
#undef SBAR
#undef WAIT_BAR
}


constexpr int NWAVES = 8;
constexpr int NB = 2, T = 4096, NTOK = NB * T, D = 2048, C = 1024, NH = 16, HD = 64;
constexpr int PPITCH = 6656;
constexpr int PC_R = 0, PC_K = 1024, PC_V = 2048, PC_L = 3072, PC_Q = 3584, PC_KA = 4608, PC_VA = 5632;
constexpr int LK = 384;
constexpr int NEXP = 32, DEXP = 512, RMAX = 24576;
constexpr int NPH_LAYER = 13, NPHASES = 1 + 2 * NPH_LAYER;

constexpr size_t MiB = 1u << 20, KiB = 1u << 10;
constexpr size_t WS_CTL = 0, CTL_ZERO_BYTES = 1 * MiB;
constexpr size_t WS_ROPE = 1 * MiB;
constexpr size_t WS_PART = WS_ROPE + 256 * KiB;
constexpr size_t WS_TOKE = WS_PART + 1 * MiB;
constexpr size_t WS_TOKW = WS_TOKE + 64 * KiB;
constexpr size_t WS_TOKR = WS_TOKW + 64 * KiB;
constexpr size_t WS_TOKS = WS_TOKR + 64 * KiB;
constexpr size_t WS_RSTD2 = WS_TOKS + 64 * KiB;
constexpr size_t WS_CNT = WS_RSTD2 + 32 * KiB;
constexpr size_t WS_SRS = WS_CNT + 32 * KiB;
constexpr size_t WS_SWT = WS_SRS + 96 * KiB;
constexpr size_t WS_BONUS = WS_SWT + 96 * KiB;
constexpr size_t WS_RSTD1 = WS_BONUS + 512 * KiB;
constexpr size_t WS_RW = WS_RSTD1 + 32 * KiB;
constexpr size_t WS_SMALL_END = WS_RW + 576 * KiB;
static_assert(WS_SMALL_END <= 4 * MiB, "small tables");
constexpr size_t WS_HBA = 4 * MiB, WS_HBB = WS_HBA + 32 * MiB;
constexpr size_t WS_VFIRST = WS_HBB + 32 * MiB;
constexpr size_t WS_PB = WS_VFIRST + 32 * MiB;
constexpr size_t WS_WIN = WS_PB + 8 * MiB;
constexpr size_t WS_WOUT = WS_WIN + 52 * MiB;
constexpr size_t WS_WPG = WS_WOUT + 16 * MiB;
constexpr size_t WS_WPP = WS_WPG + 16 * MiB;
constexpr size_t WS_WL2 = WS_WPP + 2 * MiB;
constexpr size_t WS_WGU = WS_WL2 + 6 * MiB;
constexpr size_t WS_WD = WS_WGU + 128 * MiB;
constexpr size_t WS_PROJ = WS_WD + 64 * MiB;
constexpr size_t WS_LORAA = WS_PROJ + 104 * MiB;
constexpr size_t WS_LORAO = WS_LORAA + 6 * MiB;
constexpr size_t WS_OB = WS_LORAO + 64 * MiB;
constexpr size_t WS_CONCAT = WS_OB + 32 * MiB;
constexpr size_t WS_PPB = WS_CONCAT + 32 * MiB;
constexpr size_t WS_SCAN = WS_PPB + 32 * MiB;
constexpr size_t WS_Y = WS_SCAN + 192 * MiB;
constexpr size_t WS_ASORT = WS_SCAN;
constexpr size_t WS_HG = WS_ASORT + 96 * MiB;
constexpr size_t WS_OSLOT = WS_HG + 24 * MiB;
constexpr size_t WS_TPS = WS_SCAN + 224 * MiB;
constexpr size_t WS_END = WS_TPS + 32 * MiB;
constexpr size_t WS_TPQ0 = WS_PPB, WS_TPQ1 = WS_PPB;
constexpr size_t WS_SCIN0 = WS_SCAN, WS_SCIN1 = WS_SCAN;
constexpr size_t WS_SV = WS_SCAN + 160 * MiB;
constexpr size_t WS_TPP = WS_CONCAT, WS_TPZ = WS_CONCAT + 16 * MiB;
static_assert(WS_OSLOT + 96 * MiB <= WS_TPS, "MoE overlay fits the scan region");
constexpr int CW_BAR = 4096;
constexpr size_t WS_SLOTTOK = 640 * KiB;


constexpr int RING_OFF = 0, RING_BYTES = 131072;
constexpr int LDSCTL_OFF = RING_BYTES, MISC_OFF = LDSCTL_OFF + 320;
constexpr int L1FLAG_OFF = LDSCTL_OFF + 512;
constexpr int RSTAB_OFF = LDSCTL_OFF + 8192;
constexpr int META_OFF = LDSCTL_OFF + 1024;
constexpr int LDS_BYTES = 147456;
static_assert(attn_body::ATTN_LDS_BYTES <= RING_BYTES, "attention scratch fits the ring");

#define GAS __attribute__((address_space(1)))
#define LAS __attribute__((address_space(3)))
typedef unsigned short bf16;
typedef unsigned v4u __attribute__((ext_vector_type(4)));
typedef unsigned v2u __attribute__((ext_vector_type(2)));
typedef float f32x4 __attribute__((ext_vector_type(4)));
typedef GAS unsigned gu32;
#define RLX_AGENT __ATOMIC_RELAXED, __HIP_MEMORY_SCOPE_AGENT
#define LDS_WAIT() asm volatile("s_waitcnt lgkmcnt(0)" ::: "memory")
__device__ __forceinline__ unsigned f2bf(float f) { unsigned u = __builtin_bit_cast(unsigned, f); return (u + 0x7fffu + ((u >> 16) & 1u)) >> 16; }
__device__ __forceinline__ unsigned pk2(float lo, float hi) { return f2bf(lo) | (f2bf(hi) << 16); }
__device__ __forceinline__ float bflo(unsigned u) { return __builtin_bit_cast(float, u << 16); }
__device__ __forceinline__ float bfhi(unsigned u) { return __builtin_bit_cast(float, u & 0xffff0000u); }
__device__ __forceinline__ float sigmoidf_(float x) { return 1.0f / (1.0f + __expf(-x)); }

#define XB_TMO      128
#define XB_XCNT(j)  (256  + 64 * (j))
#define XB_XSUB(j)  (1280 + 64 * (j))
#define XB_XGEN(j)  (2304 + 64 * (j))
#define XB_TOP      3328
#define XB_TOPGEN   3392
#define XCD_BAR_WORDS 3456
#define XB_SPIN_CAP (1u << 18)

__device__ __forceinline__ unsigned xb_ld(unsigned* p)              { return __hip_atomic_load(p, __ATOMIC_RELAXED, __HIP_MEMORY_SCOPE_AGENT); }
__device__ __forceinline__ unsigned xb_add(unsigned* p, unsigned v) { return __hip_atomic_fetch_add(p, v, __ATOMIC_RELAXED, __HIP_MEMORY_SCOPE_AGENT); }
__device__ __forceinline__ unsigned xb_xcc_id() { return (unsigned)__builtin_amdgcn_s_getreg((3 << 11) | 20) & 0xFu; }
#define XB_SPIN(cond, bar) do { unsigned _sp = 0; while (cond) { __builtin_amdgcn_s_sleep(1); \
    if ((++_sp & 255u) == 0u) { if (xb_ld(&(bar)[XB_TMO])) break; if (_sp > XB_SPIN_CAP) { atomicAdd(&(bar)[XB_TMO], 1u); break; } } } } while (0)

struct XcdBarrier {
    unsigned* bar; unsigned x;
    volatile LAS unsigned* st;
};

__device__ __forceinline__ XcdBarrier xcd_barrier_post(unsigned* bar, volatile LAS unsigned* st) {
    XcdBarrier b; b.bar = bar; b.x = xb_xcc_id(); b.st = st;
    if (threadIdx.x == 0) (void)xb_add(&bar[XB_XCNT(b.x)], 1u);
    return b;
}
__device__ __forceinline__ void xcd_barrier_complete(unsigned* bar, unsigned x, unsigned& nloc, unsigned& nx) {
    const unsigned G = gridDim.x * gridDim.y * gridDim.z;
    unsigned sum, cnt, mine, sp = 0u;
    for (;;) {
        sum = 0u; cnt = 0u; mine = 0u;
#pragma unroll
        for (unsigned j = 0; j < 16; ++j) { const unsigned c = xb_ld(&bar[XB_XCNT(j)]); sum += c; cnt += (c > 0u) ? 1u : 0u; mine = (j == x) ? c : mine; }
        if (sum == G) break;
        __builtin_amdgcn_s_sleep(1);
        if ((++sp & 255u) == 0u) { if (xb_ld(&bar[XB_TMO])) break; if (sp > XB_SPIN_CAP) { atomicAdd(&bar[XB_TMO], 1u); break; } }
    }
    nloc = mine > 0u ? mine : 1u; nx = cnt > 0u ? cnt : 1u;
}

__device__ __forceinline__ void xcd_barrier(const XcdBarrier& b) {
    asm volatile("s_waitcnt vmcnt(0)" ::: "memory");
    __syncthreads();
    if (threadIdx.x == 0) {
        unsigned* bar = b.bar;
        __builtin_amdgcn_s_waitcnt(0);
        unsigned nloc = b.st[0], nx = b.st[1];
        if (nloc == 0u) { xcd_barrier_complete(bar, b.x, nloc, nx); b.st[0] = nloc; b.st[1] = nx; }
        const unsigned old = xb_add(&bar[XB_XSUB(b.x)], 1u);
        const unsigned gen = old / nloc;
        if (old + 1u == (gen + 1u) * nloc) {
            __builtin_amdgcn_fence(__ATOMIC_RELEASE, "agent");
            asm volatile("s_waitcnt vmcnt(0)" ::: "memory");
            const unsigned og = xb_add(&bar[XB_TOP], 1u);
            const unsigned tg = og / nx;
            if (og + 1u == (tg + 1u) * nx) xb_add(&bar[XB_TOPGEN], 1u);
            else XB_SPIN(xb_ld(&bar[XB_TOPGEN]) == tg, bar);
            __builtin_amdgcn_fence(__ATOMIC_ACQUIRE, "agent");
            xb_add(&bar[XB_XGEN(b.x)], 1u);
            asm volatile("s_waitcnt vmcnt(0)" ::: "memory");
        } else {
            XB_SPIN(xb_ld(&bar[XB_XGEN(b.x)]) == gen, bar);
            __builtin_amdgcn_fence(__ATOMIC_ACQUIRE, "agent");
            asm volatile("s_waitcnt vmcnt(0)" ::: "memory");
        }
    }
    __syncthreads();
}


__device__ __forceinline__ int fresh_tid() { int t = threadIdx.x; asm volatile("" : "+v"(t)); return t; }
struct Frame {
    LAS unsigned char* lds;
    int tid, lane, wave, vcu, G;
    unsigned char* ws;
};
extern __shared__ __attribute__((aligned(16))) unsigned char lds_dyn[];
__device__ __forceinline__ Frame mk_frame(unsigned char* ws) {
    Frame F; F.lds = (LAS unsigned char*)lds_dyn; F.tid = fresh_tid(); F.lane = F.tid & 63; F.wave = __builtin_amdgcn_readfirstlane(F.tid >> 6);
    F.G = gridDim.x; { const int bx = blockIdx.x; F.vcu = (F.G % 8 == 0) ? (bx % 8) * (F.G / 8) + bx / 8 : bx; }
    F.ws = ws; return F;
}
template <int CTRL, int RM> __device__ __forceinline__ float dpp_get(float v) { return __int_as_float(__builtin_amdgcn_update_dpp(0, __float_as_int(v), CTRL, RM, 0xf, false)); }
__device__ __forceinline__ float wave_total63(float v) {
    v += dpp_get<0xB1, 0xf>(v);
    v += dpp_get<0x4E, 0xf>(v);
    v += dpp_get<0x141, 0xf>(v);
    v += dpp_get<0x140, 0xf>(v);
    v += dpp_get<0x142, 0xa>(v);
    v += dpp_get<0x143, 0xc>(v);
    return v;
}
__device__ __forceinline__ float wave_bcast63(float v) { return __int_as_float(__builtin_amdgcn_readlane(__float_as_int(v), 63)); }
__device__ __forceinline__ float red16(float v) { v += __shfl_xor(v, 1); v += __shfl_xor(v, 2); v += __shfl_xor(v, 4); v += __shfl_xor(v, 8); return v; }
__device__ __forceinline__ float red32(float v) { v = red16(v); v += __shfl_xor(v, 16); return v; }
__device__ __forceinline__ float red64(float v) { v = red32(v); v += __shfl_xor(v, 32); return v; }

struct ConvItem { const float* W; bf16* WT; const float* gain; int ldw, k0, n0, n_end, Kd, split, shift0, shift1, map; };
__device__ __forceinline__ void conv_load(const ConvItem& p, int lane, f32x4 (&v)[16]) {
    const int kq = lane >> 4, nq = lane & 15, n = p.n0 + nq * 4;
    if (n < p.n_end) { const float* src = p.W + (size_t)(p.k0 + kq * 16) * p.ldw + n;
#pragma unroll
        for (int i = 0; i < 16; ++i) v[i] = *(const f32x4*)(src + (size_t)i * p.ldw); }
}
__device__ __forceinline__ void conv_store(const ConvItem& p, int lane, f32x4 (&v)[16]) {
    const int kq = lane >> 4, nq = lane & 15, n = p.n0 + nq * 4;
    if (n >= p.n_end) return;
    if (p.gain) { const f32x4* gp = (const f32x4*)(p.gain + p.k0 + kq * 16);
#pragma unroll
        for (int i4 = 0; i4 < 4; ++i4) { const f32x4 g = gp[i4];
#pragma unroll
            for (int e = 0; e < 4; ++e) v[4 * i4 + e] = v[4 * i4 + e] * g[e]; } }
#pragma unroll
    for (int e = 0; e < 4; ++e) { const int nn = n + e; const int dr = (p.map == 0) ? nn + ((nn >= p.split) ? p.shift1 : p.shift0) : ((nn >> 7) * 256 + p.shift0 + (nn & 127));
        GAS v4u* dst = (GAS v4u*)(p.WT + (size_t)dr * p.Kd + p.k0 + kq * 16);
        dst[0] = (v4u){pk2(v[0][e], v[1][e]), pk2(v[2][e], v[3][e]), pk2(v[4][e], v[5][e]), pk2(v[6][e], v[7][e])};
        dst[1] = (v4u){pk2(v[8][e], v[9][e]), pk2(v[10][e], v[11][e]), pk2(v[12][e], v[13][e]), pk2(v[14][e], v[15][e])}; }
}
__device__ __forceinline__ void conv_half(const ConvItem& p, int lane, int hf) {
    const int kq = lane >> 4, nq = lane & 15, n = p.n0 + nq * 4;
    if (n >= p.n_end) return;
    const float* src = p.W + (size_t)(p.k0 + kq * 16 + 8 * hf) * p.ldw + n; f32x4 v[8];
#pragma unroll
    for (int i = 0; i < 8; ++i) v[i] = *(const f32x4*)(src + (size_t)i * p.ldw);
    if (p.gain) { const f32x4* gp = (const f32x4*)(p.gain + p.k0 + kq * 16 + 8 * hf);
#pragma unroll
        for (int i4 = 0; i4 < 2; ++i4) { const f32x4 g = gp[i4];
#pragma unroll
            for (int e = 0; e < 4; ++e) v[4 * i4 + e] = v[4 * i4 + e] * g[e]; } }
#pragma unroll
    for (int e = 0; e < 4; ++e) { const int nn = n + e; const int dr = (p.map == 0) ? nn + ((nn >= p.split) ? p.shift1 : p.shift0) : ((nn >> 7) * 256 + p.shift0 + (nn & 127));
        *(GAS v4u*)(p.WT + (size_t)dr * p.Kd + p.k0 + kq * 16 + 8 * hf) = (v4u){pk2(v[0][e], v[1][e]), pk2(v[2][e], v[3][e]), pk2(v[4][e], v[5][e]), pk2(v[6][e], v[7][e])}; }
}
__device__ __forceinline__ void conv_half_load(const ConvItem& p, int lane, int hf, f32x4 (&v)[8]) {
    const int kq = lane >> 4, nq = lane & 15, n = p.n0 + nq * 4;
    if (n < p.n_end) { const float* src = p.W + (size_t)(p.k0 + kq * 16 + 8 * hf) * p.ldw + n;
#pragma unroll
        for (int i = 0; i < 8; ++i) v[i] = *(const f32x4*)(src + (size_t)i * p.ldw); }
}
__device__ __forceinline__ void conv_half_store(const ConvItem& p, int lane, int hf, f32x4 (&v)[8]) {
    const int kq = lane >> 4, nq = lane & 15, n = p.n0 + nq * 4;
    if (n >= p.n_end) return;
    if (p.gain) { const f32x4* gp = (const f32x4*)(p.gain + p.k0 + kq * 16 + 8 * hf);
#pragma unroll
        for (int i4 = 0; i4 < 2; ++i4) { const f32x4 g = gp[i4];
#pragma unroll
            for (int e = 0; e < 4; ++e) v[4 * i4 + e] = v[4 * i4 + e] * g[e]; } }
#pragma unroll
    for (int e = 0; e < 4; ++e) { const int nn = n + e; const int dr = (p.map == 0) ? nn + ((nn >= p.split) ? p.shift1 : p.shift0) : ((nn >> 7) * 256 + p.shift0 + (nn & 127));
        *(GAS v4u*)(p.WT + (size_t)dr * p.Kd + p.k0 + kq * 16 + 8 * hf) = (v4u){pk2(v[0][e], v[1][e]), pk2(v[2][e], v[3][e]), pk2(v[4][e], v[5][e]), pk2(v[6][e], v[7][e])}; }
}
#define CONV_PIPELINE(NIT, GW, NGW_, MK) do { f32x4 va_[16], vb_[16]; ConvItem pa_, pb_; int it_ = (GW); \
    if (it_ < (NIT)) { pa_ = MK(it_); conv_load(pa_, F.lane, va_); } \
    for (; it_ < (NIT); it_ += 2 * (NGW_)) { const int i1_ = it_ + (NGW_), i2_ = it_ + 2 * (NGW_); \
        if (i1_ < (NIT)) { pb_ = MK(i1_); conv_load(pb_, F.lane, vb_); } \
        conv_store(pa_, F.lane, va_); \
        if (i2_ < (NIT)) { pa_ = MK(i2_); conv_load(pa_, F.lane, va_); } \
        if (i1_ < (NIT)) conv_store(pb_, F.lane, vb_); } } while (0)
__device__ __forceinline__ void conv_plain(Frame& F, const float* W, int ldw, int K, int n_lo, int n_hi, bf16* WT, int split, int shift0, int shift1, const float* gain, int gw, int NGW) {
    const int nblk = (n_hi - n_lo + 63) / 64, nit = (K / 64) * nblk;
#define MK_PLAIN(it) (ConvItem{W, WT, gain, ldw, 64 * ((it) / nblk), n_lo + 64 * ((it) % nblk), n_hi, K, split, shift0, shift1, 0})
    CONV_PIPELINE(nit, gw, NGW, MK_PLAIN);
#undef MK_PLAIN
}
__device__ __forceinline__ void zero_rows(Frame& F, bf16* WT, int K, int r0, int r1) {
    const size_t n16 = (size_t)(r1 - r0) * K / 8; GAS v4u* p = (GAS v4u*)(WT + (size_t)r0 * K);
    for (size_t i = (size_t)F.vcu * 512 + F.tid; i < n16; i += (size_t)F.G * 512) p[i] = (v4u){0u, 0u, 0u, 0u};
}
__device__ __forceinline__ ConvItem moe_item(int it, const float* wg, const float* wu, const float* wd, const float* gain, bf16* WGU, bf16* WD) {
    const int e = it / 768, r = it % 768;
    if (r < 512) { const int up = r >> 8, q = r & 255, kb = q >> 3, nb = q & 7;
        return ConvItem{(up ? wu : wg) + (size_t)e * 2048 * 512, WGU + (size_t)e * 1024 * 2048, gain, 512, 64 * kb, 64 * nb, 512, 2048, 0, up * 128, 0, 1}; }
    const int q = r - 512, kb = q >> 5, nb = q & 31;
    return ConvItem{wd + (size_t)e * 512 * 2048, WD + (size_t)e * 2048 * 512, nullptr, 2048, 64 * kb, 64 * nb, 2048, 512, 1 << 30, 0, 0, 0};
}
__device__ __forceinline__ void conv_moe(Frame& F, const float* wg, const float* wu, const float* wd, const float* gain, bf16* WGU, bf16* WD, int gw, int NGW) {
#define MK_MOE(it) moe_item((it), wg, wu, wd, gain, WGU, WD)
    CONV_PIPELINE(32 * 768, gw, NGW, MK_MOE);
#undef MK_MOE
}

struct Args { const float* in[38]; float* out; unsigned char* ws; int ph_lo, ph_hi; };
typedef const __attribute__((address_space(4))) Args* ArgP;
__device__ __forceinline__ ArgP get_args() { ArgP p = (ArgP)__builtin_amdgcn_kernarg_segment_ptr(); asm volatile("" : "+s"(p)); return p; }

__device__ __forceinline__ void p0_prologue(Frame& F, ArgP A) {
    unsigned char* ws = F.ws;
    const int gt = F.vcu * 512 + F.tid, NGT = F.G * 512;
    const int gw = F.vcu * NWAVES + F.wave, NGW = F.G * NWAVES;
    { float* rope = (float*)(ws + WS_ROPE);
      for (int i = gt; i < T * 8; i += NGT) { const int t = i >> 3, j = i & 7; const float inv = powf(500000.0f, -((float)(2 * j) / 16.0f)); const float ang = (float)t * inv;
          rope[t * 16 + j] = cosf(ang); rope[t * 16 + 8 + j] = sinf(ang); } }
    { const float* x = A->in[0]; bf16* hb = (bf16*)(ws + WS_HBA); float* part = (float*)(ws + WS_PART);
      for (int m = gw; m < NTOK; m += NGW) { const GAS f32x4* xr = (const GAS f32x4*)(x + (size_t)m * D); GAS v2u* o = (GAS v2u*)(hb + (size_t)m * D); float ss = 0.f;
#pragma unroll
          for (int j = 0; j < 8; ++j) { const f32x4 v = xr[F.lane + 64 * j]; ss += (v[0] * v[0] + v[1] * v[1]) + (v[2] * v[2] + v[3] * v[3]); o[F.lane + 64 * j] = (v2u){pk2(v[0], v[1]), pk2(v[2], v[3])}; }
          ss = red64(ss);
          if (F.lane < 32) part[(size_t)m * 32 + F.lane] = (F.lane == 0) ? ss : 0.f; } }
    { const GAS f32x4* p = (const GAS f32x4*)A->in[1]; GAS v2u* o = (GAS v2u*)(ws + WS_PB);
      for (int i = gt; i < 2 * NTOK * 256 / 4; i += NGT) { const f32x4 v = p[i]; o[i] = (v2u){pk2(v[0], v[1]), pk2(v[2], v[3])}; } }
    { float* rw = (float*)(ws + WS_RW);
      for (int i = gt; i < 2 * 36 * D; i += NGT) { const int l = i / (36 * D), r = i % (36 * D), row = r / D, k = r % D;
          const float w = (row < 32) ? A->in[30][((size_t)l * D + k) * 32 + row] : A->in[28][((size_t)l * D + k) * 4 + (row - 32)];
          rw[i] = w * A->in[3][l * D + k]; } }
    { bf16* wl2 = (bf16*)(ws + WS_WL2);
      for (int i = gt; i < 2 * 4096 * LK; i += NGT) { const int l = i / (4096 * LK), r = i % (4096 * LK), c = r / LK, j = r % LK, seg = c >> 10, cc = c & 1023; float v = 0.f;
          if (seg == 0 && j < 64) v = A->in[9][(size_t)l * 64 * 1024 + (size_t)j * 1024 + cc];
          else if (seg == 1 && j >= 64 && j < 128) v = A->in[11][(size_t)l * 64 * 1024 + (size_t)(j - 64) * 1024 + cc];
          else if (seg == 2 && j >= 128 && j < 288) v = A->in[12][(size_t)l * 160 * 1024 + (size_t)(j - 128) * 1024 + cc];
          else if (seg == 3 && j >= 288 && j < 320 && l == 1) v = A->in[14][(size_t)(j - 288) * 1024 + cc];
          wl2[i] = (bf16)f2bf(v); } }
    { bf16* w0 = (bf16*)(ws + WS_WIN);
      conv_plain(F, A->in[4], 6432, D, 0, 6432, w0, 3360, 0, 224, A->in[2], gw, NGW);
      zero_rows(F, w0, D, 3360, 3584); }
}

__device__ __forceinline__ void conv_deferred(Frame& F, ArgP A, int gw, int NGW) {
    unsigned char* ws = F.ws;
    { bf16* w1 = (bf16*)(ws + WS_WIN) + (size_t)PPITCH * D;
      conv_plain(F, A->in[5], 6464, D, 0, 6464, w1, 3392, 0, 192, A->in[2] + D, gw, NGW);
      const size_t n16 = (size_t)(3584 - 3392) * D / 8; GAS v4u* p = (GAS v4u*)(w1 + (size_t)3392 * D);
      for (size_t i = (size_t)gw * 64 + F.lane; i < n16; i += (size_t)NGW * 64) p[i] = (v4u){0u, 0u, 0u, 0u}; }
    for (int l = 0; l < 2; ++l) {
        conv_plain(F, A->in[27] + (size_t)l * D * D, D, D, 0, D, (bf16*)(ws + WS_WOUT) + (size_t)l * D * D, 1 << 30, 0, 0, nullptr, gw, NGW);
        conv_plain(F, A->in[35] + (size_t)l * D * D, D, D, 0, D, (bf16*)(ws + WS_WPG) + (size_t)l * D * D, 1 << 30, 0, 0, nullptr, gw, NGW);
        conv_plain(F, A->in[37] + (size_t)l * 256 * D, D, 256, 0, D, (bf16*)(ws + WS_WPP) + (size_t)l * D * 256, 1 << 30, 0, 0, nullptr, gw, NGW);
    }
}

__device__ __forceinline__ void prep1_phase(Frame& F, ArgP A, int layer) {
    unsigned char* ws = F.ws; bf16* proj = (bf16*)(ws + WS_PROJ); bf16* la = (bf16*)(ws + WS_LORAA);
    const float* mu = layer ? A->in[7] : A->in[6];
    const int gt = F.vcu * 512 + F.tid, NGT = F.G * 512;
    const float* LP = (const float*)(ws + WS_LORAO); const float* rstd1 = (const float*)(ws + WS_RSTD1);
    for (int i = gt; i < NTOK * (LK / 2); i += NGT) { const int m = i / (LK / 2), j = (i % (LK / 2)) * 2; float o0 = 0.f, o1 = 0.f;
        if (j < (layer ? 320 : 288)) { float c0 = 0.f, c1 = 0.f, q0 = 0.f, q1 = 0.f; const bool hp = (m & (T - 1)) != 0;
#pragma unroll
            for (int ks = 0; ks < 4; ++ks) { const float* p = LP + ((size_t)ks * NTOK + m) * 512 + j; c0 += p[0]; c1 += p[1]; if (hp) { q0 += p[-512]; q1 += p[-511]; } }
            const float rc = rstd1[m], rp = hp ? rstd1[m - 1] : 0.f;
            c0 = bflo(f2bf(c0 * rc)); c1 = bflo(f2bf(c1 * rc)); q0 = bflo(f2bf(q0 * rp)); q1 = bflo(f2bf(q1 * rp));
            o0 = c0 + (q0 - c0) * mu[3072 + j]; o1 = c1 + (q1 - c1) * mu[3072 + j + 1];
            if (j < 64) { o0 = tanhf(o0); o1 = tanhf(o1); } else if (j >= 128 && j < 288) { o0 = sigmoidf_(o0); o1 = sigmoidf_(o1); } }
        *(GAS unsigned*)(la + (size_t)m * LK + j) = pk2(o0, o1); }
    const float* qg = A->in[20] + layer * 64; const float* kg = A->in[21] + layer * 64; const float* rope = (const float*)(ws + WS_ROPE);
    const int gw = F.vcu * NWAVES + F.wave, NGW = F.G * NWAVES, sub = F.lane & 15;
    for (int m = gw; m < NTOK; m += NGW) { const int t = m & (T - 1);
#pragma unroll
        for (int j = 0; j < 8; ++j) { const int grp = j * 4 + (F.lane >> 4); const bool isq = grp < 16;
            bf16* p = proj + (size_t)m * PPITCH + (isq ? PC_Q + grp * 64 : PC_KA + (grp - 16) * 64) + sub * 4;
            const v2u raw = *(const GAS v2u*)p; float x[4] = {bflo(raw.x), bfhi(raw.x), bflo(raw.y), bfhi(raw.y)};
            const float ss = red16(x[0] * x[0] + x[1] * x[1] + x[2] * x[2] + x[3] * x[3]); const float rs = rsqrtf(ss * (1.0f / 64.0f) + 1e-6f);
            const float* g = isq ? qg : kg;
#pragma unroll
            for (int e = 0; e < 4; ++e) x[e] = x[e] * rs * g[sub * 4 + e];
            float y[4];
#pragma unroll
            for (int e = 0; e < 4; ++e) { const float other = __shfl_xor(x[e], 2); const int ri = (sub & 1) * 4 + e; const float cs = rope[t * 16 + ri], sn = rope[t * 16 + 8 + ri];
                y[e] = (sub < 2) ? (x[e] * cs - other * sn) : ((sub < 4) ? (x[e] * cs + other * sn) : x[e]); }
            const float sc = isq ? attn_body::C2 : 1.0f;
            *(GAS v2u*)p = (v2u){pk2(y[0] * sc, y[1] * sc), pk2(y[2] * sc, y[3] * sc)}; } }
}

constexpr int TP_NC = 32, TP_LC = 128, TP_TB = 4;
typedef float f32x2 __attribute__((ext_vector_type(2)));
#define FMAC_BC(acc, av, s, K) asm("v_fmac_f32_dpp %0, %1, %2 row_newbcast:" #K " row_mask:0xf bank_mask:0xf" : "+v"(acc) : "v"(av), "v"(s))
#define MUL_BC(dst, av, s, K) asm("v_mul_f32_dpp %0, %1, %2 row_newbcast:" #K " row_mask:0xf bank_mask:0xf" : "=v"(dst) : "v"(av), "v"(s))
#define L1_PASS1 FMAC_BC(sar0, aq0, SR[0], 0); FMAC_BC(sai0, aq0, SI[0], 0); \
    FMAC_BC(sar1, aq0, SR[1], 1); FMAC_BC(sai1, aq0, SI[1], 1); \
    FMAC_BC(sar2, aq0, SR[2], 2); FMAC_BC(sai2, aq0, SI[2], 2); \
    FMAC_BC(sar3, aq0, SR[3], 3); FMAC_BC(sai3, aq0, SI[3], 3); \
    FMAC_BC(sar0, aq0, SR[4], 4); FMAC_BC(sai0, aq0, SI[4], 4); \
    FMAC_BC(sar1, aq0, SR[5], 5); FMAC_BC(sai1, aq0, SI[5], 5); \
    FMAC_BC(sar2, aq0, SR[6], 6); FMAC_BC(sai2, aq0, SI[6], 6); \
    FMAC_BC(sar3, aq0, SR[7], 7); FMAC_BC(sai3, aq0, SI[7], 7); \
    FMAC_BC(sar0, aq0, SR[8], 8); FMAC_BC(sai0, aq0, SI[8], 8); \
    FMAC_BC(sar1, aq0, SR[9], 9); FMAC_BC(sai1, aq0, SI[9], 9); \
    FMAC_BC(sar2, aq0, SR[10], 10); FMAC_BC(sai2, aq0, SI[10], 10); \
    FMAC_BC(sar3, aq0, SR[11], 11); FMAC_BC(sai3, aq0, SI[11], 11); \
    FMAC_BC(sar0, aq0, SR[12], 12); FMAC_BC(sai0, aq0, SI[12], 12); \
    FMAC_BC(sar1, aq0, SR[13], 13); FMAC_BC(sai1, aq0, SI[13], 13); \
    FMAC_BC(sar2, aq0, SR[14], 14); FMAC_BC(sai2, aq0, SI[14], 14); \
    FMAC_BC(sar3, aq0, SR[15], 15); FMAC_BC(sai3, aq0, SI[15], 15); \
    FMAC_BC(sar0, aq1, SR[16], 0); FMAC_BC(sai0, aq1, SI[16], 0); \
    FMAC_BC(sar1, aq1, SR[17], 1); FMAC_BC(sai1, aq1, SI[17], 1); \
    FMAC_BC(sar2, aq1, SR[18], 2); FMAC_BC(sai2, aq1, SI[18], 2); \
    FMAC_BC(sar3, aq1, SR[19], 3); FMAC_BC(sai3, aq1, SI[19], 3); \
    FMAC_BC(sar0, aq1, SR[20], 4); FMAC_BC(sai0, aq1, SI[20], 4); \
    FMAC_BC(sar1, aq1, SR[21], 5); FMAC_BC(sai1, aq1, SI[21], 5); \
    FMAC_BC(sar2, aq1, SR[22], 6); FMAC_BC(sai2, aq1, SI[22], 6); \
    FMAC_BC(sar3, aq1, SR[23], 7); FMAC_BC(sai3, aq1, SI[23], 7); \
    FMAC_BC(sar0, aq1, SR[24], 8); FMAC_BC(sai0, aq1, SI[24], 8); \
    FMAC_BC(sar1, aq1, SR[25], 9); FMAC_BC(sai1, aq1, SI[25], 9); \
    FMAC_BC(sar2, aq1, SR[26], 10); FMAC_BC(sai2, aq1, SI[26], 10); \
    FMAC_BC(sar3, aq1, SR[27], 11); FMAC_BC(sai3, aq1, SI[27], 11); \
    FMAC_BC(sar0, aq1, SR[28], 12); FMAC_BC(sai0, aq1, SI[28], 12); \
    FMAC_BC(sar1, aq1, SR[29], 13); FMAC_BC(sai1, aq1, SI[29], 13); \
    FMAC_BC(sar2, aq1, SR[30], 14); FMAC_BC(sai2, aq1, SI[30], 14); \
    FMAC_BC(sar3, aq1, SR[31], 15); FMAC_BC(sai3, aq1, SI[31], 15); \
    FMAC_BC(sar0, aq2, SR[32], 0); FMAC_BC(sai0, aq2, SI[32], 0); \
    FMAC_BC(sar1, aq2, SR[33], 1); FMAC_BC(sai1, aq2, SI[33], 1); \
    FMAC_BC(sar2, aq2, SR[34], 2); FMAC_BC(sai2, aq2, SI[34], 2); \
    FMAC_BC(sar3, aq2, SR[35], 3); FMAC_BC(sai3, aq2, SI[35], 3); \
    FMAC_BC(sar0, aq2, SR[36], 4); FMAC_BC(sai0, aq2, SI[36], 4); \
    FMAC_BC(sar1, aq2, SR[37], 5); FMAC_BC(sai1, aq2, SI[37], 5); \
    FMAC_BC(sar2, aq2, SR[38], 6); FMAC_BC(sai2, aq2, SI[38], 6); \
    FMAC_BC(sar3, aq2, SR[39], 7); FMAC_BC(sai3, aq2, SI[39], 7); \
    FMAC_BC(sar0, aq2, SR[40], 8); FMAC_BC(sai0, aq2, SI[40], 8); \
    FMAC_BC(sar1, aq2, SR[41], 9); FMAC_BC(sai1, aq2, SI[41], 9); \
    FMAC_BC(sar2, aq2, SR[42], 10); FMAC_BC(sai2, aq2, SI[42], 10); \
    FMAC_BC(sar3, aq2, SR[43], 11); FMAC_BC(sai3, aq2, SI[43], 11); \
    FMAC_BC(sar0, aq2, SR[44], 12); FMAC_BC(sai0, aq2, SI[44], 12); \
    FMAC_BC(sar1, aq2, SR[45], 13); FMAC_BC(sai1, aq2, SI[45], 13); \
    FMAC_BC(sar2, aq2, SR[46], 14); FMAC_BC(sai2, aq2, SI[46], 14); \
    FMAC_BC(sar3, aq2, SR[47], 15); FMAC_BC(sai3, aq2, SI[47], 15); \
    FMAC_BC(sar0, aq3, SR[48], 0); FMAC_BC(sai0, aq3, SI[48], 0); \
    FMAC_BC(sar1, aq3, SR[49], 1); FMAC_BC(sai1, aq3, SI[49], 1); \
    FMAC_BC(sar2, aq3, SR[50], 2); FMAC_BC(sai2, aq3, SI[50], 2); \
    FMAC_BC(sar3, aq3, SR[51], 3); FMAC_BC(sai3, aq3, SI[51], 3); \
    FMAC_BC(sar0, aq3, SR[52], 4); FMAC_BC(sai0, aq3, SI[52], 4); \
    FMAC_BC(sar1, aq3, SR[53], 5); FMAC_BC(sai1, aq3, SI[53], 5); \
    FMAC_BC(sar2, aq3, SR[54], 6); FMAC_BC(sai2, aq3, SI[54], 6); \
    FMAC_BC(sar3, aq3, SR[55], 7); FMAC_BC(sai3, aq3, SI[55], 7); \
    FMAC_BC(sar0, aq3, SR[56], 8); FMAC_BC(sai0, aq3, SI[56], 8); \
    FMAC_BC(sar1, aq3, SR[57], 9); FMAC_BC(sai1, aq3, SI[57], 9); \
    FMAC_BC(sar2, aq3, SR[58], 10); FMAC_BC(sai2, aq3, SI[58], 10); \
    FMAC_BC(sar3, aq3, SR[59], 11); FMAC_BC(sai3, aq3, SI[59], 11); \
    FMAC_BC(sar0, aq3, SR[60], 12); FMAC_BC(sai0, aq3, SI[60], 12); \
    FMAC_BC(sar1, aq3, SR[61], 13); FMAC_BC(sai1, aq3, SI[61], 13); \
    FMAC_BC(sar2, aq3, SR[62], 14); FMAC_BC(sai2, aq3, SI[62], 14); \
    FMAC_BC(sar3, aq3, SR[63], 15); FMAC_BC(sai3, aq3, SI[63], 15);
#define L1_PASS2 { float t_, u_; MUL_BC(t_, wq0, SR[0], 0); FMAC_BC(t_, bq0, sar, 0); FMAC_BC(t_, kq0, vcur, 0); SR[0] = t_; FMAC_BC(yr0, rq0, t_, 0); MUL_BC(u_, wq0, SI[0], 0); FMAC_BC(u_, bq0, sai, 0); SI[0] = u_; FMAC_BC(yi0, rq0, u_, 0); } \
    { float t_, u_; MUL_BC(t_, wq0, SR[1], 1); FMAC_BC(t_, bq0, sar, 1); FMAC_BC(t_, kq0, vcur, 1); SR[1] = t_; FMAC_BC(yr1, rq0, t_, 1); MUL_BC(u_, wq0, SI[1], 1); FMAC_BC(u_, bq0, sai, 1); SI[1] = u_; FMAC_BC(yi1, rq0, u_, 1); } \
    { float t_, u_; MUL_BC(t_, wq0, SR[2], 2); FMAC_BC(t_, bq0, sar, 2); FMAC_BC(t_, kq0, vcur, 2); SR[2] = t_; FMAC_BC(yr2, rq0, t_, 2); MUL_BC(u_, wq0, SI[2], 2); FMAC_BC(u_, bq0, sai, 2); SI[2] = u_; FMAC_BC(yi2, rq0, u_, 2); } \
    { float t_, u_; MUL_BC(t_, wq0, SR[3], 3); FMAC_BC(t_, bq0, sar, 3); FMAC_BC(t_, kq0, vcur, 3); SR[3] = t_; FMAC_BC(yr3, rq0, t_, 3); MUL_BC(u_, wq0, SI[3], 3); FMAC_BC(u_, bq0, sai, 3); SI[3] = u_; FMAC_BC(yi3, rq0, u_, 3); } \
    { float t_, u_; MUL_BC(t_, wq0, SR[4], 4); FMAC_BC(t_, bq0, sar, 4); FMAC_BC(t_, kq0, vcur, 4); SR[4] = t_; FMAC_BC(yr0, rq0, t_, 4); MUL_BC(u_, wq0, SI[4], 4); FMAC_BC(u_, bq0, sai, 4); SI[4] = u_; FMAC_BC(yi0, rq0, u_, 4); } \
    { float t_, u_; MUL_BC(t_, wq0, SR[5], 5); FMAC_BC(t_, bq0, sar, 5); FMAC_BC(t_, kq0, vcur, 5); SR[5] = t_; FMAC_BC(yr1, rq0, t_, 5); MUL_BC(u_, wq0, SI[5], 5); FMAC_BC(u_, bq0, sai, 5); SI[5] = u_; FMAC_BC(yi1, rq0, u_, 5); } \
    { float t_, u_; MUL_BC(t_, wq0, SR[6], 6); FMAC_BC(t_, bq0, sar, 6); FMAC_BC(t_, kq0, vcur, 6); SR[6] = t_; FMAC_BC(yr2, rq0, t_, 6); MUL_BC(u_, wq0, SI[6], 6); FMAC_BC(u_, bq0, sai, 6); SI[6] = u_; FMAC_BC(yi2, rq0, u_, 6); } \
    { float t_, u_; MUL_BC(t_, wq0, SR[7], 7); FMAC_BC(t_, bq0, sar, 7); FMAC_BC(t_, kq0, vcur, 7); SR[7] = t_; FMAC_BC(yr3, rq0, t_, 7); MUL_BC(u_, wq0, SI[7], 7); FMAC_BC(u_, bq0, sai, 7); SI[7] = u_; FMAC_BC(yi3, rq0, u_, 7); } \
    { float t_, u_; MUL_BC(t_, wq0, SR[8], 8); FMAC_BC(t_, bq0, sar, 8); FMAC_BC(t_, kq0, vcur, 8); SR[8] = t_; FMAC_BC(yr0, rq0, t_, 8); MUL_BC(u_, wq0, SI[8], 8); FMAC_BC(u_, bq0, sai, 8); SI[8] = u_; FMAC_BC(yi0, rq0, u_, 8); } \
    { float t_, u_; MUL_BC(t_, wq0, SR[9], 9); FMAC_BC(t_, bq0, sar, 9); FMAC_BC(t_, kq0, vcur, 9); SR[9] = t_; FMAC_BC(yr1, rq0, t_, 9); MUL_BC(u_, wq0, SI[9], 9); FMAC_BC(u_, bq0, sai, 9); SI[9] = u_; FMAC_BC(yi1, rq0, u_, 9); } \
    { float t_, u_; MUL_BC(t_, wq0, SR[10], 10); FMAC_BC(t_, bq0, sar, 10); FMAC_BC(t_, kq0, vcur, 10); SR[10] = t_; FMAC_BC(yr2, rq0, t_, 10); MUL_BC(u_, wq0, SI[10], 10); FMAC_BC(u_, bq0, sai, 10); SI[10] = u_; FMAC_BC(yi2, rq0, u_, 10); } \
    { float t_, u_; MUL_BC(t_, wq0, SR[11], 11); FMAC_BC(t_, bq0, sar, 11); FMAC_BC(t_, kq0, vcur, 11); SR[11] = t_; FMAC_BC(yr3, rq0, t_, 11); MUL_BC(u_, wq0, SI[11], 11); FMAC_BC(u_, bq0, sai, 11); SI[11] = u_; FMAC_BC(yi3, rq0, u_, 11); } \
    { float t_, u_; MUL_BC(t_, wq0, SR[12], 12); FMAC_BC(t_, bq0, sar, 12); FMAC_BC(t_, kq0, vcur, 12); SR[12] = t_; FMAC_BC(yr0, rq0, t_, 12); MUL_BC(u_, wq0, SI[12], 12); FMAC_BC(u_, bq0, sai, 12); SI[12] = u_; FMAC_BC(yi0, rq0, u_, 12); } \
    { float t_, u_; MUL_BC(t_, wq0, SR[13], 13); FMAC_BC(t_, bq0, sar, 13); FMAC_BC(t_, kq0, vcur, 13); SR[13] = t_; FMAC_BC(yr1, rq0, t_, 13); MUL_BC(u_, wq0, SI[13], 13); FMAC_BC(u_, bq0, sai, 13); SI[13] = u_; FMAC_BC(yi1, rq0, u_, 13); } \
    { float t_, u_; MUL_BC(t_, wq0, SR[14], 14); FMAC_BC(t_, bq0, sar, 14); FMAC_BC(t_, kq0, vcur, 14); SR[14] = t_; FMAC_BC(yr2, rq0, t_, 14); MUL_BC(u_, wq0, SI[14], 14); FMAC_BC(u_, bq0, sai, 14); SI[14] = u_; FMAC_BC(yi2, rq0, u_, 14); } \
    { float t_, u_; MUL_BC(t_, wq0, SR[15], 15); FMAC_BC(t_, bq0, sar, 15); FMAC_BC(t_, kq0, vcur, 15); SR[15] = t_; FMAC_BC(yr3, rq0, t_, 15); MUL_BC(u_, wq0, SI[15], 15); FMAC_BC(u_, bq0, sai, 15); SI[15] = u_; FMAC_BC(yi3, rq0, u_, 15); } \
    { float t_, u_; MUL_BC(t_, wq1, SR[16], 0); FMAC_BC(t_, bq1, sar, 0); FMAC_BC(t_, kq1, vcur, 0); SR[16] = t_; FMAC_BC(yr0, rq1, t_, 0); MUL_BC(u_, wq1, SI[16], 0); FMAC_BC(u_, bq1, sai, 0); SI[16] = u_; FMAC_BC(yi0, rq1, u_, 0); } \
    { float t_, u_; MUL_BC(t_, wq1, SR[17], 1); FMAC_BC(t_, bq1, sar, 1); FMAC_BC(t_, kq1, vcur, 1); SR[17] = t_; FMAC_BC(yr1, rq1, t_, 1); MUL_BC(u_, wq1, SI[17], 1); FMAC_BC(u_, bq1, sai, 1); SI[17] = u_; FMAC_BC(yi1, rq1, u_, 1); } \
    { float t_, u_; MUL_BC(t_, wq1, SR[18], 2); FMAC_BC(t_, bq1, sar, 2); FMAC_BC(t_, kq1, vcur, 2); SR[18] = t_; FMAC_BC(yr2, rq1, t_, 2); MUL_BC(u_, wq1, SI[18], 2); FMAC_BC(u_, bq1, sai, 2); SI[18] = u_; FMAC_BC(yi2, rq1, u_, 2); } \
    { float t_, u_; MUL_BC(t_, wq1, SR[19], 3); FMAC_BC(t_, bq1, sar, 3); FMAC_BC(t_, kq1, vcur, 3); SR[19] = t_; FMAC_BC(yr3, rq1, t_, 3); MUL_BC(u_, wq1, SI[19], 3); FMAC_BC(u_, bq1, sai, 3); SI[19] = u_; FMAC_BC(yi3, rq1, u_, 3); } \
    { float t_, u_; MUL_BC(t_, wq1, SR[20], 4); FMAC_BC(t_, bq1, sar, 4); FMAC_BC(t_, kq1, vcur, 4); SR[20] = t_; FMAC_BC(yr0, rq1, t_, 4); MUL_BC(u_, wq1, SI[20], 4); FMAC_BC(u_, bq1, sai, 4); SI[20] = u_; FMAC_BC(yi0, rq1, u_, 4); } \
    { float t_, u_; MUL_BC(t_, wq1, SR[21], 5); FMAC_BC(t_, bq1, sar, 5); FMAC_BC(t_, kq1, vcur, 5); SR[21] = t_; FMAC_BC(yr1, rq1, t_, 5); MUL_BC(u_, wq1, SI[21], 5); FMAC_BC(u_, bq1, sai, 5); SI[21] = u_; FMAC_BC(yi1, rq1, u_, 5); } \
    { float t_, u_; MUL_BC(t_, wq1, SR[22], 6); FMAC_BC(t_, bq1, sar, 6); FMAC_BC(t_, kq1, vcur, 6); SR[22] = t_; FMAC_BC(yr2, rq1, t_, 6); MUL_BC(u_, wq1, SI[22], 6); FMAC_BC(u_, bq1, sai, 6); SI[22] = u_; FMAC_BC(yi2, rq1, u_, 6); } \
    { float t_, u_; MUL_BC(t_, wq1, SR[23], 7); FMAC_BC(t_, bq1, sar, 7); FMAC_BC(t_, kq1, vcur, 7); SR[23] = t_; FMAC_BC(yr3, rq1, t_, 7); MUL_BC(u_, wq1, SI[23], 7); FMAC_BC(u_, bq1, sai, 7); SI[23] = u_; FMAC_BC(yi3, rq1, u_, 7); } \
    { float t_, u_; MUL_BC(t_, wq1, SR[24], 8); FMAC_BC(t_, bq1, sar, 8); FMAC_BC(t_, kq1, vcur, 8); SR[24] = t_; FMAC_BC(yr0, rq1, t_, 8); MUL_BC(u_, wq1, SI[24], 8); FMAC_BC(u_, bq1, sai, 8); SI[24] = u_; FMAC_BC(yi0, rq1, u_, 8); } \
    { float t_, u_; MUL_BC(t_, wq1, SR[25], 9); FMAC_BC(t_, bq1, sar, 9); FMAC_BC(t_, kq1, vcur, 9); SR[25] = t_; FMAC_BC(yr1, rq1, t_, 9); MUL_BC(u_, wq1, SI[25], 9); FMAC_BC(u_, bq1, sai, 9); SI[25] = u_; FMAC_BC(yi1, rq1, u_, 9); } \
    { float t_, u_; MUL_BC(t_, wq1, SR[26], 10); FMAC_BC(t_, bq1, sar, 10); FMAC_BC(t_, kq1, vcur, 10); SR[26] = t_; FMAC_BC(yr2, rq1, t_, 10); MUL_BC(u_, wq1, SI[26], 10); FMAC_BC(u_, bq1, sai, 10); SI[26] = u_; FMAC_BC(yi2, rq1, u_, 10); } \
    { float t_, u_; MUL_BC(t_, wq1, SR[27], 11); FMAC_BC(t_, bq1, sar, 11); FMAC_BC(t_, kq1, vcur, 11); SR[27] = t_; FMAC_BC(yr3, rq1, t_, 11); MUL_BC(u_, wq1, SI[27], 11); FMAC_BC(u_, bq1, sai, 11); SI[27] = u_; FMAC_BC(yi3, rq1, u_, 11); } \
    { float t_, u_; MUL_BC(t_, wq1, SR[28], 12); FMAC_BC(t_, bq1, sar, 12); FMAC_BC(t_, kq1, vcur, 12); SR[28] = t_; FMAC_BC(yr0, rq1, t_, 12); MUL_BC(u_, wq1, SI[28], 12); FMAC_BC(u_, bq1, sai, 12); SI[28] = u_; FMAC_BC(yi0, rq1, u_, 12); } \
    { float t_, u_; MUL_BC(t_, wq1, SR[29], 13); FMAC_BC(t_, bq1, sar, 13); FMAC_BC(t_, kq1, vcur, 13); SR[29] = t_; FMAC_BC(yr1, rq1, t_, 13); MUL_BC(u_, wq1, SI[29], 13); FMAC_BC(u_, bq1, sai, 13); SI[29] = u_; FMAC_BC(yi1, rq1, u_, 13); } \
    { float t_, u_; MUL_BC(t_, wq1, SR[30], 14); FMAC_BC(t_, bq1, sar, 14); FMAC_BC(t_, kq1, vcur, 14); SR[30] = t_; FMAC_BC(yr2, rq1, t_, 14); MUL_BC(u_, wq1, SI[30], 14); FMAC_BC(u_, bq1, sai, 14); SI[30] = u_; FMAC_BC(yi2, rq1, u_, 14); } \
    { float t_, u_; MUL_BC(t_, wq1, SR[31], 15); FMAC_BC(t_, bq1, sar, 15); FMAC_BC(t_, kq1, vcur, 15); SR[31] = t_; FMAC_BC(yr3, rq1, t_, 15); MUL_BC(u_, wq1, SI[31], 15); FMAC_BC(u_, bq1, sai, 15); SI[31] = u_; FMAC_BC(yi3, rq1, u_, 15); } \
    { float t_, u_; MUL_BC(t_, wq2, SR[32], 0); FMAC_BC(t_, bq2, sar, 0); FMAC_BC(t_, kq2, vcur, 0); SR[32] = t_; FMAC_BC(yr0, rq2, t_, 0); MUL_BC(u_, wq2, SI[32], 0); FMAC_BC(u_, bq2, sai, 0); SI[32] = u_; FMAC_BC(yi0, rq2, u_, 0); } \
    { float t_, u_; MUL_BC(t_, wq2, SR[33], 1); FMAC_BC(t_, bq2, sar, 1); FMAC_BC(t_, kq2, vcur, 1); SR[33] = t_; FMAC_BC(yr1, rq2, t_, 1); MUL_BC(u_, wq2, SI[33], 1); FMAC_BC(u_, bq2, sai, 1); SI[33] = u_; FMAC_BC(yi1, rq2, u_, 1); } \
    { float t_, u_; MUL_BC(t_, wq2, SR[34], 2); FMAC_BC(t_, bq2, sar, 2); FMAC_BC(t_, kq2, vcur, 2); SR[34] = t_; FMAC_BC(yr2, rq2, t_, 2); MUL_BC(u_, wq2, SI[34], 2); FMAC_BC(u_, bq2, sai, 2); SI[34] = u_; FMAC_BC(yi2, rq2, u_, 2); } \
    { float t_, u_; MUL_BC(t_, wq2, SR[35], 3); FMAC_BC(t_, bq2, sar, 3); FMAC_BC(t_, kq2, vcur, 3); SR[35] = t_; FMAC_BC(yr3, rq2, t_, 3); MUL_BC(u_, wq2, SI[35], 3); FMAC_BC(u_, bq2, sai, 3); SI[35] = u_; FMAC_BC(yi3, rq2, u_, 3); } \
    { float t_, u_; MUL_BC(t_, wq2, SR[36], 4); FMAC_BC(t_, bq2, sar, 4); FMAC_BC(t_, kq2, vcur, 4); SR[36] = t_; FMAC_BC(yr0, rq2, t_, 4); MUL_BC(u_, wq2, SI[36], 4); FMAC_BC(u_, bq2, sai, 4); SI[36] = u_; FMAC_BC(yi0, rq2, u_, 4); } \
    { float t_, u_; MUL_BC(t_, wq2, SR[37], 5); FMAC_BC(t_, bq2, sar, 5); FMAC_BC(t_, kq2, vcur, 5); SR[37] = t_; FMAC_BC(yr1, rq2, t_, 5); MUL_BC(u_, wq2, SI[37], 5); FMAC_BC(u_, bq2, sai, 5); SI[37] = u_; FMAC_BC(yi1, rq2, u_, 5); } \
    { float t_, u_; MUL_BC(t_, wq2, SR[38], 6); FMAC_BC(t_, bq2, sar, 6); FMAC_BC(t_, kq2, vcur, 6); SR[38] = t_; FMAC_BC(yr2, rq2, t_, 6); MUL_BC(u_, wq2, SI[38], 6); FMAC_BC(u_, bq2, sai, 6); SI[38] = u_; FMAC_BC(yi2, rq2, u_, 6); } \
    { float t_, u_; MUL_BC(t_, wq2, SR[39], 7); FMAC_BC(t_, bq2, sar, 7); FMAC_BC(t_, kq2, vcur, 7); SR[39] = t_; FMAC_BC(yr3, rq2, t_, 7); MUL_BC(u_, wq2, SI[39], 7); FMAC_BC(u_, bq2, sai, 7); SI[39] = u_; FMAC_BC(yi3, rq2, u_, 7); } \
    { float t_, u_; MUL_BC(t_, wq2, SR[40], 8); FMAC_BC(t_, bq2, sar, 8); FMAC_BC(t_, kq2, vcur, 8); SR[40] = t_; FMAC_BC(yr0, rq2, t_, 8); MUL_BC(u_, wq2, SI[40], 8); FMAC_BC(u_, bq2, sai, 8); SI[40] = u_; FMAC_BC(yi0, rq2, u_, 8); } \
    { float t_, u_; MUL_BC(t_, wq2, SR[41], 9); FMAC_BC(t_, bq2, sar, 9); FMAC_BC(t_, kq2, vcur, 9); SR[41] = t_; FMAC_BC(yr1, rq2, t_, 9); MUL_BC(u_, wq2, SI[41], 9); FMAC_BC(u_, bq2, sai, 9); SI[41] = u_; FMAC_BC(yi1, rq2, u_, 9); } \
    { float t_, u_; MUL_BC(t_, wq2, SR[42], 10); FMAC_BC(t_, bq2, sar, 10); FMAC_BC(t_, kq2, vcur, 10); SR[42] = t_; FMAC_BC(yr2, rq2, t_, 10); MUL_BC(u_, wq2, SI[42], 10); FMAC_BC(u_, bq2, sai, 10); SI[42] = u_; FMAC_BC(yi2, rq2, u_, 10); } \
    { float t_, u_; MUL_BC(t_, wq2, SR[43], 11); FMAC_BC(t_, bq2, sar, 11); FMAC_BC(t_, kq2, vcur, 11); SR[43] = t_; FMAC_BC(yr3, rq2, t_, 11); MUL_BC(u_, wq2, SI[43], 11); FMAC_BC(u_, bq2, sai, 11); SI[43] = u_; FMAC_BC(yi3, rq2, u_, 11); } \
    { float t_, u_; MUL_BC(t_, wq2, SR[44], 12); FMAC_BC(t_, bq2, sar, 12); FMAC_BC(t_, kq2, vcur, 12); SR[44] = t_; FMAC_BC(yr0, rq2, t_, 12); MUL_BC(u_, wq2, SI[44], 12); FMAC_BC(u_, bq2, sai, 12); SI[44] = u_; FMAC_BC(yi0, rq2, u_, 12); } \
    { float t_, u_; MUL_BC(t_, wq2, SR[45], 13); FMAC_BC(t_, bq2, sar, 13); FMAC_BC(t_, kq2, vcur, 13); SR[45] = t_; FMAC_BC(yr1, rq2, t_, 13); MUL_BC(u_, wq2, SI[45], 13); FMAC_BC(u_, bq2, sai, 13); SI[45] = u_; FMAC_BC(yi1, rq2, u_, 13); } \
    { float t_, u_; MUL_BC(t_, wq2, SR[46], 14); FMAC_BC(t_, bq2, sar, 14); FMAC_BC(t_, kq2, vcur, 14); SR[46] = t_; FMAC_BC(yr2, rq2, t_, 14); MUL_BC(u_, wq2, SI[46], 14); FMAC_BC(u_, bq2, sai, 14); SI[46] = u_; FMAC_BC(yi2, rq2, u_, 14); } \
    { float t_, u_; MUL_BC(t_, wq2, SR[47], 15); FMAC_BC(t_, bq2, sar, 15); FMAC_BC(t_, kq2, vcur, 15); SR[47] = t_; FMAC_BC(yr3, rq2, t_, 15); MUL_BC(u_, wq2, SI[47], 15); FMAC_BC(u_, bq2, sai, 15); SI[47] = u_; FMAC_BC(yi3, rq2, u_, 15); } \
    { float t_, u_; MUL_BC(t_, wq3, SR[48], 0); FMAC_BC(t_, bq3, sar, 0); FMAC_BC(t_, kq3, vcur, 0); SR[48] = t_; FMAC_BC(yr0, rq3, t_, 0); MUL_BC(u_, wq3, SI[48], 0); FMAC_BC(u_, bq3, sai, 0); SI[48] = u_; FMAC_BC(yi0, rq3, u_, 0); } \
    { float t_, u_; MUL_BC(t_, wq3, SR[49], 1); FMAC_BC(t_, bq3, sar, 1); FMAC_BC(t_, kq3, vcur, 1); SR[49] = t_; FMAC_BC(yr1, rq3, t_, 1); MUL_BC(u_, wq3, SI[49], 1); FMAC_BC(u_, bq3, sai, 1); SI[49] = u_; FMAC_BC(yi1, rq3, u_, 1); } \
    { float t_, u_; MUL_BC(t_, wq3, SR[50], 2); FMAC_BC(t_, bq3, sar, 2); FMAC_BC(t_, kq3, vcur, 2); SR[50] = t_; FMAC_BC(yr2, rq3, t_, 2); MUL_BC(u_, wq3, SI[50], 2); FMAC_BC(u_, bq3, sai, 2); SI[50] = u_; FMAC_BC(yi2, rq3, u_, 2); } \
    { float t_, u_; MUL_BC(t_, wq3, SR[51], 3); FMAC_BC(t_, bq3, sar, 3); FMAC_BC(t_, kq3, vcur, 3); SR[51] = t_; FMAC_BC(yr3, rq3, t_, 3); MUL_BC(u_, wq3, SI[51], 3); FMAC_BC(u_, bq3, sai, 3); SI[51] = u_; FMAC_BC(yi3, rq3, u_, 3); } \
    { float t_, u_; MUL_BC(t_, wq3, SR[52], 4); FMAC_BC(t_, bq3, sar, 4); FMAC_BC(t_, kq3, vcur, 4); SR[52] = t_; FMAC_BC(yr0, rq3, t_, 4); MUL_BC(u_, wq3, SI[52], 4); FMAC_BC(u_, bq3, sai, 4); SI[52] = u_; FMAC_BC(yi0, rq3, u_, 4); } \
    { float t_, u_; MUL_BC(t_, wq3, SR[53], 5); FMAC_BC(t_, bq3, sar, 5); FMAC_BC(t_, kq3, vcur, 5); SR[53] = t_; FMAC_BC(yr1, rq3, t_, 5); MUL_BC(u_, wq3, SI[53], 5); FMAC_BC(u_, bq3, sai, 5); SI[53] = u_; FMAC_BC(yi1, rq3, u_, 5); } \
    { float t_, u_; MUL_BC(t_, wq3, SR[54], 6); FMAC_BC(t_, bq3, sar, 6); FMAC_BC(t_, kq3, vcur, 6); SR[54] = t_; FMAC_BC(yr2, rq3, t_, 6); MUL_BC(u_, wq3, SI[54], 6); FMAC_BC(u_, bq3, sai, 6); SI[54] = u_; FMAC_BC(yi2, rq3, u_, 6); } \
    { float t_, u_; MUL_BC(t_, wq3, SR[55], 7); FMAC_BC(t_, bq3, sar, 7); FMAC_BC(t_, kq3, vcur, 7); SR[55] = t_; FMAC_BC(yr3, rq3, t_, 7); MUL_BC(u_, wq3, SI[55], 7); FMAC_BC(u_, bq3, sai, 7); SI[55] = u_; FMAC_BC(yi3, rq3, u_, 7); } \
    { float t_, u_; MUL_BC(t_, wq3, SR[56], 8); FMAC_BC(t_, bq3, sar, 8); FMAC_BC(t_, kq3, vcur, 8); SR[56] = t_; FMAC_BC(yr0, rq3, t_, 8); MUL_BC(u_, wq3, SI[56], 8); FMAC_BC(u_, bq3, sai, 8); SI[56] = u_; FMAC_BC(yi0, rq3, u_, 8); } \
    { float t_, u_; MUL_BC(t_, wq3, SR[57], 9); FMAC_BC(t_, bq3, sar, 9); FMAC_BC(t_, kq3, vcur, 9); SR[57] = t_; FMAC_BC(yr1, rq3, t_, 9); MUL_BC(u_, wq3, SI[57], 9); FMAC_BC(u_, bq3, sai, 9); SI[57] = u_; FMAC_BC(yi1, rq3, u_, 9); } \
    { float t_, u_; MUL_BC(t_, wq3, SR[58], 10); FMAC_BC(t_, bq3, sar, 10); FMAC_BC(t_, kq3, vcur, 10); SR[58] = t_; FMAC_BC(yr2, rq3, t_, 10); MUL_BC(u_, wq3, SI[58], 10); FMAC_BC(u_, bq3, sai, 10); SI[58] = u_; FMAC_BC(yi2, rq3, u_, 10); } \
    { float t_, u_; MUL_BC(t_, wq3, SR[59], 11); FMAC_BC(t_, bq3, sar, 11); FMAC_BC(t_, kq3, vcur, 11); SR[59] = t_; FMAC_BC(yr3, rq3, t_, 11); MUL_BC(u_, wq3, SI[59], 11); FMAC_BC(u_, bq3, sai, 11); SI[59] = u_; FMAC_BC(yi3, rq3, u_, 11); } \
    { float t_, u_; MUL_BC(t_, wq3, SR[60], 12); FMAC_BC(t_, bq3, sar, 12); FMAC_BC(t_, kq3, vcur, 12); SR[60] = t_; FMAC_BC(yr0, rq3, t_, 12); MUL_BC(u_, wq3, SI[60], 12); FMAC_BC(u_, bq3, sai, 12); SI[60] = u_; FMAC_BC(yi0, rq3, u_, 12); } \
    { float t_, u_; MUL_BC(t_, wq3, SR[61], 13); FMAC_BC(t_, bq3, sar, 13); FMAC_BC(t_, kq3, vcur, 13); SR[61] = t_; FMAC_BC(yr1, rq3, t_, 13); MUL_BC(u_, wq3, SI[61], 13); FMAC_BC(u_, bq3, sai, 13); SI[61] = u_; FMAC_BC(yi1, rq3, u_, 13); } \
    { float t_, u_; MUL_BC(t_, wq3, SR[62], 14); FMAC_BC(t_, bq3, sar, 14); FMAC_BC(t_, kq3, vcur, 14); SR[62] = t_; FMAC_BC(yr2, rq3, t_, 14); MUL_BC(u_, wq3, SI[62], 14); FMAC_BC(u_, bq3, sai, 14); SI[62] = u_; FMAC_BC(yi2, rq3, u_, 14); } \
    { float t_, u_; MUL_BC(t_, wq3, SR[63], 15); FMAC_BC(t_, bq3, sar, 15); FMAC_BC(t_, kq3, vcur, 15); SR[63] = t_; FMAC_BC(yr3, rq3, t_, 15); MUL_BC(u_, wq3, SI[63], 15); FMAC_BC(u_, bq3, sai, 15); SI[63] = u_; FMAC_BC(yi3, rq3, u_, 15); }
#define L3_DOT FMAC_BC(a0, qq0, R[0], 0); \
    FMAC_BC(a1, qq0, R[1], 1); \
    FMAC_BC(a2, qq0, R[2], 2); \
    FMAC_BC(a3, qq0, R[3], 3); \
    FMAC_BC(a0, qq0, R[4], 4); \
    FMAC_BC(a1, qq0, R[5], 5); \
    FMAC_BC(a2, qq0, R[6], 6); \
    FMAC_BC(a3, qq0, R[7], 7); \
    FMAC_BC(a0, qq0, R[8], 8); \
    FMAC_BC(a1, qq0, R[9], 9); \
    FMAC_BC(a2, qq0, R[10], 10); \
    FMAC_BC(a3, qq0, R[11], 11); \
    FMAC_BC(a0, qq0, R[12], 12); \
    FMAC_BC(a1, qq0, R[13], 13); \
    FMAC_BC(a2, qq0, R[14], 14); \
    FMAC_BC(a3, qq0, R[15], 15); \
    FMAC_BC(a0, qq1, R[16], 0); \
    FMAC_BC(a1, qq1, R[17], 1); \
    FMAC_BC(a2, qq1, R[18], 2); \
    FMAC_BC(a3, qq1, R[19], 3); \
    FMAC_BC(a0, qq1, R[20], 4); \
    FMAC_BC(a1, qq1, R[21], 5); \
    FMAC_BC(a2, qq1, R[22], 6); \
    FMAC_BC(a3, qq1, R[23], 7); \
    FMAC_BC(a0, qq1, R[24], 8); \
    FMAC_BC(a1, qq1, R[25], 9); \
    FMAC_BC(a2, qq1, R[26], 10); \
    FMAC_BC(a3, qq1, R[27], 11); \
    FMAC_BC(a0, qq1, R[28], 12); \
    FMAC_BC(a1, qq1, R[29], 13); \
    FMAC_BC(a2, qq1, R[30], 14); \
    FMAC_BC(a3, qq1, R[31], 15); \
    FMAC_BC(a0, qq2, R[32], 0); \
    FMAC_BC(a1, qq2, R[33], 1); \
    FMAC_BC(a2, qq2, R[34], 2); \
    FMAC_BC(a3, qq2, R[35], 3); \
    FMAC_BC(a0, qq2, R[36], 4); \
    FMAC_BC(a1, qq2, R[37], 5); \
    FMAC_BC(a2, qq2, R[38], 6); \
    FMAC_BC(a3, qq2, R[39], 7); \
    FMAC_BC(a0, qq2, R[40], 8); \
    FMAC_BC(a1, qq2, R[41], 9); \
    FMAC_BC(a2, qq2, R[42], 10); \
    FMAC_BC(a3, qq2, R[43], 11); \
    FMAC_BC(a0, qq2, R[44], 12); \
    FMAC_BC(a1, qq2, R[45], 13); \
    FMAC_BC(a2, qq2, R[46], 14); \
    FMAC_BC(a3, qq2, R[47], 15); \
    FMAC_BC(a0, qq3, R[48], 0); \
    FMAC_BC(a1, qq3, R[49], 1); \
    FMAC_BC(a2, qq3, R[50], 2); \
    FMAC_BC(a3, qq3, R[51], 3); \
    FMAC_BC(a0, qq3, R[52], 4); \
    FMAC_BC(a1, qq3, R[53], 5); \
    FMAC_BC(a2, qq3, R[54], 6); \
    FMAC_BC(a3, qq3, R[55], 7); \
    FMAC_BC(a0, qq3, R[56], 8); \
    FMAC_BC(a1, qq3, R[57], 9); \
    FMAC_BC(a2, qq3, R[58], 10); \
    FMAC_BC(a3, qq3, R[59], 11); \
    FMAC_BC(a0, qq3, R[60], 12); \
    FMAC_BC(a1, qq3, R[61], 13); \
    FMAC_BC(a2, qq3, R[62], 14); \
    FMAC_BC(a3, qq3, R[63], 15);

__device__ __forceinline__ ConvItem any_item(int it, ArgP A, unsigned char* ws, int layer) {
    if (it < 32 * 768) return moe_item(it, A->in[32] + (size_t)layer * 32 * 2048 * 512, A->in[33] + (size_t)layer * 32 * 2048 * 512, A->in[34] + (size_t)layer * 32 * 512 * 2048, A->in[3] + layer * D, (bf16*)(ws + WS_WGU), (bf16*)(ws + WS_WD));
    it -= 32 * 768;
    if (it < 32 * 101) return ConvItem{A->in[5], (bf16*)(ws + WS_WIN) + (size_t)PPITCH * D, A->in[2] + D, 6464, 64 * (it / 101), 64 * (it % 101), 6464, D, 3392, 0, 192, 0};
    it -= 32 * 101;
    if (it < 2048) { const int l = it >> 10, q = it & 1023; return ConvItem{A->in[27] + (size_t)l * D * D, (bf16*)(ws + WS_WOUT) + (size_t)l * D * D, nullptr, D, 64 * (q >> 5), 64 * (q & 31), D, D, 1 << 30, 0, 0, 0}; }
    it -= 2048;
    if (it < 2048) { const int l = it >> 10, q = it & 1023; return ConvItem{A->in[35] + (size_t)l * D * D, (bf16*)(ws + WS_WPG) + (size_t)l * D * D, nullptr, D, 64 * (q >> 5), 64 * (q & 31), D, D, 1 << 30, 0, 0, 0}; }
    it -= 2048;
    { const int l = it >> 7, q = it & 127; return ConvItem{A->in[37] + (size_t)l * 256 * D, (bf16*)(ws + WS_WPP) + (size_t)l * D * 256, nullptr, D, 64 * (q >> 5), 64 * (q & 31), D, 256, 1 << 30, 0, 0, 0}; }
}
constexpr int N_CONV_L0 = 32 * 768 + 32 * 101 + 2048 + 2048 + 256, N_CONV_L1 = 32 * 768;
__device__ __forceinline__ void tp_level1_producer(Frame& F, ArgP A, int layer) {
    unsigned char* ws = F.ws;
    const int lane = F.lane, slot = F.wave & 3; const bool producer = F.wave >= 4;
    constexpr int BUFB = TP_TB * 1280 + TP_TB * 256, NB = TP_LC / TP_TB;
    LAS unsigned char* wl = F.lds + RING_OFF + slot * (2 * BUFB); LAS int* fl = (LAS int*)(F.lds + L1FLAG_OFF);
    const int nconv = layer ? N_CONV_L1 : N_CONV_L0; int cit = F.vcu * 4 + slot; const int cstep = F.G * 4;
    const int nrounds = (32 * TP_NC + F.G * 4 - 1) / (F.G * 4);
#pragma unroll 1
    for (int rd = 0; rd < nrounds; ++rd) {
        const int u = (rd * F.G + F.vcu) * 4 + slot; const bool act = u < 32 * TP_NC;
        __syncthreads(); if (F.tid < 8) fl[F.tid] = 0; __syncthreads();
        const int bh = act ? (u >> 5) : 0, c = u & 31, b = bh >> 4, h = bh & 15; const size_t m0 = (size_t)b * T + (size_t)c * TP_LC; const int col = h * 64, ch = col + lane;
            const bf16* proj = (const bf16*)(ws + WS_PROJ); const bf16* lo = (const bf16*)(ws + WS_LORAO); float* SV = (float*)(ws + WS_SV); float* vfirst = (float*)(ws + WS_VFIRST); float* bonus = (float*)(ws + WS_BONUS);
            const float* mu = layer ? A->in[7] : A->in[6];
            const float p_w0 = A->in[8][layer * C + ch], p_a0 = A->in[10][layer * C + ch], p_v0 = layer ? A->in[13][ch] : 0.f, p_kk = A->in[15][layer * C + ch], p_ka = A->in[16][layer * C + ch], p_rk = A->in[17][layer * C + ch];
            const float mu_r = mu[ch], mu_k = mu[1024 + ch], mu_v = mu[2048 + ch];
#define L1_LOADRAW(blk, raw, vfr) do { _Pragma("unroll") for (int s2 = 0; s2 < TP_TB; ++s2) { const size_t m = m0 + (size_t)(blk) * TP_TB + s2; const bool hp = (m & (T - 1)) != 0; const bf16* pr = proj + m * PPITCH + ch; \
                    raw[s2][0] = pr[PC_R]; raw[s2][1] = pr[PC_K]; raw[s2][2] = pr[PC_V]; raw[s2][3] = hp ? pr[PC_R - PPITCH] : (bf16)0; raw[s2][4] = hp ? pr[PC_K - PPITCH] : (bf16)0; raw[s2][5] = hp ? pr[PC_V - PPITCH] : (bf16)0; \
                    raw[s2][6] = lo[m * 4096 + ch]; raw[s2][7] = lo[m * 4096 + 1024 + ch]; raw[s2][8] = lo[m * 4096 + 3072 + ch]; vfr[s2] = layer ? vfirst[m * C + ch] : 0.f; } } while (0)
#define L1_PRODUCE(blk, raw, vfr) do { LAS unsigned char* lw_ = wl + ((blk) & 1) * BUFB; \
                _Pragma("unroll") for (int s2 = 0; s2 < TP_TB; ++s2) { const size_t m = m0 + (size_t)(blk) * TP_TB + s2; \
                    const float r_c = bflo((unsigned)raw[s2][0]), k_c = bflo((unsigned)raw[s2][1]), v_c = bflo((unsigned)raw[s2][2]), r_p = bflo((unsigned)raw[s2][3]), k_p = bflo((unsigned)raw[s2][4]), v_p = bflo((unsigned)raw[s2][5]); \
                    const float lw = bflo((unsigned)raw[s2][6]), la = bflo((unsigned)raw[s2][7]), lv = bflo((unsigned)raw[s2][8]); const float vf = vfr[s2]; \
                    const float xr = r_c + (r_p - r_c) * mu_r, xk = k_c + (k_p - k_c) * mu_k, xv = v_c + (v_p - v_c) * mu_v; \
                    const float zz = -(p_w0 + lw); const float sp = fmaxf(zz, 0.f) + log1pf(__expf(-fabsf(zz))); const float dec = __expf(-__expf(-sp - 0.5f)); \
                    const float av = sigmoidf_(p_a0 + la); const float vv = layer ? xv + (vf - xv) * sigmoidf_(p_v0 + lv) : xv; \
                    const float kkn = xk * p_kk; const float k2 = xk * (1.0f + (av - 1.0f) * p_ka); \
                    const float ssq = wave_bcast63(wave_total63(kkn * kkn)), bs = wave_bcast63(wave_total63(xr * k2 * p_rk)); \
                    const float kn = kkn * (1.0f / fmaxf(sqrtf(ssq), 1e-12f)); \
                    LAS float* ls_ = (LAS float*)(lw_ + s2 * 1280) + lane; ls_[0] = -kn; ls_[64] = dec; ls_[128] = kn * av; ls_[192] = k2; ls_[256] = xr; \
                    ((LAS float*)(lw_ + TP_TB * 1280 + s2 * 256))[lane] = vv; \
                    SV[m * C + ch] = vv; if (!layer) vfirst[m * C + ch] = xv; if (lane == 0) bonus[m * 16 + h] = bs; __builtin_amdgcn_sched_barrier(0); } } while (0)
            bf16 rawa[TP_TB][9], rawb[TP_TB][9]; float vfa[TP_TB], vfb[TP_TB];
#define L1_ITER(n_, RC, VC, RN, VN) do { f32x4 cv[16]; ConvItem it; const bool hc = cit < nconv; \
                if (hc) { it = any_item(cit, A, ws, layer); conv_load(it, lane, cv); }        \
                if (act) { if ((n_) + 1 < NB) L1_LOADRAW((n_) + 1, RN, VN); __builtin_amdgcn_sched_barrier(0); \
                    if ((n_) >= 2) { while (*(volatile LAS int*)(fl + 4 + slot) < (n_) - 1) __builtin_amdgcn_s_sleep(2); asm volatile("" ::: "memory"); } \
                    L1_PRODUCE(n_, RC, VC); \
                    asm volatile("s_waitcnt lgkmcnt(0)" ::: "memory"); if (lane == 0) *(volatile LAS int*)(fl + slot) = (n_) + 1; } \
                if (hc) { conv_store(it, lane, cv); cit += cstep; } } while (0)
            if (act) L1_LOADRAW(0, rawa, vfa);
#pragma unroll 1
            for (int n = 0; n < NB; n += 2) { L1_ITER(n, rawa, vfa, rawb, vfb); L1_ITER(n + 1, rawb, vfb, rawa, vfa); }
#undef L1_ITER
#undef L1_LOADRAW
#undef L1_PRODUCE
    }
    { for (; cit < nconv; cit += cstep) { const ConvItem it = any_item(cit, A, ws, layer); conv_half(it, lane, 0); conv_half(it, lane, 1); }
        if (!layer) { bf16* w1 = (bf16*)(ws + WS_WIN) + (size_t)PPITCH * D; const size_t n16 = (size_t)(3584 - 3392) * D / 8; GAS v4u* p = (GAS v4u*)(w1 + (size_t)3392 * D);
            for (size_t i = (size_t)(F.vcu * 4 + slot) * 64 + lane; i < n16; i += (size_t)cstep * 64) p[i] = (v4u){0u, 0u, 0u, 0u}; } }
}

__device__ __forceinline__ void tp_level1_consumer(Frame& F, ArgP A, int layer) {
    unsigned char* ws = F.ws;
    const int lane = F.lane, slot = F.wave & 3; const bool producer = F.wave >= 4;
    constexpr int BUFB = TP_TB * 1280 + TP_TB * 256, NB = TP_LC / TP_TB;
    LAS unsigned char* wl = F.lds + RING_OFF + slot * (2 * BUFB); LAS int* fl = (LAS int*)(F.lds + L1FLAG_OFF);
    const int nconv = layer ? N_CONV_L1 : N_CONV_L0; int cit = F.vcu * 4 + slot; const int cstep = F.G * 4;
    const int nrounds = (32 * TP_NC + F.G * 4 - 1) / (F.G * 4);
#pragma unroll 1
    for (int rd = 0; rd < nrounds; ++rd) {
        const int u = (rd * F.G + F.vcu) * 4 + slot; const bool act = u < 32 * TP_NC;
        __syncthreads(); if (F.tid < 8) fl[F.tid] = 0; __syncthreads();
        const int bh = act ? (u >> 5) : 0, c = u & 31, b = bh >> 4, h = bh & 15; const size_t m0 = (size_t)b * T + (size_t)c * TP_LC; const int col = h * 64, ch = col + lane;
            float* Yout = (float*)(ws + WS_Y); float* Qout = (float*)(ws + (layer ? WS_TPQ1 : WS_TPQ0)); float* Zout = (float*)(ws + WS_TPZ); float* Pout = (float*)(ws + WS_TPP);
            float SR[64], SI[64]; int ln = lane; asm volatile("" : "+v"(ln));
#pragma unroll
            for (int k = 0; k < 64; ++k) { SR[k] = 0.f; SI[k] = (k == ln) ? 1.f : 0.f; }
            const int l16 = (lane & 15) * 4;
#pragma unroll 1
            for (int n = 0; n < NB; ++n) {
                if (act) { const size_t mb = m0 + (size_t)n * TP_TB; const LAS unsigned char* lb = wl + (n & 1) * BUFB;
                    while (*(volatile LAS int*)(fl + slot) < n + 1) __builtin_amdgcn_s_sleep(2);
                    asm volatile("" ::: "memory");
#pragma unroll
                    for (int s2 = 0; s2 < TP_TB; ++s2) {
                        const LAS unsigned char* ls = lb + s2 * 1280 + l16;
#define LDQ(arr, q) (*(const LAS float*)(ls + (arr) * 256 + (q) * 64))
                        const float aq0 = LDQ(0, 0), aq1 = LDQ(0, 1), aq2 = LDQ(0, 2), aq3 = LDQ(0, 3), wq0 = LDQ(1, 0), wq1 = LDQ(1, 1), wq2 = LDQ(1, 2), wq3 = LDQ(1, 3);
                        const float bq0 = LDQ(2, 0), bq1 = LDQ(2, 1), bq2 = LDQ(2, 2), bq3 = LDQ(2, 3), kq0 = LDQ(3, 0), kq1 = LDQ(3, 1), kq2 = LDQ(3, 2), kq3 = LDQ(3, 3);
                        const float rq0 = LDQ(4, 0), rq1 = LDQ(4, 1), rq2 = LDQ(4, 2), rq3 = LDQ(4, 3);
#undef LDQ
                        const float vcur = *(const LAS float*)(lb + TP_TB * 1280 + s2 * 256 + lane * 4);
                        float sar0 = 0.f, sar1 = 0.f, sar2 = 0.f, sar3 = 0.f, sai0 = 0.f, sai1 = 0.f, sai2 = 0.f, sai3 = 0.f;
                        L1_PASS1
                        const float sar = (sar0 + sar1) + (sar2 + sar3), sai = (sai0 + sai1) + (sai2 + sai3);
                        float yr0 = 0.f, yr1 = 0.f, yr2 = 0.f, yr3 = 0.f, yi0 = 0.f, yi1 = 0.f, yi2 = 0.f, yi3 = 0.f;
                        L1_PASS2
                        Yout[(mb + s2) * C + col + lane] = (yr0 + yr1) + (yr2 + yr3);
                        Qout[((size_t)bh * T + (size_t)c * TP_LC + n * TP_TB + s2) * 64 + lane] = (yi0 + yi1) + (yi2 + yi3);
                    }
                    asm volatile("s_waitcnt lgkmcnt(0)" ::: "memory"); if (lane == 0) *(volatile LAS int*)(fl + 4 + slot) = n + 1; } }
            if (act) {
#pragma unroll
                for (int k = 0; k < 64; ++k) { const size_t zo = (((size_t)bh * TP_NC + c) * 64 + k) * 64 + lane;
                    Zout[zo] = SR[k]; Pout[zo] = SI[k]; } }
    }
}

__device__ __forceinline__ void tp_level1_fused(Frame& F, ArgP A, int layer) {
    if (F.wave >= 4) tp_level1_producer(F, A, layer); else tp_level1_consumer(F, A, layer);
}

__device__ __forceinline__ void tp_level2(Frame& F, int layer) {
    unsigned char* ws = F.ws; const float* TPP = (const float*)(ws + WS_TPP); const float* TPZ = (const float*)(ws + WS_TPZ); float* SC = (float*)(ws + WS_TPS + (layer ? 16 * MiB : 0));
    LAS float* PL = (LAS float*)(F.lds + RING_OFF);
    for (int u = F.vcu; u < 256; u += F.G) { const int bh = u >> 3, v = (u & 7) * 8 + F.wave;
        float S = 0.f; SC[(((size_t)bh * TP_NC + 0) * 64 + v) * 64 + F.lane] = 0.f;
        float pa[8], pb[8], za, zb;
#define L2_LOAD(P_, Z_, c_) do { Z_ = TPZ[(((size_t)bh * TP_NC + (c_)) * 64 + F.lane) * 64 + v]; \
            _Pragma("unroll") for (int q = 0; q < 8; ++q) P_[q] = TPP[((size_t)bh * TP_NC + (c_)) * 4096 + F.tid + 512 * q]; } while (0)
#define L2_STEP(P_, Z_, c_) do { LAS float* Pc = PL + ((c_) & 1) * (64 * 65); \
            _Pragma("unroll") for (int q = 0; q < 8; ++q) { const int idx = F.tid + 512 * q; Pc[(idx >> 6) * 65 + (idx & 63)] = P_[q]; } \
            const float z = Z_; \
            __syncthreads(); \
            if ((c_) + 2 < TP_NC - 1) L2_LOAD(P_, Z_, (c_) + 2); \
            float a0 = z, a1 = 0.f, a2 = 0.f, a3 = 0.f; const LAS float* prow = Pc + F.lane * 65; \
            _Pragma("unroll") for (int i = 0; i < 64; i += 4) { \
                a0 = fmaf(__int_as_float(__builtin_amdgcn_readlane(__float_as_int(S), i)), prow[i], a0); a1 = fmaf(__int_as_float(__builtin_amdgcn_readlane(__float_as_int(S), i + 1)), prow[i + 1], a1); \
                a2 = fmaf(__int_as_float(__builtin_amdgcn_readlane(__float_as_int(S), i + 2)), prow[i + 2], a2); a3 = fmaf(__int_as_float(__builtin_amdgcn_readlane(__float_as_int(S), i + 3)), prow[i + 3], a3); } \
            S = (a0 + a1) + (a2 + a3); SC[(((size_t)bh * TP_NC + (c_) + 1) * 64 + v) * 64 + F.lane] = S; } while (0)
        L2_LOAD(pa, za, 0); L2_LOAD(pb, zb, 1);
#pragma unroll 1
        for (int c = 0; c + 1 < TP_NC; c += 2) { L2_STEP(pa, za, c); if (c + 2 < TP_NC) L2_STEP(pb, zb, c + 1); }
#undef L2_LOAD
#undef L2_STEP
        __syncthreads();
    }
}
__device__ __forceinline__ void tp_level3_post(Frame& F, ArgP A, int layer) {
    unsigned char* ws = F.ws; const float* SC = (const float*)(ws + WS_TPS + (layer ? 16 * MiB : 0)); const float* Q = (const float*)(ws + (layer ? WS_TPQ1 : WS_TPQ0)); const float* Y = (const float*)(ws + WS_Y);
    const float* SV = (const float*)(ws + WS_SV); const bf16* lo = (const bf16*)(ws + WS_LORAO); const float* bonus = (const float*)(ws + WS_BONUS); bf16* cc = (bf16*)(ws + WS_CONCAT);
    const float* gng = A->in[18] + layer * C; const float* gnb = A->in[19] + layer * C;
    const int lane = F.lane; constexpr int TB3 = 8, NB3 = 64 / TB3;
    LAS unsigned char* wl = F.lds + RING_OFF + F.wave * (2 * TB3 * 256);
    const int half = F.wave >> 2;
#pragma unroll 1
    for (int u = F.vcu * 4 + (F.wave & 3); u < 32 * TP_NC; u += F.G * 4) { const int bh = u >> 5, c = u & 31; const bool corr = c != 0;
        float R[64];
        if (corr) { const f32x4* rp = (const f32x4*)(SC + (((size_t)bh * TP_NC + c) * 64 + lane) * 64);
#pragma unroll
            for (int i = 0; i < 16; ++i) { const f32x4 x = rp[i]; R[4 * i] = x[0]; R[4 * i + 1] = x[1]; R[4 * i + 2] = x[2]; R[4 * i + 3] = x[3]; } }
        else {
#pragma unroll
            for (int i = 0; i < 64; ++i) R[i] = 0.f; }
        const int l16 = (lane & 15) * 4;
        const int b = bh >> 4, h = bh & 15, col = h * 64 + lane; const size_t m0 = (size_t)b * T + (size_t)c * TP_LC + half * 64; const float* qb = Q + ((size_t)bh * T + (size_t)c * TP_LC + half * 64) * 64;
        const float gg = gng[col], gb = gnb[col];
        int vz; asm volatile("v_mov_b32 %0, 0" : "=v"(vz));
        float ya[TB3], va[TB3], ga[TB3], ba[TB3], yb[TB3], vb[TB3], gbv[TB3], bb[TB3];
#define L3_LOADV(Y_, V_, G_, B_, n_) do { _Pragma("unroll") for (int s2 = 0; s2 < TB3; ++s2) { const size_t m = m0 + (size_t)(n_) * TB3 + s2; Y_[s2] = Y[m * C + col]; V_[s2] = SV[m * C + col]; G_[s2] = bflo((unsigned)lo[m * 4096 + 2048 + col]); B_[s2] = bonus[m * 16 + h + vz]; } } while (0)
#define L3_DMA(n_) do { LAS unsigned char* lw_ = wl + ((n_) & 1) * (TB3 * 256); _Pragma("unroll") for (int i = 0; i < 2; ++i) __builtin_amdgcn_global_load_lds((const unsigned*)(qb + (size_t)(n_) * TB3 * 64 + i * 256 + lane * 4), (LAS unsigned*)(lw_ + i * 1024), 16, 0, 0); } while (0)
#define L3_BLOCK(Y_, V_, G_, B_, Yn_, Vn_, Gn_, Bn_, n_) do { \
            if ((n_) + 1 < NB3) L3_LOADV(Yn_, Vn_, Gn_, Bn_, (n_) + 1); \
              \
            if ((n_) == 0) asm volatile("s_waitcnt vmcnt(32)" ::: "memory"); else if ((n_) + 1 < NB3) asm volatile("s_waitcnt vmcnt(40)" ::: "memory"); else asm volatile("s_waitcnt vmcnt(8)" ::: "memory"); \
            if ((n_) + 1 < NB3) L3_DMA((n_) + 1); \
            const LAS unsigned char* lb = wl + ((n_) & 1) * (TB3 * 256); const size_t mb = m0 + (size_t)(n_) * TB3; \
            _Pragma("unroll") for (int s2 = 0; s2 < TB3; ++s2) { const LAS unsigned char* lq_ = lb + s2 * 256 + l16; float a0 = 0.f, a1 = 0.f, a2 = 0.f, a3 = 0.f; \
                if (corr) { const float qq0 = *(const LAS float*)(lq_), qq1 = *(const LAS float*)(lq_ + 64), qq2 = *(const LAS float*)(lq_ + 128), qq3 = *(const LAS float*)(lq_ + 192); L3_DOT } \
                const float y = Y_[s2] + ((a0 + a1) + (a2 + a3)); \
                const float mean = wave_bcast63(wave_total63(y)) * (1.0f / 64.0f); const float d = y - mean; const float var = wave_bcast63(wave_total63(d * d)) * (1.0f / 64.0f); const float rs = rsqrtf(var + 64e-5f); \
                const float o = (d * rs * gg + gb + B_[s2] * V_[s2]) * G_[s2]; \
                cc[(mb + s2) * 2048 + col] = (bf16)f2bf(o); } } while (0)
        asm volatile("s_waitcnt vmcnt(0)" ::: "memory");
        L3_LOADV(ya, va, ga, ba, 0); L3_DMA(0);
#pragma unroll 1
        for (int n = 0; n < NB3; n += 2) { L3_BLOCK(ya, va, ga, ba, yb, vb, gbv, bb, n); L3_BLOCK(yb, vb, gbv, bb, ya, va, ga, ba, n + 1); }
#undef L3_LOADV
#undef L3_DMA
#undef L3_BLOCK
    }
}
__device__ __forceinline__ f32x4 ld_bf4(const bf16* p) { const v2u r = *(const GAS v2u*)p; return (f32x4){bflo(r.x), bfhi(r.x), bflo(r.y), bfhi(r.y)}; }
__device__ __forceinline__ void post_attn(Frame& F, ArgP A, int layer) {
    unsigned char* ws = F.ws; bf16* cc = (bf16*)(ws + WS_CONCAT); const bf16* ob = (const bf16*)(ws + WS_OB); const float* sg = A->in[26] + layer * 128;
    const float lam_init = layer ? (0.8f - 0.6f * 0.74081822068171788f) : 0.2f;
    const float s1 = red64(A->in[22][layer * 64 + F.lane] * A->in[23][layer * 64 + F.lane]), s2 = red64(A->in[24][layer * 64 + F.lane] * A->in[25][layer * 64 + F.lane]);
    const float lam = expf(s1) - expf(s2) + lam_init;
    const int gw = F.vcu * NWAVES + F.wave, NGW = F.G * NWAVES;
    for (int m = gw; m < NTOK; m += NGW) {
#pragma unroll
        for (int j = 0; j < 4; ++j) { const int hd = j * 2 + (F.lane >> 5), e0 = (F.lane & 31) * 4; const size_t o = (size_t)m * 1024 + hd * 128 + e0;
            const f32x4 o0 = ld_bf4(ob + o), o1 = ld_bf4(ob + (size_t)NTOK * 1024 + o); const f32x4 d = o0 - o1 * lam;
            const float ss = red32((d[0] * d[0] + d[1] * d[1]) + (d[2] * d[2] + d[3] * d[3])); const float rs = rsqrtf(ss * (1.0f / 128.0f) + 1e-6f) * (1.0f - lam_init);
            const f32x4 gv = *(const f32x4*)(sg + e0);
            *(GAS v2u*)(cc + (size_t)m * 2048 + 1024 + hd * 128 + e0) = (v2u){pk2(d[0] * rs * gv[0], d[1] * rs * gv[1]), pk2(d[2] * rs * gv[2], d[3] * rs * gv[3])}; }
    }
}

__device__ __forceinline__ void attn_phase_all(Frame& F, char* ldsc) {
    unsigned char* ws = F.ws; const attn_body::bf16* proj = (const attn_body::bf16*)(ws + WS_PROJ); attn_body::bf16* ob = (attn_body::bf16*)(ws + WS_OB);
    const int per = (F.G == 256) ? 4 : 0;
    for (int i = 0;; ++i) { int inst, qb;
        if (per) { if (i >= 4) break; const int s = F.vcu & 3; inst = F.vcu >> 2; qb = (i == 0) ? 15 - s : (i == 1) ? 8 + s : (i == 2) ? 7 - s : s; }
        else { const int L = i * F.G + F.vcu; if (L >= 1024) break; inst = L >> 4; qb = 15 - (L & 15); }
        const int b = inst >> 5, h = (inst >> 2) & 7, c = (inst >> 1) & 1, e = inst & 1;
        attn_body::attn_unit<8>(b, qb, proj + PC_Q + h * 128 + c * 64, proj + PC_KA + h * 128 + c * 64, proj + PC_VA + h * 128 + e * 64, ob + (size_t)c * NTOK * 1024 + h * 128 + e * 64, ldsc);
    }
}

typedef float f32x16 __attribute__((ext_vector_type(16)));
__device__ __forceinline__ void router_phase(Frame& F, ArgP A, int layer, const bf16* hcur) {
    unsigned char* ws = F.ws;
    const float* rw = (const float*)(ws + WS_RW) + (size_t)layer * 36 * D; const float* brg = A->in[29] + layer * 4; const float* bre = A->in[31] + layer * 32;
    int* toke = (int*)(ws + WS_TOKE); float* tokw = (float*)(ws + WS_TOKW); int* tokr = (int*)(ws + WS_TOKR); float* rstd2 = (float*)(ws + WS_RSTD2); int* cnt = (int*)(ws + WS_CNT);
    constexpr int ST = 260;
    LAS float* HS = (LAS float*)(F.lds + RING_OFF);
    LAS float* WT = (LAS float*)(F.lds + RING_OFF + 33280);
    LAS float* RED = (LAS float*)(F.lds + RING_OFF);
    LAS float* GRED = (LAS float*)(F.lds + RING_OFF + 73728);
    LAS float* lg = (LAS float*)(F.lds + RING_OFF + 90 * 1024);
    const int tok = F.tid & 31, ks = F.tid >> 5, r32 = F.lane & 31, hi = F.lane >> 5;
    for (int tile = F.vcu; tile < NTOK / 32; tile += F.G) { const int m0 = tile * 32;
        f32x16 acc = (f32x16){0.f, 0.f, 0.f, 0.f, 0.f, 0.f, 0.f, 0.f, 0.f, 0.f, 0.f, 0.f, 0.f, 0.f, 0.f, 0.f}; float g0 = 0.f, g1 = 0.f, g2 = 0.f, g3 = 0.f, ssq = 0.f;
        v2u ph[4]; f32x4 pw[5];
#define RT_LOAD(kc_) do { const int k0_ = (kc_) * 256; \
            _Pragma("unroll") for (int q = 0; q < 4; ++q) { const int idx = F.tid + 512 * q, row = idx >> 6, c4 = idx & 63; ph[q] = *(const GAS v2u*)(hcur + (size_t)(m0 + row) * D + k0_ + c4 * 4); } \
            _Pragma("unroll") for (int q = 0; q < 5; ++q) { const int idx = F.tid + 512 * q; if (idx < 36 * 64) { const int row = idx >> 6, c4 = idx & 63; pw[q] = *(const f32x4*)(rw + (size_t)row * D + k0_ + c4 * 4); } } } while (0)
        RT_LOAD(0);
#pragma unroll 1
        for (int kc = 0; kc < 8; ++kc) {
            __syncthreads();
#pragma unroll
            for (int q = 0; q < 4; ++q) { const int idx = F.tid + 512 * q, row = idx >> 6, c4 = idx & 63; *(LAS f32x4*)(HS + row * ST + c4 * 4) = (f32x4){bflo(ph[q].x), bfhi(ph[q].x), bflo(ph[q].y), bfhi(ph[q].y)}; }
#pragma unroll
            for (int q = 0; q < 5; ++q) { const int idx = F.tid + 512 * q; if (idx < 36 * 64) { const int row = idx >> 6, c4 = idx & 63; *(LAS f32x4*)(WT + row * ST + c4 * 4) = pw[q]; } }
            __syncthreads();
            if (kc + 1 < 8) RT_LOAD(kc + 1);
#pragma unroll
            for (int q = 0; q < 4; ++q) { const int kb = 32 * F.wave + 8 * q + 4 * hi; const f32x4 a4 = *(const LAS f32x4*)(HS + r32 * ST + kb), b4 = *(const LAS f32x4*)(WT + r32 * ST + kb);
#pragma unroll
                for (int e = 0; e < 4; ++e) acc = __builtin_amdgcn_mfma_f32_32x32x2f32(a4[e], b4[e], acc, 0, 0, 0); }
#pragma unroll
            for (int q = 0; q < 4; ++q) { const int kb = 16 * ks + 4 * q; const f32x4 x4 = *(const LAS f32x4*)(HS + tok * ST + kb);
                const f32x4 w0 = *(const LAS f32x4*)(WT + 32 * ST + kb), w1 = *(const LAS f32x4*)(WT + 33 * ST + kb), w2 = *(const LAS f32x4*)(WT + 34 * ST + kb), w3 = *(const LAS f32x4*)(WT + 35 * ST + kb);
#pragma unroll
                for (int e = 0; e < 4; ++e) { g0 = fmaf(x4[e], w0[e], g0); g1 = fmaf(x4[e], w1[e], g1); g2 = fmaf(x4[e], w2[e], g2); g3 = fmaf(x4[e], w3[e], g3); ssq = fmaf(x4[e], x4[e], ssq); } }
        }
#undef RT_LOAD
        __syncthreads();
#pragma unroll
        for (int r = 0; r < 16; ++r) RED[(F.wave * 32 + (r & 3) + 8 * (r >> 2) + 4 * hi) * 33 + r32] = acc[r];
        { LAS float* gp = GRED + (ks * 32 + tok) * 5; gp[0] = g0; gp[1] = g1; gp[2] = g2; gp[3] = g3; gp[4] = ssq; }
        __syncthreads();
        for (int idx = F.tid; idx < 1024; idx += 512) { const int i = idx >> 5, j = idx & 31; float sum = 0.f;
#pragma unroll
            for (int w = 0; w < 8; ++w) sum += RED[(w * 32 + i) * 33 + j];
            lg[i * 40 + 4 + j] = sum; }
        if (F.tid < 160) { const int tk = F.tid / 5, c = F.tid % 5; float sum = 0.f;
#pragma unroll
            for (int q = 0; q < 16; ++q) sum += GRED[(q * 32 + tk) * 5 + c];
            lg[tk * 40 + (c < 4 ? c : 36)] = sum; }
        __syncthreads();
        if (F.wave == 0) { const bool act = F.lane < 32; const int tk = F.lane & 31; const int m = m0 + tk;
            const float rs = rsqrtf(lg[tk * 40 + 36] * (1.0f / 2048.0f) + 1e-6f);
            float l0 = lg[tk * 40 + 0] * rs + brg[0], l1 = lg[tk * 40 + 1] * rs + brg[1], l2 = lg[tk * 40 + 2] * rs + brg[2], l3 = lg[tk * 40 + 3] * rs + brg[3];
            int grp = 0; float lm = l0; if (l1 > lm) { lm = l1; grp = 1; } if (l2 > lm) { lm = l2; grp = 2; } if (l3 > lm) { lm = l3; grp = 3; }
            const float gp = 1.0f / (__expf(l0 - lm) + __expf(l1 - lm) + __expf(l2 - lm) + __expf(l3 - lm));
            int i1 = 0, i2 = 0; float b1 = -3.0e38f, b2 = -3.0e38f;
#pragma unroll
            for (int q = 0; q < 8; ++q) { const float v = lg[tk * 40 + 4 + grp * 8 + q] * rs + bre[grp * 8 + q];
                if (v > b1) { b2 = b1; i2 = i1; b1 = v; i1 = q; } else if (v > b2) { b2 = v; i2 = q; } }
            const float ex = __expf(b2 - b1); const float p1 = 1.0f / (1.0f + ex), p2 = ex / (1.0f + ex);
            const int e1 = grp * 8 + i1, e2 = grp * 8 + i2; int r1 = 0, r2 = 0, mycnt = 0;
            const unsigned long long lt = (1ull << tk) - 1ull;
#pragma unroll 1
            for (int e = 0; e < 32; ++e) { const unsigned long long bm = __ballot(act && (e1 == e || e2 == e)) & 0xffffffffull;
                if (e1 == e) r1 = __popcll(bm & lt); if (e2 == e) r2 = __popcll(bm & lt); if (tk == e) mycnt = __popcll(bm); }
            if (act) { toke[m * 2] = e1; toke[m * 2 + 1] = e2; tokw[m * 2] = gp * p1; tokw[m * 2 + 1] = gp * p2; tokr[m * 2] = r1; tokr[m * 2 + 1] = r2; rstd2[m] = rs; cnt[tile * 32 + tk] = mycnt; }
        }
    }
}

__device__ __forceinline__ void moe_meta(Frame& F, int mytile) {
    LAS int* meta = (LAS int*)(F.lds + META_OFF); LAS int* poff = meta, *tot = meta + 33, *base = meta + 65, *tile_e = meta + 97, *ntl = meta + 193; LAS int* tmp = meta + 256;
    const int* cnt = (const int*)(F.ws + WS_CNT);
    __syncthreads();
    { const int e = F.tid & 31, p = F.tid >> 5; int t = 0, bs = 0;
#pragma unroll 4
      for (int q = 0; q < 16; ++q) { const int b = p * 16 + q; const int c = cnt[b * 32 + e]; t += c; bs += (b < mytile) ? c : 0; }
      tmp[p * 32 + e] = t; tmp[512 + p * 32 + e] = bs; }
    __syncthreads();
    if (F.tid < 32) { int t = 0, bs = 0; for (int p = 0; p < 16; ++p) { t += tmp[p * 32 + F.tid]; bs += tmp[512 + p * 32 + F.tid]; } tot[F.tid] = t; base[F.tid] = bs; }
    __syncthreads();
    if (F.tid == 0) { int o = 0, nt = 0; for (int e = 0; e < 32; ++e) { poff[e] = o; const int np = (tot[e] + 255) >> 8; for (int q = 0; q < np; ++q) tile_e[nt++] = e; o += np * 256; } poff[32] = o; *ntl = nt; }
    __syncthreads();
}
__device__ __forceinline__ void gather_phase(Frame& F) {
    unsigned char* ws = F.ws; LAS int* meta = (LAS int*)(F.lds + META_OFF); LAS int* poff = meta, *base = meta + 65;
    const int* toke = (const int*)(ws + WS_TOKE); const float* tokw = (const float*)(ws + WS_TOKW); const int* tokr = (const int*)(ws + WS_TOKR); const float* rstd2 = (const float*)(ws + WS_RSTD2);
    int* toks = (int*)(ws + WS_TOKS); float* srs = (float*)(ws + WS_SRS); float* swt = (float*)(ws + WS_SWT); int* slottok = (int*)(ws + WS_SLOTTOK);
    for (int tile = F.vcu; tile < NTOK / 32; tile += F.G) {
        moe_meta(F, tile);
        if (F.tid < 64) { const int tk = F.tid >> 1, j = F.tid & 1, m = tile * 32 + tk; const int e = toke[m * 2 + j]; const int slot = poff[e] + base[e] + tokr[m * 2 + j];
            toks[m * 2 + j] = slot; slottok[slot] = m; srs[slot] = rstd2[m]; swt[slot] = tokw[m * 2 + j]; }
    }
}
__device__ __forceinline__ void combine_phase(Frame& F, const bf16* hsrc, bf16* hbdst) {
    unsigned char* ws = F.ws; const int* toks = (const int*)(ws + WS_TOKS); const bf16* os = (const bf16*)(ws + WS_OSLOT);
    const int gw = F.vcu * NWAVES + F.wave, NGW = F.G * NWAVES;
    for (int m = gw; m < NTOK; m += NGW) { const int s0 = toks[m * 2], s1 = toks[m * 2 + 1];
#pragma unroll
        for (int p = 0; p < 4; ++p) { const int c0 = (F.lane + 64 * p) * 8; const v4u a = *(const GAS v4u*)(os + (size_t)s0 * D + c0), b = *(const GAS v4u*)(os + (size_t)s1 * D + c0), g = *(const GAS v4u*)(hsrc + (size_t)m * D + c0);
            *(GAS v4u*)(hbdst + (size_t)m * D + c0) = (v4u){pk2(bflo(g.x) + (bflo(a.x) + bflo(b.x)), bfhi(g.x) + (bfhi(a.x) + bfhi(b.x))), pk2(bflo(g.y) + (bflo(a.y) + bflo(b.y)), bfhi(g.y) + (bfhi(a.y) + bfhi(b.y))),
                                                             pk2(bflo(g.z) + (bflo(a.z) + bflo(b.z)), bfhi(g.z) + (bfhi(a.z) + bfhi(b.z))), pk2(bflo(g.w) + (bflo(a.w) + bflo(b.w)), bfhi(g.w) + (bfhi(a.w) + bfhi(b.w)))}; } }
}

#ifndef PHMASK
#define PHMASK 0x7FFF
#endif
#define PHBIT(k) ((k) == 0 ? 0 : (((k) - 1) % NPH_LAYER) + 1)
#define IN(k) (lo <= (k) && (k) < hi && ((PHMASK >> PHBIT(k)) & 1))
#define SEAM(k) do { if (IN(k) && IN((k) + 1)) { ArgP A_ = get_args(); XcdBarrier b_; b_.bar = (unsigned*)(A_->ws + WS_CTL) + CW_BAR; b_.x = xb_xcc_id(); b_.st = (volatile LAS unsigned*)((LAS unsigned char*)lds_dyn + MISC_OFF) + 8; xcd_barrier(b_); } } while (0)
#define PHASE_BEGIN ArgP A = get_args(); unsigned char* ws = A->ws; Frame F = mk_frame(ws);
#ifndef PROBE_SET
#define PROBE_SET 0
#endif
#ifndef PROBE_MULT
#define PROBE_MULT 4
#endif
#define PRB_ON(bit) ((PROBE_SET >> (bit)) & 1)
#define PRB_T0(bit) unsigned long long prb_t0_ = 0; if (PRB_ON(bit)) prb_t0_ = __builtin_amdgcn_s_memrealtime();
#define PRB_T1(bit) if (PRB_ON(bit)) prb_acc += __builtin_amdgcn_s_memrealtime() - prb_t0_;

template <int layer> __device__ __forceinline__ void run_layer(const int lo, const int hi, unsigned long long& prb_acc) {
        const int pb = 1 + layer * NPH_LAYER;
        { PRB_T0(1)
        if (IN(pb + 0)) { PHASE_BEGIN bf16* hb_in = (bf16*)(ws + (layer ? WS_HBB : WS_HBA));
            pg8::Gemm g{hb_in, (const bf16*)(ws + WS_WIN) + (size_t)layer * PPITCH * D, NTOK, PPITCH, D, D}; pg8::WinMainOrder S; S.init(NTOK, PPITCH - 512, F.G, (int)blockIdx.x);
            LAS float* rstab = (LAS float*)(F.lds + RSTAB_OFF);
            { const float* part = (const float*)(ws + WS_PART); pg8::Unit uu;
              for (int i = 0; i < 4 && S.next(i, uu); ++i) { if (F.tid < 256) { const f32x4* pp = (const f32x4*)(part + (size_t)(uu.pm * 256 + F.tid) * 32); f32x4 sm = pp[0];
#pragma unroll
                      for (int j = 1; j < 8; ++j) sm = sm + pp[j];
                      rstab[i * 256 + F.tid] = rsqrtf(((sm[0] + sm[1]) + (sm[2] + sm[3])) * (1.0f / 2048.0f) + 1e-6f); } }
              __syncthreads(); }
            pg8::EpiProj E{(bf16*)(ws + WS_PROJ), PPITCH, (const PG8_LAS float*)rstab, (float*)(ws + WS_RSTD1)};
            pg8::gemm_phase<pg8::EpiProj, pg8::WinMainOrder, PG8_ALIGN, PG8_SP2>(F.lds + RING_OFF, g, S, E); }
        if (IN(pb + 0)) { PHASE_BEGIN bf16* hb_in = (bf16*)(ws + (layer ? WS_HBB : WS_HBA));
            pg8::Gemm g{hb_in, (const bf16*)(ws + WS_WIN) + (size_t)layer * PPITCH * D, NTOK, 512, 512, D}; pg8::WinLoraOrder S; S.G = F.G; S.c = F.vcu;
            pg8::EpiPartF32 E{(float*)(ws + WS_LORAO), NTOK};
            pg8::gemm_phase<pg8::EpiPartF32, pg8::WinLoraOrder, PG8_ALIGN, PG8_SP2>(F.lds + RING_OFF, g, S, E); }
        SEAM(pb + 0); PRB_T1(1) }
        { PRB_T0(2)
        if (IN(pb + 1)) { PHASE_BEGIN prep1_phase(F, A, layer); }
        SEAM(pb + 1); PRB_T1(2) }
        { PRB_T0(3)
        if (IN(pb + 2)) { PHASE_BEGIN pg8::Gemm g{(const bf16*)(ws + WS_LORAA), (const bf16*)(ws + WS_WL2) + (size_t)layer * 4096 * LK, NTOK, 4096, 256, LK}; pg8::Lora2Order S; S.init(NTOK, 4096, F.G, (int)blockIdx.x);
            pg8::EpiBf16s E{(bf16*)(ws + WS_LORAO), 4096};
            pg8::gemm_phase<pg8::EpiBf16s, pg8::Lora2Order, PG8_ALIGN, PG8_SP2>(F.lds + RING_OFF, g, S, E); }
        SEAM(pb + 2); PRB_T1(3) }
        { PRB_T0(4)
#ifndef NOSCAN
        if (IN(pb + 3)) { PRB_T0(16) { PHASE_BEGIN tp_level1_fused(F, A, layer); __syncthreads(); } PRB_T1(16) }
#endif
#ifndef NOATTN
        if (IN(pb + 3)) { PRB_T0(17) { PHASE_BEGIN attn_phase_all(F, (char*)lds_dyn + RING_OFF); } PRB_T1(17) }
#endif
        SEAM(pb + 3); PRB_T1(4) }
        { PRB_T0(5)
        if (IN(pb + 4)) { PHASE_BEGIN tp_level2(F, layer); }
        SEAM(pb + 4); PRB_T1(5) }
        { PRB_T0(6)
        if (IN(pb + 5)) { PRB_T0(18) { PHASE_BEGIN tp_level3_post(F, A, layer); __syncthreads(); } PRB_T1(18) } if (IN(pb + 5)) { PRB_T0(19) { PHASE_BEGIN post_attn(F, A, layer); } PRB_T1(19) }
        SEAM(pb + 5); PRB_T1(6) }
        { PRB_T0(7)
        if (IN(pb + 6)) { PHASE_BEGIN bf16* hb_mid = (bf16*)(ws + (layer ? WS_HBA : WS_HBB));
            pg8::Gemm g{(const bf16*)(ws + WS_CONCAT), (const bf16*)(ws + WS_WOUT) + (size_t)layer * D * D, NTOK, D, D, D}; pg8::StaticOrder S; S.init(NTOK, D, F.G, (int)blockIdx.x);
            pg8::EpiResid E{layer ? (const float*)nullptr : A->in[0], (const bf16*)(ws + (layer ? WS_HBB : WS_HBA)), hb_mid};
            pg8::gemm_phase<pg8::EpiResid, pg8::StaticOrder, PG8_ALIGN, PG8_SP2>(F.lds + RING_OFF, g, S, E); }
        SEAM(pb + 6); PRB_T1(7) }
        { PRB_T0(8)
        if (IN(pb + 7)) { PHASE_BEGIN router_phase(F, A, layer, (const bf16*)(ws + (layer ? WS_HBA : WS_HBB))); }
        SEAM(pb + 7); PRB_T1(8) }
        { PRB_T0(9)
        if (IN(pb + 8)) { PHASE_BEGIN gather_phase(F); __syncthreads(); }
        if (IN(pb + 8)) { PHASE_BEGIN
            pg8::Gemm g{(const bf16*)(ws + WS_PB) + (size_t)layer * NTOK * 256, (const bf16*)(ws + WS_WPP) + (size_t)layer * D * 256, NTOK, D, 256, 256}; pg8::StaticOrder S; S.init(NTOK, D, F.G, (int)blockIdx.x);
            pg8::EpiBf16s E{(bf16*)(ws + WS_PPB), D};
            pg8::gemm_phase<pg8::EpiBf16s, pg8::StaticOrder, PG8_ALIGN, PG8_SP2>(F.lds + RING_OFF, g, S, E); }
        SEAM(pb + 8); PRB_T1(9) }
        { PRB_T0(10)
        if (IN(pb + 9)) { PHASE_BEGIN moe_meta(F, 0); LAS int* meta = (LAS int*)(F.lds + META_OFF); const int nt = __builtin_amdgcn_readfirstlane(meta[193]);
            pg8::Gemm g{(const bf16*)(ws + (layer ? WS_HBA : WS_HBB)), (const bf16*)(ws + WS_WGU), nt * 256, 1024, D, D}; pg8::MoeGatherOrder S; S.init(nt, 2, F.G, F.vcu); S.tile_e = (const PG8_LAS int*)(meta + 97); S.NE = 1024; S.slottok = (const int*)(ws + WS_SLOTTOK);
            pg8::EpiGLU E{(bf16*)(ws + WS_HG), (const float*)(ws + WS_SRS), (const float*)(ws + WS_SWT)};
            pg8::gemm_phase<pg8::EpiGLU, pg8::MoeGatherOrder, PG8_ALIGN, PG8_SP2>(F.lds + RING_OFF, g, S, E); }
        SEAM(pb + 9); PRB_T1(10) }
        { PRB_T0(11)
        if (IN(pb + 10)) { PHASE_BEGIN moe_meta(F, 0); LAS int* meta = (LAS int*)(F.lds + META_OFF); const int nt = __builtin_amdgcn_readfirstlane(meta[193]);
            pg8::Gemm g{(const bf16*)(ws + WS_HG), (const bf16*)(ws + WS_WD), nt * 256, D, DEXP, DEXP}; pg8::MoeOrder S; S.init(nt, 3, F.G, F.vcu); S.tile_e = (const PG8_LAS int*)(meta + 97); S.NE = D; S.slottok = nullptr;
            pg8::EpiBf16s E{(bf16*)(ws + WS_OSLOT), D};
            pg8::gemm_phase<pg8::EpiBf16s, pg8::MoeOrder, PG8_ALIGN, PG8_SP2>(F.lds + RING_OFF, g, S, E); }
        SEAM(pb + 10); PRB_T1(11) }
        { PRB_T0(12)
        if (IN(pb + 11)) { PHASE_BEGIN combine_phase(F, (const bf16*)(ws + (layer ? WS_HBA : WS_HBB)), (bf16*)(ws + (layer ? WS_HBB : WS_HBA))); }
        SEAM(pb + 11); PRB_T1(12) }
        { PRB_T0(13)
        if (IN(pb + 12)) { PHASE_BEGIN bf16* hb_in = (bf16*)(ws + (layer ? WS_HBB : WS_HBA)); bf16* hb_mid = (bf16*)(ws + (layer ? WS_HBA : WS_HBB));
            pg8::Gemm g{hb_in, (const bf16*)(ws + WS_WPG) + (size_t)layer * D * D, NTOK, D, D, D}; pg8::StaticOrder S; S.init(NTOK, D, F.G, (int)blockIdx.x);
            pg8::EpiPLE E{hb_in, hb_mid, layer ? A->out : (float*)nullptr, (const bf16*)(ws + WS_PPB), A->in[36] + layer * D, layer ? (float*)nullptr : (float*)(ws + WS_PART)};
            pg8::gemm_phase<pg8::EpiPLE, pg8::StaticOrder, PG8_ALIGN, PG8_SP2>(F.lds + RING_OFF, g, S, E); }
        SEAM(pb + 12); PRB_T1(13) }
    }

__global__ void __launch_bounds__(NWAVES * 64, 2) mk_fwd(Args args_unused) {
    { LAS unsigned char* l = (LAS unsigned char*)lds_dyn; const int t0 = threadIdx.x;
      for (int u = t0; u < (LDS_BYTES - LDSCTL_OFF) / 4; u += NWAVES * 64) ((LAS unsigned*)(l + LDSCTL_OFF))[u] = 0u; }
    __syncthreads();
    int lo, hi; { ArgP A = get_args(); lo = A->ph_lo; hi = A->ph_hi; }
    if (hi - lo > 1) { ArgP A = get_args(); (void)xcd_barrier_post((unsigned*)(A->ws + WS_CTL) + CW_BAR, (volatile LAS unsigned*)((LAS unsigned char*)lds_dyn + MISC_OFF) + 8); }
    unsigned long long prb_acc = 0ull;
    { PRB_T0(0) if (IN(0)) { PHASE_BEGIN p0_prologue(F, A); }
    SEAM(0); PRB_T1(0) }
    run_layer<0>(lo, hi, prb_acc);
    run_layer<1>(lo, hi, prb_acc);
    if (PROBE_SET) { const unsigned long long te = __builtin_amdgcn_s_memrealtime(); while (__builtin_amdgcn_s_memrealtime() - te < (unsigned long long)PROBE_MULT * prb_acc) __builtin_amdgcn_s_sleep(8); }
#undef IN
#undef SEAM
}

#ifndef MK_PER_PHASE
#define MK_PER_PHASE 0
#endif
extern "C" void kernel_launch(void* const* d_in, const int* in_sizes, int n_in, void* d_out, int out_size, void* d_ws, size_t ws_size, hipStream_t stream) {
    static int grid = 0;
    if (grid == 0) {
        if (n_in != 38 || out_size != NTOK * D || ws_size < WS_END) { fprintf(stderr, "kernel_launch: unexpected shapes (n_in %d out %d ws %zu need %zu)\n", n_in, out_size, ws_size, (size_t)WS_END); grid = -1; return; }
        int dev = 0, cus = 0, per_cu = 0;
        if (hipGetDevice(&dev) != hipSuccess || hipDeviceGetAttribute(&cus, hipDeviceAttributeMultiprocessorCount, dev) != hipSuccess) { grid = -1; return; }
        if (hipFuncSetAttribute((const void*)mk_fwd, hipFuncAttributeMaxDynamicSharedMemorySize, LDS_BYTES) != hipSuccess) { grid = -1; return; }
        if (hipOccupancyMaxActiveBlocksPerMultiprocessor(&per_cu, (const void*)mk_fwd, NWAVES * 64, LDS_BYTES) != hipSuccess || per_cu < 1) fprintf(stderr, "kernel_launch: occupancy query says %d\n", per_cu);
        (void)hipGetLastError();
        grid = cus;
    }
    if (grid < 0) return;
    if (hipMemsetAsync((char*)d_ws + WS_CTL, 0, CTL_ZERO_BYTES, stream) != hipSuccess) return;
    Args a{};
    for (int i = 0; i < 38; ++i) a.in[i] = (const float*)d_in[i];
    a.out = (float*)d_out; a.ws = (unsigned char*)d_ws;
#if MK_PER_PHASE
    for (int ph = 0; ph < NPHASES; ++ph) { a.ph_lo = ph; a.ph_hi = ph + 1; hipLaunchKernelGGL(mk_fwd, dim3(grid), dim3(NWAVES * 64), LDS_BYTES, stream, a); }
#else
    a.ph_lo = 0; a.ph_hi = NPHASES;
    hipLaunchKernelGGL(mk_fwd, dim3(grid), dim3(NWAVES * 64), LDS_BYTES, stream, a);
#endif
}
```

```cpp
#include <hip/hip_runtime.h>
#include <hip/hip_bf16.h>
#include <cstdio>
#include <cstdint>
namespace pg8 {
#define PG8_LAS __attribute__((address_space(3)))
typedef unsigned short bf16_t;
typedef short bf16x8 __attribute__((ext_vector_type(8)));
typedef float f32x4 __attribute__((ext_vector_type(4)));
typedef unsigned u32x4 __attribute__((ext_vector_type(4)));
constexpr int BM = 256, BK = 64, HALF = 128, HTB = HALF * BK * 2  , STAGE_BYTES = 8 * HTB, NXCD = 8, WGM = 8;

__host__ __device__ __forceinline__ int lds_byte(int r, int c) { const int st = (r >> 4) * 2 + (c >> 5), rr = r & 15, cc = c & 31, ob = rr * 64 + cc * 2; return st * 1024 + (ob ^ (((ob >> 9) & 1) << 5)); }
__host__ __device__ __forceinline__ void stage_rc(int b, int& R, int& C) { const int st = b / 1024, sb = b % 1024, swz = sb ^ (((sb >> 9) & 1) << 5); R = (st >> 1) * 16 + swz / 64; C = (st & 1) * 32 + (swz % 64) / 2; }
__host__ __device__ __forceinline__ int perm32(int rho) { const int n = rho >> 4, i = rho & 15; return 8 * (i >> 2) + 4 * n + (i & 3); }

struct Unit { int pm, pn, ord; };
struct Gemm { const bf16_t* A; const bf16_t* Bt; int M, N, K, ld; };

struct StaticOrder {
    static constexpr bool GATHER = false;
    int nM, nN, nwg, G, c;
    __host__ __device__ void init(int M, int N, int G_, int c_) { nM = M / BM; nN = N / BM; nwg = nM * nN; G = G_; c = c_; }
    __host__ __device__ bool next(int i, Unit& u) const {
        const long L = (long)i * G + c; if (L >= nwg) return false;
        int wgid = (int)L; { const int q = nwg / NXCD, r = nwg % NXCD, xcd = wgid % NXCD, off = wgid / NXCD; wgid = (xcd < r ? xcd * (q + 1) : r * (q + 1) + (xcd - r) * q) + off; }
        const int nig = WGM * nN, gid = wgid / nig, fm = gid * WGM, gsz = (nM - fm) < WGM ? (nM - fm) : WGM;
        u.pm = fm + ((wgid % nig) % gsz); u.pn = (wgid % nig) / gsz; u.ord = i; return true;
    }
    __device__ __forceinline__ void a_ready(const Unit&) const {}
    __device__ __forceinline__ void done(const Unit&) const {}
    __device__ __forceinline__ const char* aptr(const Gemm& g, const Unit& u, size_t tstep) const { return (const char*)g.A + (size_t)u.pm * tstep; }
    __device__ __forceinline__ const char* bptr(const Gemm& g, const Unit& u, size_t tstep) const { return (const char*)g.Bt + (size_t)u.pn * tstep; }
};
__device__ __forceinline__ unsigned cvt_pk_bf16(float lo, float hi) { unsigned r; asm volatile("v_cvt_pk_bf16_f32 %0, %1, %2" : "=v"(r) : "v"(lo), "v"(hi)); return r; }
typedef float f32x2 __attribute__((ext_vector_type(2)));


__device__ __forceinline__ u32x4 pack8(const f32x4& v0, const f32x4& v1) { u32x4 w; w.x = cvt_pk_bf16(v0[0], v0[1]); w.y = cvt_pk_bf16(v0[2], v0[3]); w.z = cvt_pk_bf16(v1[0], v1[1]); w.w = cvt_pk_bf16(v1[2], v1[3]); return w; }
__device__ __forceinline__ float bf_lo(unsigned u) { return __builtin_bit_cast(float, u << 16); }
__device__ __forceinline__ float bf_hi(unsigned u) { return __builtin_bit_cast(float, u & 0xffff0000u); }

struct EpiBf16s {
    static constexpr bool PERM = true, AFTER_DRAIN = false;
    bf16_t* O; int ldc;
    __device__ __forceinline__ void operator()(const f32x4 (&acc)[2][2][4][2], const Unit& u, int wr, int wc, int fr, int fq) const {
        const int row0 = u.pm * BM + wr * 64 + fr, col0 = u.pn * BM + wc * 32 + 8 * fq;
#pragma unroll
        for (int ai = 0; ai < 2; ++ai)
#pragma unroll
            for (int m = 0; m < 4; ++m) { bf16_t* rowp = O + (size_t)(row0 + ai * HALF + m * 16) * ldc + col0;
#pragma unroll
                for (int bj = 0; bj < 2; ++bj) *(u32x4*)(rowp + bj * HALF) = pack8(acc[ai][bj][m][0], acc[ai][bj][m][1]); }
    }
};
struct EpiProj {
    static constexpr bool PERM = true, AFTER_DRAIN = false;
    bf16_t* O; int ldc; const PG8_LAS float* rstab; float* rstd_out;
    __device__ __forceinline__ void operator()(const f32x4 (&acc)[2][2][4][2], const Unit& u, int wr, int wc, int fr, int fq) const {
        const int row0 = u.pm * BM + wr * 64 + fr, col0 = u.pn * BM + wc * 32 + 8 * fq; const PG8_LAS float* tb = rstab + u.ord * BM + wr * 64 + fr;
#pragma unroll
        for (int ai = 0; ai < 2; ++ai)
#pragma unroll
            for (int m = 0; m < 4; ++m) { const int row = row0 + ai * HALF + m * 16;
                const float rs = tb[ai * HALF + m * 16];
                if (u.pn == 0 && wc == 0 && fq == 0) rstd_out[row] = rs;
                bf16_t* rowp = O + (size_t)row * ldc + col0;
#pragma unroll
                for (int bj = 0; bj < 2; ++bj) *(u32x4*)(rowp + bj * HALF) = pack8(acc[ai][bj][m][0] * rs, acc[ai][bj][m][1] * rs); }
    }
};
struct EpiResid {
    static constexpr bool PERM = true, AFTER_DRAIN = false;
    const float* hin32; const bf16_t* hinb; bf16_t* hb;
    __device__ __forceinline__ void operator()(const f32x4 (&acc)[2][2][4][2], const Unit& u, int wr, int wc, int fr, int fq) const {
        const int row0 = u.pm * BM + wr * 64 + fr, col0 = u.pn * BM + wc * 32 + 8 * fq;
#pragma unroll
        for (int ai = 0; ai < 2; ++ai) { f32x4 a[4][2][2];
            if (hin32) {
#pragma unroll
                for (int m = 0; m < 4; ++m) { const size_t ro = (size_t)(row0 + ai * HALF + m * 16) * 2048 + col0;
#pragma unroll
                    for (int bj = 0; bj < 2; ++bj) { a[m][bj][0] = *(const f32x4*)(hin32 + ro + bj * HALF); a[m][bj][1] = *(const f32x4*)(hin32 + ro + bj * HALF + 4); } }
            } else { u32x4 q[4][2];
#pragma unroll
                for (int m = 0; m < 4; ++m) { const size_t ro = (size_t)(row0 + ai * HALF + m * 16) * 2048 + col0;
#pragma unroll
                    for (int bj = 0; bj < 2; ++bj) q[m][bj] = *(const u32x4*)(hinb + ro + bj * HALF); }
#pragma unroll
                for (int m = 0; m < 4; ++m)
#pragma unroll
                    for (int bj = 0; bj < 2; ++bj) { const u32x4 w = q[m][bj]; a[m][bj][0] = (f32x4){bf_lo(w.x), bf_hi(w.x), bf_lo(w.y), bf_hi(w.y)}; a[m][bj][1] = (f32x4){bf_lo(w.z), bf_hi(w.z), bf_lo(w.w), bf_hi(w.w)}; } }
#pragma unroll
            for (int m = 0; m < 4; ++m) { const size_t ro = (size_t)(row0 + ai * HALF + m * 16) * 2048 + col0;
#pragma unroll
                for (int bj = 0; bj < 2; ++bj) *(u32x4*)(hb + ro + bj * HALF) = pack8(a[m][bj][0] + acc[ai][bj][m][0], a[m][bj][1] + acc[ai][bj][m][1]); } }
    }
};
struct EpiPLE {
    static constexpr bool PERM = true, AFTER_DRAIN = false;
    const bf16_t* hin; bf16_t* hb; float* out32; const bf16_t* pp; const float* bg; float* part;
    __device__ __forceinline__ void operator()(const f32x4 (&acc)[2][2][4][2], const Unit& u, int wr, int wc, int fr, int fq) const {
        const int row0 = u.pm * BM + wr * 64 + fr, col0 = u.pn * BM + wc * 32 + 8 * fq;
        f32x4 bv[2][2];
#pragma unroll
        for (int bj = 0; bj < 2; ++bj) { bv[bj][0] = *(const f32x4*)(bg + col0 + bj * HALF); bv[bj][1] = *(const f32x4*)(bg + col0 + bj * HALF + 4); }
#pragma unroll
        for (int ai = 0; ai < 2; ++ai)
#pragma unroll
            for (int mh = 0; mh < 2; ++mh) { u32x4 hw[2][2], pw[2][2];
#pragma unroll
                for (int mm = 0; mm < 2; ++mm) { const size_t ro = (size_t)(row0 + ai * HALF + (2 * mh + mm) * 16) * 2048 + col0;
#pragma unroll
                    for (int bj = 0; bj < 2; ++bj) { hw[mm][bj] = *(const u32x4*)(hin + ro + bj * HALF); pw[mm][bj] = *(const u32x4*)(pp + ro + bj * HALF); } }
#pragma unroll
                for (int mm = 0; mm < 2; ++mm) { const int m = 2 * mh + mm, row = row0 + ai * HALF + m * 16; const size_t ro = (size_t)row * 2048 + col0; float ss = 0.f;
#pragma unroll
                    for (int bj = 0; bj < 2; ++bj) { const u32x4 q = pw[mm][bj], g = hw[mm][bj];
                        const f32x4 p0 = (f32x4){bf_lo(q.x), bf_hi(q.x), bf_lo(q.y), bf_hi(q.y)}, p1 = (f32x4){bf_lo(q.z), bf_hi(q.z), bf_lo(q.w), bf_hi(q.w)};
                        const f32x4 a0 = (f32x4){bf_lo(g.x), bf_hi(g.x), bf_lo(g.y), bf_hi(g.y)}, a1 = (f32x4){bf_lo(g.z), bf_hi(g.z), bf_lo(g.w), bf_hi(g.w)};
                        const f32x4 z0 = acc[ai][bj][m][0] + bv[bj][0], z1 = acc[ai][bj][m][1] + bv[bj][1]; f32x4 r0, r1;
#pragma unroll
                        for (int j = 0; j < 4; ++j) { r0[j] = a0[j] + p0[j] / (1.0f + __expf(-z0[j])); r1[j] = a1[j] + p1[j] / (1.0f + __expf(-z1[j])); ss += r0[j] * r0[j] + r1[j] * r1[j]; }
                        if (out32) { *(f32x4*)(out32 + ro + bj * HALF) = r0; *(f32x4*)(out32 + ro + bj * HALF + 4) = r1; }
                        else *(u32x4*)(hb + ro + bj * HALF) = pack8(r0, r1); }
                    ss += __shfl_xor(ss, 16); ss += __shfl_xor(ss, 32);
                    if (part != nullptr && fq == 0) part[(size_t)row * 32 + u.pn * 4 + wc] = ss; } }
    }
};
struct EpiGLU {
    static constexpr bool PERM = true, AFTER_DRAIN = false;
    bf16_t* HG; const float* ers; const float* ewt; const PG8_LAS int* tile_e; const PG8_LAS int* tbase;
    __device__ __forceinline__ void operator()(const f32x4 (&acc)[2][2][4][2], const Unit& u, int wr, int wc, int fr, int fq) const {
        const int row0 = u.pm * BM + wr * 64 + fr, col0 = u.pn * HALF + wc * 32 + 8 * fq;
        float rsv[2][4], wtv[2][4]; const int e_ = __builtin_amdgcn_readfirstlane(tile_e[u.pm]); const int xb = e_ * 8192 + (u.pm - __builtin_amdgcn_readfirstlane(tbase[e_])) * BM;
#pragma unroll
        for (int ai = 0; ai < 2; ++ai)
#pragma unroll
            for (int m = 0; m < 4; ++m) { const int x = xb + wr * 64 + fr + ai * HALF + m * 16; rsv[ai][m] = ers[x]; wtv[ai][m] = ewt[x]; }
#pragma unroll
        for (int ai = 0; ai < 2; ++ai)
#pragma unroll
            for (int m = 0; m < 4; ++m) { const int row = row0 + ai * HALF + m * 16; const float rs = rsv[ai][m], wt = wtv[ai][m]; f32x4 o0, o1;
#pragma unroll
                for (int j = 0; j < 4; ++j) { const float g0 = acc[ai][0][m][0][j] * rs, g1 = acc[ai][0][m][1][j] * rs, u0 = acc[ai][1][m][0][j] * rs, u1 = acc[ai][1][m][1][j] * rs;
                    o0[j] = g0 / (1.0f + __expf(-g0)) * u0 * wt; o1[j] = g1 / (1.0f + __expf(-g1)) * u1 * wt; }
                *(u32x4*)(HG + (size_t)row * 512 + col0) = pack8(o0, o1); }
    }
};
struct WinMainOrder : StaticOrder {
    __device__ __forceinline__ bool next(int i, Unit& u) const { if (!StaticOrder::next(i, u)) return false; if (u.pn >= 12) u.pn += 2; return true; }
};
struct Lora2Order : StaticOrder {
    __device__ __forceinline__ const char* aptr(const Gemm& g, const Unit& u, size_t tstep) const { return (const char*)g.A + (size_t)u.pm * tstep + ((u.pn >= 8) ? 256 : 0); }
    __device__ __forceinline__ const char* bptr(const Gemm& g, const Unit& u, size_t tstep) const { return (const char*)g.Bt + (size_t)u.pn * tstep + ((u.pn >= 8) ? 256 : 0); }
};
struct WinLoraOrder {
    static constexpr bool GATHER = false;
    int G, c;
    __device__ __forceinline__ bool next(int i, Unit& u) const { const int L = i * G + c; if (L >= 256) return false; u.pm = L >> 3; u.pn = 12 + ((L >> 2) & 1) + 16 * (L & 3); u.ord = i; return true; }
    __device__ __forceinline__ void a_ready(const Unit&) const {}
    __device__ __forceinline__ void done(const Unit&) const {}
    __device__ __forceinline__ const char* aptr(const Gemm& g, const Unit& u, size_t tstep) const { return (const char*)g.A + (size_t)u.pm * tstep + (size_t)(u.pn >> 4) * 512 * 2; }
    __device__ __forceinline__ const char* bptr(const Gemm& g, const Unit& u, size_t tstep) const { return (const char*)g.Bt + (size_t)(u.pn & 15) * tstep + (size_t)(u.pn >> 4) * 512 * 2; }
};
struct EpiPartF32 {
    static constexpr bool PERM = true, AFTER_DRAIN = false;
    float* LP; int M;
    __device__ __forceinline__ void operator()(const f32x4 (&acc)[2][2][4][2], const Unit& u, int wr, int wc, int fr, int fq) const {
        const int ks = u.pn >> 4, t = (u.pn & 15) - 12; const int row0 = u.pm * BM + wr * 64 + fr, col0 = t * BM + wc * 32 + 8 * fq;
#pragma unroll
        for (int ai = 0; ai < 2; ++ai)
#pragma unroll
            for (int m = 0; m < 4; ++m) { float* rowp = LP + ((size_t)ks * M + row0 + ai * HALF + m * 16) * 512 + col0;
#pragma unroll
                for (int bj = 0; bj < 2; ++bj) { *(f32x4*)(rowp + bj * HALF) = acc[ai][bj][m][0]; *(f32x4*)(rowp + bj * HALF + 4) = acc[ai][bj][m][1]; } }
    }
};
template <bool GATHER_> struct MoeOrderT {
    static constexpr bool GATHER = GATHER_;
    int lg, nunits, G, c; const PG8_LAS int* tile_e; int NE; const int* etok; const PG8_LAS int* tot; const PG8_LAS int* tbase;
    __device__ __forceinline__ void init(int ntiles, int lg_, int G_, int c_) { lg = lg_; nunits = ntiles << lg_; G = G_; c = c_; }
    __device__ __forceinline__ bool next(int i, Unit& u) const { const int L = i * G + c; if (L >= nunits) return false; u.pm = L >> lg; u.pn = L & ((1 << lg) - 1); u.ord = i; return true; }
    __device__ __forceinline__ void a_ready(const Unit&) const {}
    __device__ __forceinline__ void done(const Unit&) const {}
    __device__ __forceinline__ const char* aptr(const Gemm& g, const Unit& u, size_t tstep) const { return GATHER_ ? (const char*)g.A : (const char*)g.A + (size_t)u.pm * tstep; }
    __device__ __forceinline__ void rowoffs(const Gemm& g, const Unit& u, const int (&R)[2], const int (&Cc)[2], unsigned (&vo)[2][2]) const {
#pragma unroll
        for (int h = 0; h < 2; ++h)
#pragma unroll
            for (int i = 0; i < 2; ++i) { const int e = __builtin_amdgcn_readfirstlane(tile_e[u.pm]); const int idx = (u.pm - __builtin_amdgcn_readfirstlane(tbase[e])) * BM + h * HALF + R[i];
                const int tk = (idx < __builtin_amdgcn_readfirstlane(tot[e])) ? etok[e * 8192 + idx] : 0; vo[h][i] = (unsigned)(tk * g.ld + Cc[i]) * 2u; } }
    __device__ __forceinline__ const char* bptr(const Gemm& g, const Unit& u, size_t tstep) const { const int e = __builtin_amdgcn_readfirstlane(tile_e[u.pm]); return (const char*)g.Bt + ((size_t)e * NE + (size_t)u.pn * BM) * (size_t)g.ld * 2; }
};
typedef MoeOrderT<false> MoeOrder; typedef MoeOrderT<true> MoeGatherOrder;

template <class Epi, class Sched, bool ALIGN_EPI = false, bool SP2 = false>
__device__ __forceinline__ void gemm_phase(PG8_LAS unsigned char* lds, const Gemm g, const Sched& S, const Epi& E) {
    int tid_ = threadIdx.x; asm volatile("" : "+v"(tid_)); const int tid = tid_, wid = __builtin_amdgcn_readfirstlane(tid >> 6), lane = tid & 63, wr = wid >> 2, wc = wid & 3, fr = lane & 15, fq = lane >> 4;
    const int K = g.ld, nt = g.K / BK;
    unsigned voffA[2], voffB[2]; int RA[2], CA[2];
#pragma unroll
    for (int i = 0; i < 2; ++i) { int R, C; stage_rc(tid * 16 + i * 8192, R, C); RA[i] = R; CA[i] = C; const int Rb = Epi::PERM ? ((R & ~31) + perm32(R & 31)) : R;
        voffA[i] = (unsigned)(R * K + C) * 2u; voffB[i] = (unsigned)(Rb * K + C) * 2u; }
    const size_t kstep = (size_t)(BK * 2);
    const size_t hstep = (size_t)HALF * K * 2;
    const size_t tstep = 2 * hstep;
    const size_t hstepA = Sched::GATHER ? 0 : hstep;
    unsigned cvo[2][2], nvo[2][2];
#pragma unroll
    for (int h_ = 0; h_ < 2; ++h_)
#pragma unroll
        for (int i = 0; i < 2; ++i) { cvo[h_][i] = voffA[i]; nvo[h_][i] = voffA[i]; }
    const unsigned ldsw = (unsigned)wid * 1024u;
    const int aoff = lds_byte(wr * 64 + fr, fq * 8), boff = lds_byte(wc * 32 + fr, fq * 8);
#define PG8_SA(b, h) (((b) * 2 + (h)) * HTB)
#define PG8_SB(b, h) ((4 + (b) * 2 + (h)) * HTB)
#define PG8_STAGE(bufoff, gbase, voff) do { _Pragma("unroll") for (int _i = 0; _i < 2; ++_i) \
        __builtin_amdgcn_global_load_lds((const unsigned*)((const char*)(gbase) + (voff)[_i]), (PG8_LAS unsigned*)(lds + (bufoff) + ldsw + _i * 8192), 16, 0, 0); } while (0)
#define PG8_LDA(dst, b, h) do { _Pragma("unroll") for (int m = 0; m < 4; ++m) _Pragma("unroll") for (int k = 0; k < 2; ++k) dst[m][k] = *(const PG8_LAS bf16x8*)(lds + PG8_SA(b, h) + aoff + m * 2048 + k * 1024); } while (0)
#define PG8_LDB(dst, b, h) do { _Pragma("unroll") for (int n = 0; n < 2; ++n) _Pragma("unroll") for (int k = 0; k < 2; ++k) dst[n][k] = *(const PG8_LAS bf16x8*)(lds + PG8_SB(b, h) + boff + n * 2048 + k * 1024); } while (0)
#define PG8_MMA(ai, bj, At, Bt) do { __builtin_amdgcn_s_setprio(1); _Pragma("unroll") for (int m = 0; m < 4; ++m) _Pragma("unroll") for (int n = 0; n < 2; ++n) _Pragma("unroll") for (int k = 0; k < 2; ++k) \
        acc[ai][bj][m][n] = __builtin_amdgcn_mfma_f32_16x16x32_bf16(Bt[n][k], At[m][k], acc[ai][bj][m][n], 0, 0, 0); __builtin_amdgcn_s_setprio(0); } while (0)
#define PG8_WAIT_V(n) asm volatile("s_waitcnt vmcnt(" #n ")" ::: "memory")
#define PG8_WAIT_L(n) asm volatile("s_waitcnt lgkmcnt(" #n ")" ::: "memory")
#define PG8_BAR __builtin_amdgcn_s_barrier()
#define PG8_SCHED __builtin_amdgcn_sched_barrier(0)
    Unit cur, nxt; int ui = 0;
    if (!S.next(0, cur)) return;
    f32x4 acc[2][2][4][2];
#pragma unroll
    for (int a = 0; a < 2; ++a)
#pragma unroll
        for (int b = 0; b < 2; ++b)
#pragma unroll
            for (int m = 0; m < 4; ++m)
#pragma unroll
                for (int n = 0; n < 2; ++n) acc[a][b][m][n] = (f32x4){0.f, 0.f, 0.f, 0.f};
    bf16x8 At[4][2], B0[2][2], B1[2][2];
    const char* cA = S.aptr(g, cur, tstep); const char* cB = S.bptr(g, cur, tstep);
    S.a_ready(cur);
    if constexpr (Sched::GATHER) S.rowoffs(g, cur, RA, CA, cvo);
    if constexpr (SP2) {
        PG8_STAGE(PG8_SB(0, 0), cB, voffB); PG8_STAGE(PG8_SB(0, 1), cB + hstep, voffB); PG8_STAGE(PG8_SA(0, 0), cA, cvo[0]); PG8_STAGE(PG8_SA(0, 1), cA + hstepA, cvo[1]);
        if (wr == 1) PG8_BAR;
        PG8_WAIT_V(2); PG8_BAR;
        PG8_STAGE(PG8_SB(1, 0), cB + kstep, voffB); PG8_STAGE(PG8_SA(1, 0), cA + kstep, cvo[0]); PG8_STAGE(PG8_SB(1, 1), cB + hstep + kstep, voffB);
        PG8_WAIT_V(6); PG8_BAR;
    } else {
        PG8_STAGE(PG8_SB(0, 0), cB, voffB); PG8_STAGE(PG8_SA(0, 0), cA, cvo[0]); PG8_STAGE(PG8_SB(0, 1), cB + hstep, voffB); PG8_STAGE(PG8_SA(0, 1), cA + hstepA, cvo[1]);
        if (wr == 1) PG8_BAR;
        PG8_WAIT_V(4); PG8_BAR;
        PG8_STAGE(PG8_SB(1, 0), cB + kstep, voffB); PG8_STAGE(PG8_SA(1, 0), cA + kstep, cvo[0]); PG8_STAGE(PG8_SB(1, 1), cB + hstep + kstep, voffB);
        PG8_WAIT_V(6); PG8_BAR;
    }
    for (;;) {
        const bool has_next = S.next(ui + 1, nxt);
        const char* nA = has_next ? S.aptr(g, nxt, tstep) : cA; const char* nB = has_next ? S.bptr(g, nxt, tstep) : cB;
        if constexpr (Sched::GATHER) { if (has_next) S.rowoffs(g, nxt, RA, CA, nvo); }
        for (int t = 0; t < nt; t += 2) {
            const bool last = (t == nt - 2);
            const char* a1 = cA + (size_t)(t + 1) * kstep;
            const char* a2 = last ? nA : cA + (size_t)(t + 2) * kstep; const char* b2 = last ? nB : cB + (size_t)(t + 2) * kstep;
            const char* a3 = a2 + kstep; const char* b3 = b2 + kstep;
            if (last && has_next) S.a_ready(nxt);
            const bool nx_ = Sched::GATHER && last && has_next;
            const unsigned v0s[2] = {nx_ ? nvo[0][0] : cvo[0][0], nx_ ? nvo[0][1] : cvo[0][1]}, v1s[2] = {nx_ ? nvo[1][0] : cvo[1][0], nx_ ? nvo[1][1] : cvo[1][1]};
            if constexpr (SP2) {
            PG8_LDB(B0, 0, 0); PG8_LDB(B1, 0, 1); PG8_SCHED; PG8_LDA(At, 0, 0); PG8_STAGE(PG8_SA(1, 1), a1 + hstepA, cvo[1]);
            PG8_WAIT_V(8); PG8_WAIT_L(0); PG8_BAR; PG8_MMA(0, 0, At, B0); PG8_MMA(0, 1, At, B1); PG8_BAR; PG8_SCHED;
            PG8_LDA(At, 0, 1); PG8_STAGE(PG8_SB(0, 0), b2, voffB); PG8_STAGE(PG8_SB(0, 1), b2 + hstep, voffB); PG8_STAGE(PG8_SA(0, 0), a2, v0s);
            PG8_WAIT_V(8); PG8_WAIT_L(0); PG8_BAR; PG8_MMA(1, 0, At, B0); PG8_MMA(1, 1, At, B1); PG8_BAR; PG8_SCHED;
            PG8_LDB(B0, 1, 0); PG8_LDB(B1, 1, 1); PG8_SCHED; PG8_LDA(At, 1, 0); PG8_STAGE(PG8_SA(0, 1), a2 + hstepA, v1s);
            PG8_WAIT_V(8); PG8_WAIT_L(0); PG8_BAR; PG8_MMA(0, 0, At, B0); PG8_MMA(0, 1, At, B1); PG8_BAR; PG8_SCHED;
            PG8_LDA(At, 1, 1); PG8_STAGE(PG8_SB(1, 0), b3, voffB); PG8_STAGE(PG8_SB(1, 1), b3 + hstep, voffB); PG8_STAGE(PG8_SA(1, 0), a3, v0s);
            PG8_WAIT_V(8); PG8_WAIT_L(0); PG8_BAR; PG8_MMA(1, 0, At, B0); PG8_MMA(1, 1, At, B1); PG8_BAR; PG8_SCHED;
            } else {
            PG8_LDB(B0, 0, 0); PG8_SCHED; PG8_LDA(At, 0, 0); PG8_STAGE(PG8_SA(1, 1), a1 + hstepA, cvo[1]);
            PG8_WAIT_L(8); PG8_BAR; PG8_WAIT_L(0); PG8_MMA(0, 0, At, B0); PG8_BAR; PG8_SCHED;
            PG8_LDB(B1, 0, 1); PG8_STAGE(PG8_SB(0, 0), b2, voffB);
            PG8_BAR; PG8_WAIT_L(0); PG8_MMA(0, 1, At, B1); PG8_BAR;
            PG8_LDA(At, 0, 1); PG8_STAGE(PG8_SA(0, 0), a2, v0s);
            PG8_BAR; PG8_WAIT_L(0); PG8_MMA(1, 0, At, B0); PG8_BAR; PG8_SCHED;
            PG8_STAGE(PG8_SB(0, 1), b2 + hstep, voffB);
            PG8_WAIT_V(6); PG8_BAR; PG8_MMA(1, 1, At, B1); PG8_BAR;
            PG8_LDB(B0, 1, 0); PG8_SCHED; PG8_LDA(At, 1, 0); PG8_STAGE(PG8_SA(0, 1), a2 + hstepA, v1s);
            PG8_WAIT_L(8); PG8_BAR; PG8_WAIT_L(0); PG8_MMA(0, 0, At, B0); PG8_BAR; PG8_SCHED;
            PG8_LDB(B1, 1, 1); PG8_STAGE(PG8_SB(1, 0), b3, voffB);
            PG8_BAR; PG8_WAIT_L(0); PG8_MMA(0, 1, At, B1); PG8_BAR;
            PG8_LDA(At, 1, 1); PG8_STAGE(PG8_SA(1, 0), a3, v0s);
            PG8_BAR; PG8_WAIT_L(0); PG8_MMA(1, 0, At, B0); PG8_BAR; PG8_SCHED;
            PG8_STAGE(PG8_SB(1, 1), b3 + hstep, voffB);
            PG8_WAIT_V(6); PG8_BAR; PG8_MMA(1, 1, At, B1); PG8_BAR;
            }
        }
        if constexpr (ALIGN_EPI) { if (wr == 0) PG8_BAR; }
        if constexpr (!Epi::AFTER_DRAIN) { E(acc, cur, wr, wc, fr, fq); S.done(cur); }
        if (!has_next) break;
#pragma unroll
        for (int a = 0; a < 2; ++a)
#pragma unroll
            for (int b = 0; b < 2; ++b)
#pragma unroll
                for (int m = 0; m < 4; ++m)
#pragma unroll
                    for (int n = 0; n < 2; ++n) acc[a][b][m][n] = (f32x4){0.f, 0.f, 0.f, 0.f};
        cur = nxt; cA = nA; cB = nB; ++ui;
#pragma unroll
        for (int h_ = 0; h_ < 2; ++h_)
#pragma unroll
            for (int i = 0; i < 2; ++i) cvo[h_][i] = nvo[h_][i];
        if constexpr (ALIGN_EPI) { if (wr == 1) PG8_BAR; }
    }
    PG8_WAIT_V(0);
    if constexpr (!ALIGN_EPI) { if (wr == 0) PG8_BAR; }
    PG8_BAR;
    if constexpr (Epi::AFTER_DRAIN) { E.fused(acc, cur, wr, wc, fr, fq, lds, wid, lane); S.done(cur); }
#undef PG8_SA
#undef PG8_SB
#undef PG8_STAGE
#undef PG8_LDA
#undef PG8_LDB
#undef PG8_MMA
#undef PG8_WAIT_V
#undef PG8_WAIT_L
#undef PG8_BAR
#undef PG8_SCHED
}
}


#define PG8_SP2 true
#define PG8_ALIGN true
#include <hip/hip_bf16.h>
#include <cmath>
namespace attn_body {
using bf16=__hip_bfloat16;
using bf16x8=__attribute__((ext_vector_type(8)))short;
using s16x4=__attribute__((ext_vector_type(4)))short;
using f32x16=__attribute__((ext_vector_type(16)))float;
using u32x4=__attribute__((ext_vector_type(4)))unsigned;
constexpr int BATCH=2,NHEAD=16,SEQ=4096,D=64,DM=6656,DMO=1024;
constexpr int NW=8,QBLK=32,QB=QBLK*NW,KVBLK=64,NQB=SEQ/QB;
constexpr int ATTN_PITCH=DM, ATTN_UNIT_ROWS=QB;
__device__ __forceinline__ int crow(int r,int hi){return (r&3)+8*(r>>2)+4*hi;}
#define SBAR() __builtin_amdgcn_sched_barrier(0)
__device__ __forceinline__ void cmask(f32x16&p0,f32x16&p1,int jb,int qrel,int hi){
  const float NEG=-INFINITY; int kb=64*jb+4*hi;
  #pragma unroll
  for(int r=0;r<16;++r){int kv=kb+(r&3)+8*(r>>2); if(kv>qrel)p0[r]=NEG; if(kv+32>qrel)p1[r]=NEG;}
}

constexpr int NSLOT=3, SLOTB=8192;
constexpr int LDS_K=0, LDS_V=NSLOT*SLOTB, LDS_WS=2*NSLOT*SLOTB, LDS_OST=LDS_WS+NW*64*4, LDS_BYTES=LDS_OST+NW*4096;
constexpr float C2=0.125f*1.4426950408889634f;
__device__ __forceinline__ void glds16(const void*gsrc,unsigned lds_dst){unsigned keep;
  asm volatile("s_mov_b32 %0, m0\n\ts_mov_b32 m0, %2\n\ts_nop 0\n\tglobal_load_lds_dwordx4 %1, off\n\ts_mov_b32 m0, %0":"=&s"(keep):"v"(gsrc),"s"(lds_dst):"memory");}
__device__ __forceinline__ float max3f(float a,float b,float c){float r;asm("v_max3_f32 %0, %1, %2, %3":"=v"(r):"v"(a),"v"(b),"v"(c));return r;}
__device__ __forceinline__ float max2f(float a,float b){float r;asm("v_max_f32_e32 %0, %1, %2":"=v"(r):"v"(a),"v"(b));return r;}
__device__ __forceinline__ float fadd_s(float a,float b){float r;asm("v_add_f32_e32 %0, %1, %2":"=v"(r):"v"(a),"v"(b));return r;}
__device__ __forceinline__ float fsub_s(float a,float b){float r;asm("v_sub_f32_e32 %0, %1, %2":"=v"(r):"v"(a),"v"(b));return r;}
typedef float f32x2_t __attribute__((ext_vector_type(2))); typedef __bf16 bf16x2_t __attribute__((ext_vector_type(2)));
__device__ __forceinline__ unsigned cvtpk_s(float lo,float hi){f32x2_t v={lo,hi};bf16x2_t b=__builtin_convertvector(v,bf16x2_t);return __builtin_bit_cast(unsigned,b);}
#define WAIT_BAR(N) asm volatile("s_waitcnt vmcnt(" #N ") lgkmcnt(0)\n\ts_barrier":::"memory")

__device__ __forceinline__ void qkt(f32x16&p0,f32x16&p1,const char*Kslot,const bf16x8*qr,const f32x16&negm,int r32,int hi){
  const char*kb=Kslot+hi*1024+r32*16;
  #pragma unroll
  for(int d0=0;d0<4;++d0){
    const bf16x8 b0=*reinterpret_cast<const bf16x8*>(kb+d0*2048);
    const bf16x8 b1=*reinterpret_cast<const bf16x8*>(kb+d0*2048+512);
    if(d0==0){p0=__builtin_amdgcn_mfma_f32_32x32x16_bf16(b0,qr[0],negm,0,0,0);p1=__builtin_amdgcn_mfma_f32_32x32x16_bf16(b1,qr[0],negm,0,0,0);}
    else{p0=__builtin_amdgcn_mfma_f32_32x32x16_bf16(b0,qr[d0],p0,0,0,0);p1=__builtin_amdgcn_mfma_f32_32x32x16_bf16(b1,qr[d0],p1,0,0,0);}}
}
typedef __attribute__((address_space(3))) const char* lds_cptr;
typedef short v4i16_t __attribute__((ext_vector_type(4)));
__device__ __forceinline__ void kload8(bf16x8*kf,lds_cptr kp){
  kf[0]=*(const __attribute__((address_space(3))) bf16x8*)(kp);      kf[1]=*(const __attribute__((address_space(3))) bf16x8*)(kp+512);
  kf[2]=*(const __attribute__((address_space(3))) bf16x8*)(kp+2048); kf[3]=*(const __attribute__((address_space(3))) bf16x8*)(kp+2560);
  kf[4]=*(const __attribute__((address_space(3))) bf16x8*)(kp+4096); kf[5]=*(const __attribute__((address_space(3))) bf16x8*)(kp+4608);
  kf[6]=*(const __attribute__((address_space(3))) bf16x8*)(kp+6144); kf[7]=*(const __attribute__((address_space(3))) bf16x8*)(kp+6656);
}
__device__ __forceinline__ void kload2(bf16x8*kf,lds_cptr kp,int j){ kf[2*j]=*(const __attribute__((address_space(3))) bf16x8*)(kp+j*2048); kf[2*j+1]=*(const __attribute__((address_space(3))) bf16x8*)(kp+j*2048+512); }
__device__ __forceinline__ s16x4 vtr(lds_cptr p){ return __builtin_bit_cast(s16x4,__builtin_amdgcn_ds_read_tr16_b64_v4i16((__attribute__((address_space(3))) v4i16_t*)p)); }
__device__ __forceinline__ float rowmax(const f32x16&p0,const f32x16&p1){
  float a=max3f(p0[0],p0[1],p1[0]),b=max3f(p0[2],p0[3],p1[1]);a=max3f(a,p1[2],p1[3]);
  #pragma unroll
  for(int r=4;r<16;r+=4){a=max3f(a,p0[r],p0[r+1]);b=max3f(b,p0[r+2],p0[r+3]);a=max3f(a,p1[r],p1[r+1]);b=max3f(b,p1[r+2],p1[r+3]);}
  const float m=max2f(a,b);
  auto rr=__builtin_amdgcn_permlane32_swap(__float_as_uint(m),__float_as_uint(m),false,false);
  return max2f(__uint_as_float(rr[0]),__uint_as_float(rr[1]));
}
__device__ __forceinline__ void pv(f32x16*o,int vb,bf16x8 pa0,bf16x8 pa1,bf16x8 pa2,bf16x8 pa3){
  #pragma unroll
  for(int d0=0;d0<2;++d0){s16x4 lo[4],hi[4];
    #pragma unroll
    for(int ks=0;ks<4;++ks){
      asm volatile("ds_read_b64_tr_b16 %0,%1 offset:%c2":"=&v"(lo[ks]):"v"(vb),"i"(d0*4096+ks*1024):"memory");
      asm volatile("ds_read_b64_tr_b16 %0,%1 offset:%c2":"=&v"(hi[ks]):"v"(vb),"i"(d0*4096+ks*1024+512):"memory");}
    asm volatile("s_waitcnt lgkmcnt(0)":::"memory");SBAR();
    #define PK(k) (bf16x8){lo[k][0],lo[k][1],lo[k][2],lo[k][3],hi[k][0],hi[k][1],hi[k][2],hi[k][3]}
    o[d0]=__builtin_amdgcn_mfma_f32_32x32x16_bf16(pa0,PK(0),o[d0],0,0,0);
    o[d0]=__builtin_amdgcn_mfma_f32_32x32x16_bf16(pa1,PK(1),o[d0],0,0,0);
    o[d0]=__builtin_amdgcn_mfma_f32_32x32x16_bf16(pa2,PK(2),o[d0],0,0,0);
    o[d0]=__builtin_amdgcn_mfma_f32_32x32x16_bf16(pa3,PK(3),o[d0],0,0,0);
    #undef PK
  }
}

#ifndef ATTN_STORE16
#define ATTN_STORE16(p,v) (*(u32x4*)(p)=(v))
#endif
template<int THRL> __device__ __forceinline__ void attn_unit(int b,int qb,const bf16*Q,const bf16*__restrict__ K,const bf16*__restrict__ V,bf16*O,char*shm){
  int tid_=threadIdx.x; asm volatile("":"+v"(tid_)); const int tid=tid_,lane=tid&63,r32=lane&31,hi=lane>>5; const int wid=__builtin_amdgcn_readfirstlane(tid>>6);
  const long rowbase=(long)b*SEQ; const int q0=qb*QB;
  const bf16*Qw=Q+(rowbase+q0+wid*QBLK)*DM;
  const bf16*Kh=K+rowbase*DM,*Vh=V+rowbase*DM;
  const unsigned lds0=(unsigned)(uintptr_t)shm;
  float*wsf=(float*)(shm+LDS_WS)+wid*64;
  const bf16*ksrc=Kh+(long)lane*DM+wid*8;
  const bf16*vsrc=Vh+(long)(16*(wid&3)+(lane>>2))*DM+(wid>>2)*32+(lane&3)*8;
  const unsigned kdst=lds0+LDS_K+wid*1024, vdst=lds0+LDS_V+wid*1024;
  #define DMA_K(t,slot) glds16(ksrc+(long)(t)*KVBLK*DM,(unsigned)__builtin_amdgcn_readfirstlane(kdst+(slot)))
  #define DMA_V(t,slot) glds16(vsrc+(long)(t)*KVBLK*DM,(unsigned)__builtin_amdgcn_readfirstlane(vdst+(slot)))
  const int vb0=(int)(lds0+LDS_V)+((lane>>4)&1)*32+(lane&3)*8+(4*hi+((lane&15)>>2))*64;
  const char*Kbase=shm+LDS_K; bf16x8 kf[8];
  const lds_cptr shm3=(lds_cptr)shm; const lds_cptr kp0=shm3+LDS_K+hi*1024+r32*16; const lds_cptr vp0=shm3+LDS_V+((lane>>4)&1)*32+(lane&3)*8+(4*hi+((lane&15)>>2))*64;
  const int NT=(q0+QB)/KVBLK;
  DMA_K(0,0);DMA_V(0,0);DMA_K(1,SLOTB);
  bf16x8 qr[4];
  #pragma unroll
  for(int d0=0;d0<4;++d0)qr[d0]=*reinterpret_cast<const bf16x8*>(&Qw[(long)r32*DM+d0*16+hi*8]);
  float mhat=0.f,l_reg=0.f;f32x16 o[2];o[0]=f32x16{};o[1]=f32x16{};f32x16 negm=f32x16{};asm volatile("":"+v"(negm));
  const int qrel=wid*QBLK+r32;
  #define CMASK(P0,P1,t) do{int jb_=(t)-(NT-4); if(jb_>=0)cmask(P0,P1,jb_,qrel,hi);}while(0)
  bool resc=false;
  #define START(P0,P1) do{ const float rm=rowmax(P0,P1); resc=false; \
    { const float dl=rm; mhat=fadd_s(mhat,dl); \
      _Pragma("unroll") for(int r=0;r<16;++r){P0[r]=fsub_s(P0[r],dl);P1[r]=fsub_s(P1[r],dl);} \
      _Pragma("unroll") for(int r=0;r<16;++r)negm[r]=-mhat; asm volatile("":"+v"(negm)); } \
    _Pragma("unroll") for(int r=0;r<16;++r)P0[r]=__builtin_amdgcn_exp2f(P0[r]); }while(0)
  #define RESC() do{ if(resc){ asm volatile("s_waitcnt lgkmcnt(0)":::"memory"); \
      _Pragma("unroll") for(int d_=0;d_<2;++d_) _Pragma("unroll") for(int r=0;r<16;++r)o[d_][r]*=wsf[crow(r,hi)]; } }while(0)
  f32x16 pA0,pA1,pB0,pB1;
  int sl_prev=0,sl_cur=0,sl_next=SLOTB;
  #define ROT() do{sl_prev=sl_cur;sl_cur=sl_next;sl_next=(sl_next==(NSLOT-1)*SLOTB)?0:sl_next+SLOTB;}while(0)
  DMA_K(2,2*SLOTB);
  WAIT_BAR(3);
  qkt(pA0,pA1,Kbase,qr,negm,r32,hi);asm volatile("s_nop 15\n\ts_nop 7":"+v"(pA0),"+v"(pA1));CMASK(pA0,pA1,0);
  START(pA0,pA1);
  _Pragma("unroll") for(int r=0;r<16;++r)pA1[r]=__builtin_amdgcn_exp2f(pA1[r]);
  WAIT_BAR(0);
  DMA_K(3,0);DMA_V(1,SLOTB);
  ROT();
  kload8(kf,kp0+sl_cur);
  WAIT_BAR(2);
  s16x4 vlo[8],vhi[8]; u32x4 pw0,pw1,pw2,pw3;
  #define PKW(P,B) cvtpk_s(P[B],P[B+1])
  #define PAF(k) __builtin_bit_cast(bf16x8,pw##k)
  #define VFR(i) (bf16x8){vlo[i][0],vlo[i][1],vlo[i][2],vlo[i][3],vhi[i][0],vhi[i][1],vhi[i][2],vhi[i][3]}
  #define PIN(x) asm volatile("":"+v"(x))
  #define MX3(a,b,c) __builtin_fmaxf(__builtin_fmaxf((a),(b)),(c))
  #define GAPA(MF,A0,A1,A2,A3,W0,W1,PW) do{ MF; sacc+=A0; sacc+=A1; sacc+=A2; sacc+=A3; PIN(sacc); W0; W1; PIN(PW); SBAR(); }while(0)
  #define EX(v) __builtin_amdgcn_exp2f(v)
  #define GAPB(MF,X,B) do{ MF; X[B]=EX(X[B]); X[B+1]=EX(X[B+1]); X[B+2]=EX(X[B+2]); X[B+3]=EX(X[B+3]); PIN(X); SBAR(); }while(0)
  #define VRD(i) do{ vlo[i]=vtr(vp_+(((i)>>2)*4096+((i)&3)*1024)); vhi[i]=vtr(vp_+(((i)>>2)*4096+((i)&3)*1024+512)); }while(0)
  #define KRD(G,j) do{ if(G){ kload2(kf,kp0+sl_next,j); SBAR(); } }while(0)
  #define STEP(C0,C1,P0,P1,t,GK,GV,GL) do{ SBAR(); \
    const lds_cptr vp_=vp0+sl_prev; \
    VRD(0); SBAR(); float sacc=(P0[0]+P0[1]); \
    GAPA(C0=__builtin_amdgcn_mfma_f32_32x32x16_bf16(kf[0],qr[0],negm,0,0,0), P0[2],P0[3],P0[4],P0[5],     pw0[0]=PKW(P0,0), pw0[1]=PKW(P0,2), pw0); \
    VRD(4); SBAR(); GAPA(C1=__builtin_amdgcn_mfma_f32_32x32x16_bf16(kf[1],qr[0],negm,0,0,0), P0[6],P0[7],P0[8],P0[9],     pw0[2]=PKW(P0,4), pw0[3]=PKW(P0,6), pw0); \
    VRD(1); SBAR(); GAPA(C0=__builtin_amdgcn_mfma_f32_32x32x16_bf16(kf[2],qr[1],C0,0,0,0),   P0[10],P0[11],P0[12],P0[13], pw1[0]=PKW(P0,8), pw1[1]=PKW(P0,10), pw1); \
    VRD(5); SBAR(); GAPA(C1=__builtin_amdgcn_mfma_f32_32x32x16_bf16(kf[3],qr[1],C1,0,0,0),   P0[14],P0[15],P1[0],P1[1],   pw1[2]=PKW(P0,12),pw1[3]=PKW(P0,14), pw1); \
    VRD(2); SBAR(); GAPA(C0=__builtin_amdgcn_mfma_f32_32x32x16_bf16(kf[4],qr[2],C0,0,0,0),   P1[2],P1[3],P1[4],P1[5],     pw2[0]=PKW(P1,0), pw2[1]=PKW(P1,2), pw2); \
    VRD(6); SBAR(); GAPA(C1=__builtin_amdgcn_mfma_f32_32x32x16_bf16(kf[5],qr[2],C1,0,0,0),   P1[6],P1[7],P1[8],P1[9],     pw2[2]=PKW(P1,4), pw2[3]=PKW(P1,6), pw2); \
    VRD(3); SBAR(); GAPA(C0=__builtin_amdgcn_mfma_f32_32x32x16_bf16(kf[6],qr[3],C0,0,0,0),   P1[10],P1[11],P1[12],P1[13], pw3[0]=PKW(P1,8), pw3[1]=PKW(P1,10), pw3); \
    VRD(7); SBAR(); GAPA(C1=__builtin_amdgcn_mfma_f32_32x32x16_bf16(kf[7],qr[3],C1,0,0,0),   P1[14],P1[15],0.f,0.f,       pw3[2]=PKW(P1,12),pw3[3]=PKW(P1,14), pw3); \
    l_reg+=sacc; \
    if(GK){DMA_K((t)+3,sl_cur);} if(GV){DMA_V((t)+1,sl_next);} \
    CMASK(C0,C1,t); \
    { float a=MX3(C0[0],C0[1],C1[0]),b=MX3(C0[2],C0[3],C1[1]); a=MX3(a,C1[2],C1[3]); \
      _Pragma("unroll") for(int r=4;r<16;r+=4){a=MX3(a,C0[r],C0[r+1]);b=MX3(b,C0[r+2],C0[r+3]);a=MX3(a,C1[r],C1[r+1]);b=MX3(b,C1[r+2],C1[r+3]);} \
      float rm=__builtin_fmaxf(a,b); { auto rr=__builtin_amdgcn_permlane32_swap(__float_as_uint(rm),__float_as_uint(rm),false,false); rm=__builtin_fmaxf(__uint_as_float(rr[0]),__uint_as_float(rr[1])); } \
      resc=false; \
      if(__builtin_expect(__any(rm>(float)THRL),0)){ const float dl=__builtin_fmaxf(rm,0.f); mhat+=dl; \
        _Pragma("unroll") for(int r=0;r<16;++r){C0[r]-=dl;C1[r]-=dl;} \
        _Pragma("unroll") for(int r=0;r<16;++r)negm[r]=-mhat; asm volatile("":"+v"(negm)); \
        const float f=__builtin_amdgcn_exp2f(-dl); l_reg*=f; if(hi==0)wsf[r32]=f; resc=true; } } \
    SBAR(); \
    GAPB(o[0]=__builtin_amdgcn_mfma_f32_32x32x16_bf16(PAF(0),VFR(0),o[0],0,0,0), C0,0); \
    GAPB(o[1]=__builtin_amdgcn_mfma_f32_32x32x16_bf16(PAF(0),VFR(4),o[1],0,0,0), C0,4); \
    KRD(GL,0); GAPB(o[0]=__builtin_amdgcn_mfma_f32_32x32x16_bf16(PAF(1),VFR(1),o[0],0,0,0), C0,8); \
    KRD(GL,1); GAPB(o[1]=__builtin_amdgcn_mfma_f32_32x32x16_bf16(PAF(1),VFR(5),o[1],0,0,0), C0,12); \
    KRD(GL,2); GAPB(o[0]=__builtin_amdgcn_mfma_f32_32x32x16_bf16(PAF(2),VFR(2),o[0],0,0,0), C1,0); \
    KRD(GL,3); GAPB(o[1]=__builtin_amdgcn_mfma_f32_32x32x16_bf16(PAF(2),VFR(6),o[1],0,0,0), C1,4); \
    GAPB(o[0]=__builtin_amdgcn_mfma_f32_32x32x16_bf16(PAF(3),VFR(3),o[0],0,0,0), C1,8); \
    GAPB(o[1]=__builtin_amdgcn_mfma_f32_32x32x16_bf16(PAF(3),VFR(7),o[1],0,0,0), C1,12); \
    }while(0)
  int t=1;
  #undef CMASK
  #define CMASK(P0,P1,t) do{}while(0)
  for(;t+5<NT;t+=2){
    STEP(pB0,pB1,pA0,pA1,t,true,true,true);     WAIT_BAR(2); RESC(); ROT();
    STEP(pA0,pA1,pB0,pB1,t+1,true,true,true);   WAIT_BAR(2); RESC(); ROT();
  }
  #undef CMASK
  #define CMASK(P0,P1,t) do{int jb_=(t)-(NT-4); if(jb_>=0)cmask(P0,P1,jb_,qrel,hi);}while(0)
  #define ENDW(tt) do{ if((tt)+3<NT){WAIT_BAR(2);} else if((tt)+2<NT){WAIT_BAR(1);} else {WAIT_BAR(0);} }while(0)
  for(;t+1<NT;t+=2){
    STEP(pB0,pB1,pA0,pA1,t,(t+3<NT),(t+1<NT),(t+1<NT));       ENDW(t);   RESC(); ROT();
    STEP(pA0,pA1,pB0,pB1,t+1,(t+4<NT),(t+2<NT),(t+2<NT));     ENDW(t+1); RESC(); ROT();
  }
  STEP(pB0,pB1,pA0,pA1,NT-1,false,false,false); RESC();
  { float sacc=pB0[0]+pB0[1]; _Pragma("unroll") for(int r=2;r<16;++r)sacc+=pB0[r]; _Pragma("unroll") for(int r=0;r<16;++r)sacc+=pB1[r]; l_reg+=sacc;
    pw0=(u32x4){PKW(pB0,0),PKW(pB0,2),PKW(pB0,4),PKW(pB0,6)};pw1=(u32x4){PKW(pB0,8),PKW(pB0,10),PKW(pB0,12),PKW(pB0,14)};pw2=(u32x4){PKW(pB1,0),PKW(pB1,2),PKW(pB1,4),PKW(pB1,6)};pw3=(u32x4){PKW(pB1,8),PKW(pB1,10),PKW(pB1,12),PKW(pB1,14)};
    SBAR(); pv(o,vb0+sl_cur,PAF(0),PAF(1),PAF(2),PAF(3)); }
  #undef PKW
  #undef PAF
  #undef VFR
  #undef PIN
  #undef MX3
  #undef GAPA
  #undef GAPB
  #undef EX
  #undef VRD
  #undef KRD
  #undef STEP
  #undef ENDW
  {auto rr=__builtin_amdgcn_permlane32_swap(__float_as_uint(l_reg),__float_as_uint(l_reg),false,false);l_reg=__uint_as_float(rr[0])+__uint_as_float(rr[1]);}
  if(hi==0)wsf[32+r32]=l_reg;asm volatile("s_waitcnt lgkmcnt(0)":::"memory");
  float rli[16];
  #pragma unroll
  for(int r=0;r<16;++r)rli[r]=__builtin_amdgcn_rcpf(wsf[32+crow(r,hi)]);
  bf16*Ow=O+(rowbase+q0+wid*QBLK)*DMO;
  { bf16*stg=(bf16*)(shm+LDS_OST)+wid*2048;
    #pragma unroll
    for(int r=0;r<16;++r){const int orow=crow(r,hi);
      #pragma unroll
      for(int d0=0;d0<2;++d0)stg[orow*64+d0*32+r32]=__float2bfloat16(o[d0][r]*rli[r]);}
    asm volatile("s_waitcnt lgkmcnt(0)":::"memory");
    #pragma unroll
    for(int i=0;i<4;++i){const int row=i*8+(lane>>3),ch=lane&7; const u32x4 v=*(const u32x4*)(stg+row*64+ch*8); ATTN_STORE16(Ow+(long)row*DMO+ch*8,v);} }
  asm volatile("s_waitcnt lgkmcnt(0)\n\ts_barrier":::"memory");
  #undef DMA_K
  #undef DMA_V
  #undef CMASK
  #undef START
  #undef RESC
  #undef ROT
}
constexpr int ATTN_LDS_BYTES=LDS_BYTES;
#undef SBAR
#undef WAIT_BAR
}


constexpr int NWAVES = 8;
constexpr int NB = 2, T = 4096, NTOK = NB * T, D = 2048, C = 1024, NH = 16, HD = 64;
constexpr int PPITCH = 6656;
constexpr int PC_R = 0, PC_K = 1024, PC_V = 2048, PC_L = 3072, PC_Q = 3584, PC_KA = 4608, PC_VA = 5632;
constexpr int LK = 384;
constexpr int NEXP = 32, DEXP = 512, RMAX = 24576;
constexpr int NPH_LAYER = 12, NPHASES = 1 + 2 * NPH_LAYER;

constexpr size_t MiB = 1u << 20, KiB = 1u << 10;
constexpr size_t WS_CTL = 0, CTL_ZERO_BYTES = 1 * MiB;
constexpr size_t WS_ROPE = 1 * MiB;
constexpr size_t WS_PART = WS_ROPE + 256 * KiB;
constexpr size_t WS_TOKE = WS_PART + 1 * MiB;
constexpr size_t WS_TOKW = WS_TOKE + 64 * KiB;
constexpr size_t WS_TOKR = WS_TOKW + 64 * KiB;
constexpr size_t WS_TOKS = WS_TOKR + 64 * KiB;
constexpr size_t WS_RSTD2 = WS_TOKS + 64 * KiB;
constexpr size_t WS_CNT = WS_RSTD2 + 32 * KiB;
constexpr size_t WS_SRS = WS_CNT + 32 * KiB;
constexpr size_t WS_SWT = WS_SRS + 96 * KiB;
constexpr size_t WS_BONUS = WS_SWT + 96 * KiB;
constexpr size_t WS_RSTD1 = WS_BONUS + 512 * KiB;
constexpr size_t WS_RW = WS_RSTD1 + 32 * KiB;
constexpr size_t WS_SMALL_END = WS_RW + 576 * KiB;
static_assert(WS_SMALL_END <= 4 * MiB, "small tables");
constexpr size_t WS_HBA = 4 * MiB, WS_HBB = WS_HBA + 32 * MiB;
constexpr size_t WS_VFIRST = WS_HBB + 32 * MiB;
constexpr size_t WS_PB = WS_VFIRST + 32 * MiB;
constexpr size_t WS_WIN = WS_PB + 8 * MiB;
constexpr size_t WS_WOUT = WS_WIN + 52 * MiB;
constexpr size_t WS_WPG = WS_WOUT + 16 * MiB;
constexpr size_t WS_WPP = WS_WPG + 16 * MiB;
constexpr size_t WS_WL2 = WS_WPP + 2 * MiB;
constexpr size_t WS_WGU = WS_WL2 + 6 * MiB;
constexpr size_t WS_WD = WS_WGU + 128 * MiB;
constexpr size_t WS_PROJ = WS_WD + 64 * MiB;
constexpr size_t WS_LORAA = WS_PROJ + 104 * MiB;
constexpr size_t WS_LORAO = WS_LORAA + 6 * MiB;
constexpr size_t WS_OB = WS_LORAO + 64 * MiB;
constexpr size_t WS_CONCAT = WS_OB + 32 * MiB;
constexpr size_t WS_PPB = WS_CONCAT + 32 * MiB;
constexpr size_t WS_SCAN = WS_PPB + 32 * MiB;
constexpr size_t WS_Y = WS_SCAN + 192 * MiB;
constexpr size_t WS_ASORT = WS_SCAN;
constexpr size_t WS_HG = WS_ASORT + 96 * MiB;
constexpr size_t WS_OSLOT = WS_HG + 24 * MiB;
constexpr size_t WS_TPS = WS_SCAN + 224 * MiB;
constexpr size_t WS_MOETAB = WS_TPS + 32 * MiB;
constexpr int ECAP = 8192;
constexpr size_t WS_END = WS_MOETAB + 3 * MiB;
constexpr size_t WS_TPQ0 = WS_PPB, WS_TPQ1 = WS_PPB;
constexpr size_t WS_SCIN0 = WS_SCAN, WS_SCIN1 = WS_SCAN;
constexpr size_t WS_SV = WS_SCAN + 160 * MiB;
constexpr size_t WS_TPP = WS_CONCAT, WS_TPZ = WS_CONCAT + 16 * MiB;
static_assert(WS_OSLOT + 96 * MiB <= WS_TPS, "MoE overlay fits the scan region");
constexpr int CW_BAR = 4096;
constexpr size_t WS_ECNT = 768 * KiB;
constexpr size_t WS_SLOTTOK = 640 * KiB;


constexpr int RING_OFF = 0, RING_BYTES = 131072;
constexpr int LDSCTL_OFF = RING_BYTES, MISC_OFF = LDSCTL_OFF + 320;
constexpr int L1FLAG_OFF = LDSCTL_OFF + 512;
constexpr int RSTAB_OFF = LDSCTL_OFF + 8192;
constexpr int META_OFF = LDSCTL_OFF + 1024;
constexpr int LDS_BYTES = 147456;
static_assert(attn_body::ATTN_LDS_BYTES <= RING_BYTES, "attention scratch fits the ring");

#define GAS __attribute__((address_space(1)))
#define LAS __attribute__((address_space(3)))
typedef unsigned short bf16;
typedef unsigned v4u __attribute__((ext_vector_type(4)));
typedef unsigned v2u __attribute__((ext_vector_type(2)));
typedef float f32x4 __attribute__((ext_vector_type(4)));
typedef GAS unsigned gu32;
#define RLX_AGENT __ATOMIC_RELAXED, __HIP_MEMORY_SCOPE_AGENT
#define LDS_WAIT() asm volatile("s_waitcnt lgkmcnt(0)" ::: "memory")
__device__ __forceinline__ unsigned f2bf(float f) { unsigned u = __builtin_bit_cast(unsigned, f); return (u + 0x7fffu + ((u >> 16) & 1u)) >> 16; }
__device__ __forceinline__ unsigned pk2(float lo, float hi) { return f2bf(lo) | (f2bf(hi) << 16); }
__device__ __forceinline__ float bflo(unsigned u) { return __builtin_bit_cast(float, u << 16); }
__device__ __forceinline__ float bfhi(unsigned u) { return __builtin_bit_cast(float, u & 0xffff0000u); }
__device__ __forceinline__ float sigmoidf_(float x) { return 1.0f / (1.0f + __expf(-x)); }

#define XB_TMO      128
#define XB_XCNT(j)  (256  + 64 * (j))
#define XB_XSUB(j)  (1280 + 64 * (j))
#define XB_XGEN(j)  (2304 + 64 * (j))
#define XB_TOP      3328
#define XB_TOPGEN   3392
#define XCD_BAR_WORDS 3456
#define XB_SPIN_CAP (1u << 18)

__device__ __forceinline__ unsigned xb_ld(unsigned* p)              { return __hip_atomic_load(p, __ATOMIC_RELAXED, __HIP_MEMORY_SCOPE_AGENT); }
__device__ __forceinline__ unsigned xb_add(unsigned* p, unsigned v) { return __hip_atomic_fetch_add(p, v, __ATOMIC_RELAXED, __HIP_MEMORY_SCOPE_AGENT); }
__device__ __forceinline__ unsigned xb_xcc_id() { return (unsigned)__builtin_amdgcn_s_getreg((3 << 11) | 20) & 0xFu; }
#define XB_SPIN(cond, bar) do { unsigned _sp = 0; while (cond) { __builtin_amdgcn_s_sleep(1); \
    if ((++_sp & 255u) == 0u) { if (xb_ld(&(bar)[XB_TMO])) break; if (_sp > XB_SPIN_CAP) { atomicAdd(&(bar)[XB_TMO], 1u); break; } } } } while (0)

struct XcdBarrier {
    unsigned* bar; unsigned x;
    volatile LAS unsigned* st;
};

__device__ __forceinline__ XcdBarrier xcd_barrier_post(unsigned* bar, volatile LAS unsigned* st) {
    XcdBarrier b; b.bar = bar; b.x = xb_xcc_id(); b.st = st;
    if (threadIdx.x == 0) (void)xb_add(&bar[XB_XCNT(b.x)], 1u);
    return b;
}
__device__ __forceinline__ void xcd_barrier_complete(unsigned* bar, unsigned x, unsigned& nloc, unsigned& nx) {
    const unsigned G = gridDim.x * gridDim.y * gridDim.z;
    unsigned sum, cnt, mine, sp = 0u;
    for (;;) {
        sum = 0u; cnt = 0u; mine = 0u;
#pragma unroll
        for (unsigned j = 0; j < 16; ++j) { const unsigned c = xb_ld(&bar[XB_XCNT(j)]); sum += c; cnt += (c > 0u) ? 1u : 0u; mine = (j == x) ? c : mine; }
        if (sum == G) break;
        __builtin_amdgcn_s_sleep(1);
        if ((++sp & 255u) == 0u) { if (xb_ld(&bar[XB_TMO])) break; if (sp > XB_SPIN_CAP) { atomicAdd(&bar[XB_TMO], 1u); break; } }
    }
    nloc = mine > 0u ? mine : 1u; nx = cnt > 0u ? cnt : 1u;
}

__device__ __forceinline__ void xcd_barrier(const XcdBarrier& b) {
    asm volatile("s_waitcnt vmcnt(0)" ::: "memory");
    __syncthreads();
    if (threadIdx.x == 0) {
        unsigned* bar = b.bar;
        __builtin_amdgcn_s_waitcnt(0);
        unsigned nloc = b.st[0], nx = b.st[1];
        if (nloc == 0u) { xcd_barrier_complete(bar, b.x, nloc, nx); b.st[0] = nloc; b.st[1] = nx; }
        const unsigned old = xb_add(&bar[XB_XSUB(b.x)], 1u);
        const unsigned gen = old / nloc;
        if (old + 1u == (gen + 1u) * nloc) {
            __builtin_amdgcn_fence(__ATOMIC_RELEASE, "agent");
            asm volatile("s_waitcnt vmcnt(0)" ::: "memory");
            const unsigned og = xb_add(&bar[XB_TOP], 1u);
            const unsigned tg = og / nx;
            if (og + 1u == (tg + 1u) * nx) xb_add(&bar[XB_TOPGEN], 1u);
            else XB_SPIN(xb_ld(&bar[XB_TOPGEN]) == tg, bar);
            __builtin_amdgcn_fence(__ATOMIC_ACQUIRE, "agent");
            xb_add(&bar[XB_XGEN(b.x)], 1u);
            asm volatile("s_waitcnt vmcnt(0)" ::: "memory");
        } else {
            XB_SPIN(xb_ld(&bar[XB_XGEN(b.x)]) == gen, bar);
            __builtin_amdgcn_fence(__ATOMIC_ACQUIRE, "agent");
            asm volatile("s_waitcnt vmcnt(0)" ::: "memory");
        }
    }
    __syncthreads();
}


__device__ __forceinline__ int fresh_tid() { int t = threadIdx.x; asm volatile("" : "+v"(t)); return t; }
struct Frame {
    LAS unsigned char* lds;
    int tid, lane, wave, vcu, G;
    unsigned char* ws;
};
extern __shared__ __attribute__((aligned(16))) unsigned char lds_dyn[];
__device__ __forceinline__ Frame mk_frame(unsigned char* ws) {
    Frame F; F.lds = (LAS unsigned char*)lds_dyn; F.tid = fresh_tid(); F.lane = F.tid & 63; F.wave = __builtin_amdgcn_readfirstlane(F.tid >> 6);
    F.G = gridDim.x; { const int bx = blockIdx.x; F.vcu = (F.G % 8 == 0) ? (bx % 8) * (F.G / 8) + bx / 8 : bx; }
    F.ws = ws; return F;
}
template <int CTRL, int RM> __device__ __forceinline__ float dpp_get(float v) { return __int_as_float(__builtin_amdgcn_update_dpp(0, __float_as_int(v), CTRL, RM, 0xf, false)); }
__device__ __forceinline__ float wave_total63(float v) {
    v += dpp_get<0xB1, 0xf>(v);
    v += dpp_get<0x4E, 0xf>(v);
    v += dpp_get<0x141, 0xf>(v);
    v += dpp_get<0x140, 0xf>(v);
    v += dpp_get<0x142, 0xa>(v);
    v += dpp_get<0x143, 0xc>(v);
    return v;
}
__device__ __forceinline__ float wave_bcast63(float v) { return __int_as_float(__builtin_amdgcn_readlane(__float_as_int(v), 63)); }
__device__ __forceinline__ float red16(float v) { v += __shfl_xor(v, 1); v += __shfl_xor(v, 2); v += __shfl_xor(v, 4); v += __shfl_xor(v, 8); return v; }
__device__ __forceinline__ float red32(float v) { v = red16(v); v += __shfl_xor(v, 16); return v; }
__device__ __forceinline__ float red64(float v) { v = red32(v); v += __shfl_xor(v, 32); return v; }

struct ConvItem { const float* W; bf16* WT; const float* gain; int ldw, k0, n0, n_end, Kd, split, shift0, shift1, map; };
__device__ __forceinline__ void conv_load(const ConvItem& p, int lane, f32x4 (&v)[16]) {
    const int kq = lane >> 4, nq = lane & 15, n = p.n0 + nq * 4;
    if (n < p.n_end) { const float* src = p.W + (size_t)(p.k0 + kq * 16) * p.ldw + n;
#pragma unroll
        for (int i = 0; i < 16; ++i) v[i] = *(const f32x4*)(src + (size_t)i * p.ldw); }
}
__device__ __forceinline__ void conv_store(const ConvItem& p, int lane, f32x4 (&v)[16]) {
    const int kq = lane >> 4, nq = lane & 15, n = p.n0 + nq * 4;
    if (n >= p.n_end) return;
    if (p.gain) { const f32x4* gp = (const f32x4*)(p.gain + p.k0 + kq * 16);
#pragma unroll
        for (int i4 = 0; i4 < 4; ++i4) { const f32x4 g = gp[i4];
#pragma unroll
            for (int e = 0; e < 4; ++e) v[4 * i4 + e] = v[4 * i4 + e] * g[e]; } }
#pragma unroll
    for (int e = 0; e < 4; ++e) { const int nn = n + e; const int dr = (p.map == 0) ? nn + ((nn >= p.split) ? p.shift1 : p.shift0) : ((nn >> 7) * 256 + p.shift0 + (nn & 127));
        GAS v4u* dst = (GAS v4u*)(p.WT + (size_t)dr * p.Kd + p.k0 + kq * 16);
        dst[0] = (v4u){pk2(v[0][e], v[1][e]), pk2(v[2][e], v[3][e]), pk2(v[4][e], v[5][e]), pk2(v[6][e], v[7][e])};
        dst[1] = (v4u){pk2(v[8][e], v[9][e]), pk2(v[10][e], v[11][e]), pk2(v[12][e], v[13][e]), pk2(v[14][e], v[15][e])}; }
}
__device__ __forceinline__ void conv_half(const ConvItem& p, int lane, int hf) {
    const int kq = lane >> 4, nq = lane & 15, n = p.n0 + nq * 4;
    if (n >= p.n_end) return;
    const float* src = p.W + (size_t)(p.k0 + kq * 16 + 8 * hf) * p.ldw + n; f32x4 v[8];
#pragma unroll
    for (int i = 0; i < 8; ++i) v[i] = *(const f32x4*)(src + (size_t)i * p.ldw);
    if (p.gain) { const f32x4* gp = (const f32x4*)(p.gain + p.k0 + kq * 16 + 8 * hf);
#pragma unroll
        for (int i4 = 0; i4 < 2; ++i4) { const f32x4 g = gp[i4];
#pragma unroll
            for (int e = 0; e < 4; ++e) v[4 * i4 + e] = v[4 * i4 + e] * g[e]; } }
#pragma unroll
    for (int e = 0; e < 4; ++e) { const int nn = n + e; const int dr = (p.map == 0) ? nn + ((nn >= p.split) ? p.shift1 : p.shift0) : ((nn >> 7) * 256 + p.shift0 + (nn & 127));
        *(GAS v4u*)(p.WT + (size_t)dr * p.Kd + p.k0 + kq * 16 + 8 * hf) = (v4u){pk2(v[0][e], v[1][e]), pk2(v[2][e], v[3][e]), pk2(v[4][e], v[5][e]), pk2(v[6][e], v[7][e])}; }
}
__device__ __forceinline__ void conv_half_load(const ConvItem& p, int lane, int hf, f32x4 (&v)[8]) {
    const int kq = lane >> 4, nq = lane & 15, n = p.n0 + nq * 4;
    if (n < p.n_end) { const float* src = p.W + (size_t)(p.k0 + kq * 16 + 8 * hf) * p.ldw + n;
#pragma unroll
        for (int i = 0; i < 8; ++i) v[i] = *(const f32x4*)(src + (size_t)i * p.ldw); }
}
__device__ __forceinline__ void conv_half_store(const ConvItem& p, int lane, int hf, f32x4 (&v)[8]) {
    const int kq = lane >> 4, nq = lane & 15, n = p.n0 + nq * 4;
    if (n >= p.n_end) return;
    if (p.gain) { const f32x4* gp = (const f32x4*)(p.gain + p.k0 + kq * 16 + 8 * hf);
#pragma unroll
        for (int i4 = 0; i4 < 2; ++i4) { const f32x4 g = gp[i4];
#pragma unroll
            for (int e = 0; e < 4; ++e) v[4 * i4 + e] = v[4 * i4 + e] * g[e]; } }
#pragma unroll
    for (int e = 0; e < 4; ++e) { const int nn = n + e; const int dr = (p.map == 0) ? nn + ((nn >= p.split) ? p.shift1 : p.shift0) : ((nn >> 7) * 256 + p.shift0 + (nn & 127));
        *(GAS v4u*)(p.WT + (size_t)dr * p.Kd + p.k0 + kq * 16 + 8 * hf) = (v4u){pk2(v[0][e], v[1][e]), pk2(v[2][e], v[3][e]), pk2(v[4][e], v[5][e]), pk2(v[6][e], v[7][e])}; }
}
#define CONV_PIPELINE(NIT, GW, NGW_, MK) do { f32x4 va_[16], vb_[16]; ConvItem pa_, pb_; int it_ = (GW); \
    if (it_ < (NIT)) { pa_ = MK(it_); conv_load(pa_, F.lane, va_); } \
    for (; it_ < (NIT); it_ += 2 * (NGW_)) { const int i1_ = it_ + (NGW_), i2_ = it_ + 2 * (NGW_); \
        if (i1_ < (NIT)) { pb_ = MK(i1_); conv_load(pb_, F.lane, vb_); } \
        conv_store(pa_, F.lane, va_); \
        if (i2_ < (NIT)) { pa_ = MK(i2_); conv_load(pa_, F.lane, va_); } \
        if (i1_ < (NIT)) conv_store(pb_, F.lane, vb_); } } while (0)
__device__ __forceinline__ void conv_plain(Frame& F, const float* W, int ldw, int K, int n_lo, int n_hi, bf16* WT, int split, int shift0, int shift1, const float* gain, int gw, int NGW) {
    const int nblk = (n_hi - n_lo + 63) / 64, nit = (K / 64) * nblk;
#define MK_PLAIN(it) (ConvItem{W, WT, gain, ldw, 64 * ((it) / nblk), n_lo + 64 * ((it) % nblk), n_hi, K, split, shift0, shift1, 0})
    CONV_PIPELINE(nit, gw, NGW, MK_PLAIN);
#undef MK_PLAIN
}
__device__ __forceinline__ void zero_rows(Frame& F, bf16* WT, int K, int r0, int r1) {
    const size_t n16 = (size_t)(r1 - r0) * K / 8; GAS v4u* p = (GAS v4u*)(WT + (size_t)r0 * K);
    for (size_t i = (size_t)F.vcu * 512 + F.tid; i < n16; i += (size_t)F.G * 512) p[i] = (v4u){0u, 0u, 0u, 0u};
}
__device__ __forceinline__ ConvItem moe_item(int it, const float* wg, const float* wu, const float* wd, const float* gain, bf16* WGU, bf16* WD) {
    const int e = it / 768, r = it % 768;
    if (r < 512) { const int up = r >> 8, q = r & 255, kb = q >> 3, nb = q & 7;
        return ConvItem{(up ? wu : wg) + (size_t)e * 2048 * 512, WGU + (size_t)e * 1024 * 2048, gain, 512, 64 * kb, 64 * nb, 512, 2048, 0, up * 128, 0, 1}; }
    const int q = r - 512, kb = q >> 5, nb = q & 31;
    return ConvItem{wd + (size_t)e * 512 * 2048, WD + (size_t)e * 2048 * 512, nullptr, 2048, 64 * kb, 64 * nb, 2048, 512, 1 << 30, 0, 0, 0};
}
__device__ __forceinline__ void conv_moe(Frame& F, const float* wg, const float* wu, const float* wd, const float* gain, bf16* WGU, bf16* WD, int gw, int NGW) {
#define MK_MOE(it) moe_item((it), wg, wu, wd, gain, WGU, WD)
    CONV_PIPELINE(32 * 768, gw, NGW, MK_MOE);
#undef MK_MOE
}

struct Args { const float* in[38]; float* out; unsigned char* ws; int ph_lo, ph_hi; };
typedef const __attribute__((address_space(4))) Args* ArgP;
__device__ __forceinline__ ArgP get_args() { ArgP p = (ArgP)__builtin_amdgcn_kernarg_segment_ptr(); asm volatile("" : "+s"(p)); return p; }

__device__ __forceinline__ void p0_prologue(Frame& F, ArgP A) {
    unsigned char* ws = F.ws;
    const int gt = F.vcu * 512 + F.tid, NGT = F.G * 512;
    const int gw = F.vcu * NWAVES + F.wave, NGW = F.G * NWAVES;
    { float* rope = (float*)(ws + WS_ROPE);
      for (int i = gt; i < T * 8; i += NGT) { const int t = i >> 3, j = i & 7; const float inv = powf(500000.0f, -((float)(2 * j) / 16.0f)); const float ang = (float)t * inv;
          rope[t * 16 + j] = cosf(ang); rope[t * 16 + 8 + j] = sinf(ang); } }
    { const float* x = A->in[0]; bf16* hb = (bf16*)(ws + WS_HBA); float* part = (float*)(ws + WS_PART);
      for (int m = gw; m < NTOK; m += NGW) { const GAS f32x4* xr = (const GAS f32x4*)(x + (size_t)m * D); GAS v2u* o = (GAS v2u*)(hb + (size_t)m * D); float ss = 0.f;
#pragma unroll
          for (int j = 0; j < 8; ++j) { const f32x4 v = xr[F.lane + 64 * j]; ss += (v[0] * v[0] + v[1] * v[1]) + (v[2] * v[2] + v[3] * v[3]); o[F.lane + 64 * j] = (v2u){pk2(v[0], v[1]), pk2(v[2], v[3])}; }
          ss = red64(ss);
          if (F.lane < 32) part[(size_t)m * 32 + F.lane] = (F.lane == 0) ? ss : 0.f; } }
    { const GAS f32x4* p = (const GAS f32x4*)A->in[1]; GAS v2u* o = (GAS v2u*)(ws + WS_PB);
      for (int i = gt; i < 2 * NTOK * 256 / 4; i += NGT) { const f32x4 v = p[i]; o[i] = (v2u){pk2(v[0], v[1]), pk2(v[2], v[3])}; } }
    { float* rw = (float*)(ws + WS_RW);
      for (int i = gt; i < 2 * 36 * D; i += NGT) { const int l = i / (36 * D), r = i % (36 * D), row = r / D, k = r % D;
          const float w = (row < 32) ? A->in[30][((size_t)l * D + k) * 32 + row] : A->in[28][((size_t)l * D + k) * 4 + (row - 32)];
          rw[i] = w * A->in[3][l * D + k]; } }
    { bf16* wl2 = (bf16*)(ws + WS_WL2);
      for (int i = gt; i < 2 * 4096 * LK; i += NGT) { const int l = i / (4096 * LK), r = i % (4096 * LK), c = r / LK, j = r % LK, seg = c >> 10, cc = c & 1023; float v = 0.f;
          if (seg == 0 && j < 64) v = A->in[9][(size_t)l * 64 * 1024 + (size_t)j * 1024 + cc];
          else if (seg == 1 && j >= 64 && j < 128) v = A->in[11][(size_t)l * 64 * 1024 + (size_t)(j - 64) * 1024 + cc];
          else if (seg == 2 && j >= 128 && j < 288) v = A->in[12][(size_t)l * 160 * 1024 + (size_t)(j - 128) * 1024 + cc];
          else if (seg == 3 && j >= 288 && j < 320 && l == 1) v = A->in[14][(size_t)(j - 288) * 1024 + cc];
          wl2[i] = (bf16)f2bf(v); } }
    { bf16* w0 = (bf16*)(ws + WS_WIN);
      conv_plain(F, A->in[4], 6432, D, 0, 6432, w0, 3360, 0, 224, A->in[2], gw, NGW);
      zero_rows(F, w0, D, 3360, 3584); }
}

__device__ __forceinline__ void conv_deferred(Frame& F, ArgP A, int gw, int NGW) {
    unsigned char* ws = F.ws;
    { bf16* w1 = (bf16*)(ws + WS_WIN) + (size_t)PPITCH * D;
      conv_plain(F, A->in[5], 6464, D, 0, 6464, w1, 3392, 0, 192, A->in[2] + D, gw, NGW);
      const size_t n16 = (size_t)(3584 - 3392) * D / 8; GAS v4u* p = (GAS v4u*)(w1 + (size_t)3392 * D);
      for (size_t i = (size_t)gw * 64 + F.lane; i < n16; i += (size_t)NGW * 64) p[i] = (v4u){0u, 0u, 0u, 0u}; }
    for (int l = 0; l < 2; ++l) {
        conv_plain(F, A->in[27] + (size_t)l * D * D, D, D, 0, D, (bf16*)(ws + WS_WOUT) + (size_t)l * D * D, 1 << 30, 0, 0, nullptr, gw, NGW);
        conv_plain(F, A->in[35] + (size_t)l * D * D, D, D, 0, D, (bf16*)(ws + WS_WPG) + (size_t)l * D * D, 1 << 30, 0, 0, nullptr, gw, NGW);
        conv_plain(F, A->in[37] + (size_t)l * 256 * D, D, 256, 0, D, (bf16*)(ws + WS_WPP) + (size_t)l * D * 256, 1 << 30, 0, 0, nullptr, gw, NGW);
    }
}

__device__ __forceinline__ void prep1_phase(Frame& F, ArgP A, int layer) {
    unsigned char* ws = F.ws; bf16* proj = (bf16*)(ws + WS_PROJ); bf16* la = (bf16*)(ws + WS_LORAA);
    const float* mu = layer ? A->in[7] : A->in[6];
    const int gt = F.vcu * 512 + F.tid, NGT = F.G * 512;
    const float* LP = (const float*)(ws + WS_LORAO); const float* rstd1 = (const float*)(ws + WS_RSTD1);
    for (int i = gt; i < NTOK * (LK / 2); i += NGT) { const int m = i / (LK / 2), j = (i % (LK / 2)) * 2; float o0 = 0.f, o1 = 0.f;
        if (j < (layer ? 320 : 288)) { float c0 = 0.f, c1 = 0.f, q0 = 0.f, q1 = 0.f; const bool hp = (m & (T - 1)) != 0;
#pragma unroll
            for (int ks = 0; ks < 4; ++ks) { const float* p = LP + ((size_t)ks * NTOK + m) * 512 + j; c0 += p[0]; c1 += p[1]; if (hp) { q0 += p[-512]; q1 += p[-511]; } }
            const float rc = rstd1[m], rp = hp ? rstd1[m - 1] : 0.f;
            c0 = bflo(f2bf(c0 * rc)); c1 = bflo(f2bf(c1 * rc)); q0 = bflo(f2bf(q0 * rp)); q1 = bflo(f2bf(q1 * rp));
            o0 = c0 + (q0 - c0) * mu[3072 + j]; o1 = c1 + (q1 - c1) * mu[3072 + j + 1];
            if (j < 64) { o0 = tanhf(o0); o1 = tanhf(o1); } else if (j >= 128 && j < 288) { o0 = sigmoidf_(o0); o1 = sigmoidf_(o1); } }
        *(GAS unsigned*)(la + (size_t)m * LK + j) = pk2(o0, o1); }
    const float* qg = A->in[20] + layer * 64; const float* kg = A->in[21] + layer * 64; const float* rope = (const float*)(ws + WS_ROPE);
    const int gw = F.vcu * NWAVES + F.wave, NGW = F.G * NWAVES, sub = F.lane & 15;
    for (int m = gw; m < NTOK; m += NGW) { const int t = m & (T - 1);
#pragma unroll
        for (int j = 0; j < 8; ++j) { const int grp = j * 4 + (F.lane >> 4); const bool isq = grp < 16;
            bf16* p = proj + (size_t)m * PPITCH + (isq ? PC_Q + grp * 64 : PC_KA + (grp - 16) * 64) + sub * 4;
            const v2u raw = *(const GAS v2u*)p; float x[4] = {bflo(raw.x), bfhi(raw.x), bflo(raw.y), bfhi(raw.y)};
            const float ss = red16(x[0] * x[0] + x[1] * x[1] + x[2] * x[2] + x[3] * x[3]); const float rs = rsqrtf(ss * (1.0f / 64.0f) + 1e-6f);
            const float* g = isq ? qg : kg;
#pragma unroll
            for (int e = 0; e < 4; ++e) x[e] = x[e] * rs * g[sub * 4 + e];
            float y[4];
#pragma unroll
            for (int e = 0; e < 4; ++e) { const float other = __shfl_xor(x[e], 2); const int ri = (sub & 1) * 4 + e; const float cs = rope[t * 16 + ri], sn = rope[t * 16 + 8 + ri];
                y[e] = (sub < 2) ? (x[e] * cs - other * sn) : ((sub < 4) ? (x[e] * cs + other * sn) : x[e]); }
            const float sc = isq ? attn_body::C2 : 1.0f;
            *(GAS v2u*)p = (v2u){pk2(y[0] * sc, y[1] * sc), pk2(y[2] * sc, y[3] * sc)}; } }
}

constexpr int TP_NC = 32, TP_LC = 128, TP_TB = 4;
typedef float f32x2 __attribute__((ext_vector_type(2)));
#define FMAC_BC(acc, av, s, K) asm("v_fmac_f32_dpp %0, %1, %2 row_newbcast:" #K " row_mask:0xf bank_mask:0xf" : "+v"(acc) : "v"(av), "v"(s))
#define MUL_BC(dst, av, s, K) asm("v_mul_f32_dpp %0, %1, %2 row_newbcast:" #K " row_mask:0xf bank_mask:0xf" : "=v"(dst) : "v"(av), "v"(s))
#define L1_PASS1 FMAC_BC(sar0, aq0, SR[0], 0); FMAC_BC(sai0, aq0, SI[0], 0); \
    FMAC_BC(sar1, aq0, SR[1], 1); FMAC_BC(sai1, aq0, SI[1], 1); \
    FMAC_BC(sar2, aq0, SR[2], 2); FMAC_BC(sai2, aq0, SI[2], 2); \
    FMAC_BC(sar3, aq0, SR[3], 3); FMAC_BC(sai3, aq0, SI[3], 3); \
    FMAC_BC(sar0, aq0, SR[4], 4); FMAC_BC(sai0, aq0, SI[4], 4); \
    FMAC_BC(sar1, aq0, SR[5], 5); FMAC_BC(sai1, aq0, SI[5], 5); \
    FMAC_BC(sar2, aq0, SR[6], 6); FMAC_BC(sai2, aq0, SI[6], 6); \
    FMAC_BC(sar3, aq0, SR[7], 7); FMAC_BC(sai3, aq0, SI[7], 7); \
    FMAC_BC(sar0, aq0, SR[8], 8); FMAC_BC(sai0, aq0, SI[8], 8); \
    FMAC_BC(sar1, aq0, SR[9], 9); FMAC_BC(sai1, aq0, SI[9], 9); \
    FMAC_BC(sar2, aq0, SR[10], 10); FMAC_BC(sai2, aq0, SI[10], 10); \
    FMAC_BC(sar3, aq0, SR[11], 11); FMAC_BC(sai3, aq0, SI[11], 11); \
    FMAC_BC(sar0, aq0, SR[12], 12); FMAC_BC(sai0, aq0, SI[12], 12); \
    FMAC_BC(sar1, aq0, SR[13], 13); FMAC_BC(sai1, aq0, SI[13], 13); \
    FMAC_BC(sar2, aq0, SR[14], 14); FMAC_BC(sai2, aq0, SI[14], 14); \
    FMAC_BC(sar3, aq0, SR[15], 15); FMAC_BC(sai3, aq0, SI[15], 15); \
    FMAC_BC(sar0, aq1, SR[16], 0); FMAC_BC(sai0, aq1, SI[16], 0); \
    FMAC_BC(sar1, aq1, SR[17], 1); FMAC_BC(sai1, aq1, SI[17], 1); \
    FMAC_BC(sar2, aq1, SR[18], 2); FMAC_BC(sai2, aq1, SI[18], 2); \
    FMAC_BC(sar3, aq1, SR[19], 3); FMAC_BC(sai3, aq1, SI[19], 3); \
    FMAC_BC(sar0, aq1, SR[20], 4); FMAC_BC(sai0, aq1, SI[20], 4); \
    FMAC_BC(sar1, aq1, SR[21], 5); FMAC_BC(sai1, aq1, SI[21], 5); \
    FMAC_BC(sar2, aq1, SR[22], 6); FMAC_BC(sai2, aq1, SI[22], 6); \
    FMAC_BC(sar3, aq1, SR[23], 7); FMAC_BC(sai3, aq1, SI[23], 7); \
    FMAC_BC(sar0, aq1, SR[24], 8); FMAC_BC(sai0, aq1, SI[24], 8); \
    FMAC_BC(sar1, aq1, SR[25], 9); FMAC_BC(sai1, aq1, SI[25], 9); \
    FMAC_BC(sar2, aq1, SR[26], 10); FMAC_BC(sai2, aq1, SI[26], 10); \
    FMAC_BC(sar3, aq1, SR[27], 11); FMAC_BC(sai3, aq1, SI[27], 11); \
    FMAC_BC(sar0, aq1, SR[28], 12); FMAC_BC(sai0, aq1, SI[28], 12); \
    FMAC_BC(sar1, aq1, SR[29], 13); FMAC_BC(sai1, aq1, SI[29], 13); \
    FMAC_BC(sar2, aq1, SR[30], 14); FMAC_BC(sai2, aq1, SI[30], 14); \
    FMAC_BC(sar3, aq1, SR[31], 15); FMAC_BC(sai3, aq1, SI[31], 15); \
    FMAC_BC(sar0, aq2, SR[32], 0); FMAC_BC(sai0, aq2, SI[32], 0); \
    FMAC_BC(sar1, aq2, SR[33], 1); FMAC_BC(sai1, aq2, SI[33], 1); \
    FMAC_BC(sar2, aq2, SR[34], 2); FMAC_BC(sai2, aq2, SI[34], 2); \
    FMAC_BC(sar3, aq2, SR[35], 3); FMAC_BC(sai3, aq2, SI[35], 3); \
    FMAC_BC(sar0, aq2, SR[36], 4); FMAC_BC(sai0, aq2, SI[36], 4); \
    FMAC_BC(sar1, aq2, SR[37], 5); FMAC_BC(sai1, aq2, SI[37], 5); \
    FMAC_BC(sar2, aq2, SR[38], 6); FMAC_BC(sai2, aq2, SI[38], 6); \
    FMAC_BC(sar3, aq2, SR[39], 7); FMAC_BC(sai3, aq2, SI[39], 7); \
    FMAC_BC(sar0, aq2, SR[40], 8); FMAC_BC(sai0, aq2, SI[40], 8); \
    FMAC_BC(sar1, aq2, SR[41], 9); FMAC_BC(sai1, aq2, SI[41], 9); \
    FMAC_BC(sar2, aq2, SR[42], 10); FMAC_BC(sai2, aq2, SI[42], 10); \
    FMAC_BC(sar3, aq2, SR[43], 11); FMAC_BC(sai3, aq2, SI[43], 11); \
    FMAC_BC(sar0, aq2, SR[44], 12); FMAC_BC(sai0, aq2, SI[44], 12); \
    FMAC_BC(sar1, aq2, SR[45], 13); FMAC_BC(sai1, aq2, SI[45], 13); \
    FMAC_BC(sar2, aq2, SR[46], 14); FMAC_BC(sai2, aq2, SI[46], 14); \
    FMAC_BC(sar3, aq2, SR[47], 15); FMAC_BC(sai3, aq2, SI[47], 15); \
    FMAC_BC(sar0, aq3, SR[48], 0); FMAC_BC(sai0, aq3, SI[48], 0); \
    FMAC_BC(sar1, aq3, SR[49], 1); FMAC_BC(sai1, aq3, SI[49], 1); \
    FMAC_BC(sar2, aq3, SR[50], 2); FMAC_BC(sai2, aq3, SI[50], 2); \
    FMAC_BC(sar3, aq3, SR[51], 3); FMAC_BC(sai3, aq3, SI[51], 3); \
    FMAC_BC(sar0, aq3, SR[52], 4); FMAC_BC(sai0, aq3, SI[52], 4); \
    FMAC_BC(sar1, aq3, SR[53], 5); FMAC_BC(sai1, aq3, SI[53], 5); \
    FMAC_BC(sar2, aq3, SR[54], 6); FMAC_BC(sai2, aq3, SI[54], 6); \
    FMAC_BC(sar3, aq3, SR[55], 7); FMAC_BC(sai3, aq3, SI[55], 7); \
    FMAC_BC(sar0, aq3, SR[56], 8); FMAC_BC(sai0, aq3, SI[56], 8); \
    FMAC_BC(sar1, aq3, SR[57], 9); FMAC_BC(sai1, aq3, SI[57], 9); \
    FMAC_BC(sar2, aq3, SR[58], 10); FMAC_BC(sai2, aq3, SI[58], 10); \
    FMAC_BC(sar3, aq3, SR[59], 11); FMAC_BC(sai3, aq3, SI[59], 11); \
    FMAC_BC(sar0, aq3, SR[60], 12); FMAC_BC(sai0, aq3, SI[60], 12); \
    FMAC_BC(sar1, aq3, SR[61], 13); FMAC_BC(sai1, aq3, SI[61], 13); \
    FMAC_BC(sar2, aq3, SR[62], 14); FMAC_BC(sai2, aq3, SI[62], 14); \
    FMAC_BC(sar3, aq3, SR[63], 15); FMAC_BC(sai3, aq3, SI[63], 15);
#define L1_PASS2 { float t_, u_; MUL_BC(t_, wq0, SR[0], 0); FMAC_BC(t_, bq0, sar, 0); FMAC_BC(t_, kq0, vcur, 0); SR[0] = t_; FMAC_BC(yr0, rq0, t_, 0); MUL_BC(u_, wq0, SI[0], 0); FMAC_BC(u_, bq0, sai, 0); SI[0] = u_; FMAC_BC(yi0, rq0, u_, 0); } \
    { float t_, u_; MUL_BC(t_, wq0, SR[1], 1); FMAC_BC(t_, bq0, sar, 1); FMAC_BC(t_, kq0, vcur, 1); SR[1] = t_; FMAC_BC(yr1, rq0, t_, 1); MUL_BC(u_, wq0, SI[1], 1); FMAC_BC(u_, bq0, sai, 1); SI[1] = u_; FMAC_BC(yi1, rq0, u_, 1); } \
    { float t_, u_; MUL_BC(t_, wq0, SR[2], 2); FMAC_BC(t_, bq0, sar, 2); FMAC_BC(t_, kq0, vcur, 2); SR[2] = t_; FMAC_BC(yr2, rq0, t_, 2); MUL_BC(u_, wq0, SI[2], 2); FMAC_BC(u_, bq0, sai, 2); SI[2] = u_; FMAC_BC(yi2, rq0, u_, 2); } \
    { float t_, u_; MUL_BC(t_, wq0, SR[3], 3); FMAC_BC(t_, bq0, sar, 3); FMAC_BC(t_, kq0, vcur, 3); SR[3] = t_; FMAC_BC(yr3, rq0, t_, 3); MUL_BC(u_, wq0, SI[3], 3); FMAC_BC(u_, bq0, sai, 3); SI[3] = u_; FMAC_BC(yi3, rq0, u_, 3); } \
    { float t_, u_; MUL_BC(t_, wq0, SR[4], 4); FMAC_BC(t_, bq0, sar, 4); FMAC_BC(t_, kq0, vcur, 4); SR[4] = t_; FMAC_BC(yr0, rq0, t_, 4); MUL_BC(u_, wq0, SI[4], 4); FMAC_BC(u_, bq0, sai, 4); SI[4] = u_; FMAC_BC(yi0, rq0, u_, 4); } \
    { float t_, u_; MUL_BC(t_, wq0, SR[5], 5); FMAC_BC(t_, bq0, sar, 5); FMAC_BC(t_, kq0, vcur, 5); SR[5] = t_; FMAC_BC(yr1, rq0, t_, 5); MUL_BC(u_, wq0, SI[5], 5); FMAC_BC(u_, bq0, sai, 5); SI[5] = u_; FMAC_BC(yi1, rq0, u_, 5); } \
    { float t_, u_; MUL_BC(t_, wq0, SR[6], 6); FMAC_BC(t_, bq0, sar, 6); FMAC_BC(t_, kq0, vcur, 6); SR[6] = t_; FMAC_BC(yr2, rq0, t_, 6); MUL_BC(u_, wq0, SI[6], 6); FMAC_BC(u_, bq0, sai, 6); SI[6] = u_; FMAC_BC(yi2, rq0, u_, 6); } \
    { float t_, u_; MUL_BC(t_, wq0, SR[7], 7); FMAC_BC(t_, bq0, sar, 7); FMAC_BC(t_, kq0, vcur, 7); SR[7] = t_; FMAC_BC(yr3, rq0, t_, 7); MUL_BC(u_, wq0, SI[7], 7); FMAC_BC(u_, bq0, sai, 7); SI[7] = u_; FMAC_BC(yi3, rq0, u_, 7); } \
    { float t_, u_; MUL_BC(t_, wq0, SR[8], 8); FMAC_BC(t_, bq0, sar, 8); FMAC_BC(t_, kq0, vcur, 8); SR[8] = t_; FMAC_BC(yr0, rq0, t_, 8); MUL_BC(u_, wq0, SI[8], 8); FMAC_BC(u_, bq0, sai, 8); SI[8] = u_; FMAC_BC(yi0, rq0, u_, 8); } \
    { float t_, u_; MUL_BC(t_, wq0, SR[9], 9); FMAC_BC(t_, bq0, sar, 9); FMAC_BC(t_, kq0, vcur, 9); SR[9] = t_; FMAC_BC(yr1, rq0, t_, 9); MUL_BC(u_, wq0, SI[9], 9); FMAC_BC(u_, bq0, sai, 9); SI[9] = u_; FMAC_BC(yi1, rq0, u_, 9); } \
    { float t_, u_; MUL_BC(t_, wq0, SR[10], 10); FMAC_BC(t_, bq0, sar, 10); FMAC_BC(t_, kq0, vcur, 10); SR[10] = t_; FMAC_BC(yr2, rq0, t_, 10); MUL_BC(u_, wq0, SI[10], 10); FMAC_BC(u_, bq0, sai, 10); SI[10] = u_; FMAC_BC(yi2, rq0, u_, 10); } \
    { float t_, u_; MUL_BC(t_, wq0, SR[11], 11); FMAC_BC(t_, bq0, sar, 11); FMAC_BC(t_, kq0, vcur, 11); SR[11] = t_; FMAC_BC(yr3, rq0, t_, 11); MUL_BC(u_, wq0, SI[11], 11); FMAC_BC(u_, bq0, sai, 11); SI[11] = u_; FMAC_BC(yi3, rq0, u_, 11); } \
    { float t_, u_; MUL_BC(t_, wq0, SR[12], 12); FMAC_BC(t_, bq0, sar, 12); FMAC_BC(t_, kq0, vcur, 12); SR[12] = t_; FMAC_BC(yr0, rq0, t_, 12); MUL_BC(u_, wq0, SI[12], 12); FMAC_BC(u_, bq0, sai, 12); SI[12] = u_; FMAC_BC(yi0, rq0, u_, 12); } \
    { float t_, u_; MUL_BC(t_, wq0, SR[13], 13); FMAC_BC(t_, bq0, sar, 13); FMAC_BC(t_, kq0, vcur, 13); SR[13] = t_; FMAC_BC(yr1, rq0, t_, 13); MUL_BC(u_, wq0, SI[13], 13); FMAC_BC(u_, bq0, sai, 13); SI[13] = u_; FMAC_BC(yi1, rq0, u_, 13); } \
    { float t_, u_; MUL_BC(t_, wq0, SR[14], 14); FMAC_BC(t_, bq0, sar, 14); FMAC_BC(t_, kq0, vcur, 14); SR[14] = t_; FMAC_BC(yr2, rq0, t_, 14); MUL_BC(u_, wq0, SI[14], 14); FMAC_BC(u_, bq0, sai, 14); SI[14] = u_; FMAC_BC(yi2, rq0, u_, 14); } \
    { float t_, u_; MUL_BC(t_, wq0, SR[15], 15); FMAC_BC(t_, bq0, sar, 15); FMAC_BC(t_, kq0, vcur, 15); SR[15] = t_; FMAC_BC(yr3, rq0, t_, 15); MUL_BC(u_, wq0, SI[15], 15); FMAC_BC(u_, bq0, sai, 15); SI[15] = u_; FMAC_BC(yi3, rq0, u_, 15); } \
    { float t_, u_; MUL_BC(t_, wq1, SR[16], 0); FMAC_BC(t_, bq1, sar, 0); FMAC_BC(t_, kq1, vcur, 0); SR[16] = t_; FMAC_BC(yr0, rq1, t_, 0); MUL_BC(u_, wq1, SI[16], 0); FMAC_BC(u_, bq1, sai, 0); SI[16] = u_; FMAC_BC(yi0, rq1, u_, 0); } \
    { float t_, u_; MUL_BC(t_, wq1, SR[17], 1); FMAC_BC(t_, bq1, sar, 1); FMAC_BC(t_, kq1, vcur, 1); SR[17] = t_; FMAC_BC(yr1, rq1, t_, 1); MUL_BC(u_, wq1, SI[17], 1); FMAC_BC(u_, bq1, sai, 1); SI[17] = u_; FMAC_BC(yi1, rq1, u_, 1); } \
    { float t_, u_; MUL_BC(t_, wq1, SR[18], 2); FMAC_BC(t_, bq1, sar, 2); FMAC_BC(t_, kq1, vcur, 2); SR[18] = t_; FMAC_BC(yr2, rq1, t_, 2); MUL_BC(u_, wq1, SI[18], 2); FMAC_BC(u_, bq1, sai, 2); SI[18] = u_; FMAC_BC(yi2, rq1, u_, 2); } \
    { float t_, u_; MUL_BC(t_, wq1, SR[19], 3); FMAC_BC(t_, bq1, sar, 3); FMAC_BC(t_, kq1, vcur, 3); SR[19] = t_; FMAC_BC(yr3, rq1, t_, 3); MUL_BC(u_, wq1, SI[19], 3); FMAC_BC(u_, bq1, sai, 3); SI[19] = u_; FMAC_BC(yi3, rq1, u_, 3); } \
    { float t_, u_; MUL_BC(t_, wq1, SR[20], 4); FMAC_BC(t_, bq1, sar, 4); FMAC_BC(t_, kq1, vcur, 4); SR[20] = t_; FMAC_BC(yr0, rq1, t_, 4); MUL_BC(u_, wq1, SI[20], 4); FMAC_BC(u_, bq1, sai, 4); SI[20] = u_; FMAC_BC(yi0, rq1, u_, 4); } \
    { float t_, u_; MUL_BC(t_, wq1, SR[21], 5); FMAC_BC(t_, bq1, sar, 5); FMAC_BC(t_, kq1, vcur, 5); SR[21] = t_; FMAC_BC(yr1, rq1, t_, 5); MUL_BC(u_, wq1, SI[21], 5); FMAC_BC(u_, bq1, sai, 5); SI[21] = u_; FMAC_BC(yi1, rq1, u_, 5); } \
    { float t_, u_; MUL_BC(t_, wq1, SR[22], 6); FMAC_BC(t_, bq1, sar, 6); FMAC_BC(t_, kq1, vcur, 6); SR[22] = t_; FMAC_BC(yr2, rq1, t_, 6); MUL_BC(u_, wq1, SI[22], 6); FMAC_BC(u_, bq1, sai, 6); SI[22] = u_; FMAC_BC(yi2, rq1, u_, 6); } \
    { float t_, u_; MUL_BC(t_, wq1, SR[23], 7); FMAC_BC(t_, bq1, sar, 7); FMAC_BC(t_, kq1, vcur, 7); SR[23] = t_; FMAC_BC(yr3, rq1, t_, 7); MUL_BC(u_, wq1, SI[23], 7); FMAC_BC(u_, bq1, sai, 7); SI[23] = u_; FMAC_BC(yi3, rq1, u_, 7); } \
    { float t_, u_; MUL_BC(t_, wq1, SR[24], 8); FMAC_BC(t_, bq1, sar, 8); FMAC_BC(t_, kq1, vcur, 8); SR[24] = t_; FMAC_BC(yr0, rq1, t_, 8); MUL_BC(u_, wq1, SI[24], 8); FMAC_BC(u_, bq1, sai, 8); SI[24] = u_; FMAC_BC(yi0, rq1, u_, 8); } \
    { float t_, u_; MUL_BC(t_, wq1, SR[25], 9); FMAC_BC(t_, bq1, sar, 9); FMAC_BC(t_, kq1, vcur, 9); SR[25] = t_; FMAC_BC(yr1, rq1, t_, 9); MUL_BC(u_, wq1, SI[25], 9); FMAC_BC(u_, bq1, sai, 9); SI[25] = u_; FMAC_BC(yi1, rq1, u_, 9); } \
    { float t_, u_; MUL_BC(t_, wq1, SR[26], 10); FMAC_BC(t_, bq1, sar, 10); FMAC_BC(t_, kq1, vcur, 10); SR[26] = t_; FMAC_BC(yr2, rq1, t_, 10); MUL_BC(u_, wq1, SI[26], 10); FMAC_BC(u_, bq1, sai, 10); SI[26] = u_; FMAC_BC(yi2, rq1, u_, 10); } \
    { float t_, u_; MUL_BC(t_, wq1, SR[27], 11); FMAC_BC(t_, bq1, sar, 11); FMAC_BC(t_, kq1, vcur, 11); SR[27] = t_; FMAC_BC(yr3, rq1, t_, 11); MUL_BC(u_, wq1, SI[27], 11); FMAC_BC(u_, bq1, sai, 11); SI[27] = u_; FMAC_BC(yi3, rq1, u_, 11); } \
    { float t_, u_; MUL_BC(t_, wq1, SR[28], 12); FMAC_BC(t_, bq1, sar, 12); FMAC_BC(t_, kq1, vcur, 12); SR[28] = t_; FMAC_BC(yr0, rq1, t_, 12); MUL_BC(u_, wq1, SI[28], 12); FMAC_BC(u_, bq1, sai, 12); SI[28] = u_; FMAC_BC(yi0, rq1, u_, 12); } \
    { float t_, u_; MUL_BC(t_, wq1, SR[29], 13); FMAC_BC(t_, bq1, sar, 13); FMAC_BC(t_, kq1, vcur, 13); SR[29] = t_; FMAC_BC(yr1, rq1, t_, 13); MUL_BC(u_, wq1, SI[29], 13); FMAC_BC(u_, bq1, sai, 13); SI[29] = u_; FMAC_BC(yi1, rq1, u_, 13); } \
    { float t_, u_; MUL_BC(t_, wq1, SR[30], 14); FMAC_BC(t_, bq1, sar, 14); FMAC_BC(t_, kq1, vcur, 14); SR[30] = t_; FMAC_BC(yr2, rq1, t_, 14); MUL_BC(u_, wq1, SI[30], 14); FMAC_BC(u_, bq1, sai, 14); SI[30] = u_; FMAC_BC(yi2, rq1, u_, 14); } \
    { float t_, u_; MUL_BC(t_, wq1, SR[31], 15); FMAC_BC(t_, bq1, sar, 15); FMAC_BC(t_, kq1, vcur, 15); SR[31] = t_; FMAC_BC(yr3, rq1, t_, 15); MUL_BC(u_, wq1, SI[31], 15); FMAC_BC(u_, bq1, sai, 15); SI[31] = u_; FMAC_BC(yi3, rq1, u_, 15); } \
    { float t_, u_; MUL_BC(t_, wq2, SR[32], 0); FMAC_BC(t_, bq2, sar, 0); FMAC_BC(t_, kq2, vcur, 0); SR[32] = t_; FMAC_BC(yr0, rq2, t_, 0); MUL_BC(u_, wq2, SI[32], 0); FMAC_BC(u_, bq2, sai, 0); SI[32] = u_; FMAC_BC(yi0, rq2, u_, 0); } \
    { float t_, u_; MUL_BC(t_, wq2, SR[33], 1); FMAC_BC(t_, bq2, sar, 1); FMAC_BC(t_, kq2, vcur, 1); SR[33] = t_; FMAC_BC(yr1, rq2, t_, 1); MUL_BC(u_, wq2, SI[33], 1); FMAC_BC(u_, bq2, sai, 1); SI[33] = u_; FMAC_BC(yi1, rq2, u_, 1); } \
    { float t_, u_; MUL_BC(t_, wq2, SR[34], 2); FMAC_BC(t_, bq2, sar, 2); FMAC_BC(t_, kq2, vcur, 2); SR[34] = t_; FMAC_BC(yr2, rq2, t_, 2); MUL_BC(u_, wq2, SI[34], 2); FMAC_BC(u_, bq2, sai, 2); SI[34] = u_; FMAC_BC(yi2, rq2, u_, 2); } \
    { float t_, u_; MUL_BC(t_, wq2, SR[35], 3); FMAC_BC(t_, bq2, sar, 3); FMAC_BC(t_, kq2, vcur, 3); SR[35] = t_; FMAC_BC(yr3, rq2, t_, 3); MUL_BC(u_, wq2, SI[35], 3); FMAC_BC(u_, bq2, sai, 3); SI[35] = u_; FMAC_BC(yi3, rq2, u_, 3); } \
    { float t_, u_; MUL_BC(t_, wq2, SR[36], 4); FMAC_BC(t_, bq2, sar, 4); FMAC_BC(t_, kq2, vcur, 4); SR[36] = t_; FMAC_BC(yr0, rq2, t_, 4); MUL_BC(u_, wq2, SI[36], 4); FMAC_BC(u_, bq2, sai, 4); SI[36] = u_; FMAC_BC(yi0, rq2, u_, 4); } \
    { float t_, u_; MUL_BC(t_, wq2, SR[37], 5); FMAC_BC(t_, bq2, sar, 5); FMAC_BC(t_, kq2, vcur, 5); SR[37] = t_; FMAC_BC(yr1, rq2, t_, 5); MUL_BC(u_, wq2, SI[37], 5); FMAC_BC(u_, bq2, sai, 5); SI[37] = u_; FMAC_BC(yi1, rq2, u_, 5); } \
    { float t_, u_; MUL_BC(t_, wq2, SR[38], 6); FMAC_BC(t_, bq2, sar, 6); FMAC_BC(t_, kq2, vcur, 6); SR[38] = t_; FMAC_BC(yr2, rq2, t_, 6); MUL_BC(u_, wq2, SI[38], 6); FMAC_BC(u_, bq2, sai, 6); SI[38] = u_; FMAC_BC(yi2, rq2, u_, 6); } \
    { float t_, u_; MUL_BC(t_, wq2, SR[39], 7); FMAC_BC(t_, bq2, sar, 7); FMAC_BC(t_, kq2, vcur, 7); SR[39] = t_; FMAC_BC(yr3, rq2, t_, 7); MUL_BC(u_, wq2, SI[39], 7); FMAC_BC(u_, bq2, sai, 7); SI[39] = u_; FMAC_BC(yi3, rq2, u_, 7); } \
    { float t_, u_; MUL_BC(t_, wq2, SR[40], 8); FMAC_BC(t_, bq2, sar, 8); FMAC_BC(t_, kq2, vcur, 8); SR[40] = t_; FMAC_BC(yr0, rq2, t_, 8); MUL_BC(u_, wq2, SI[40], 8); FMAC_BC(u_, bq2, sai, 8); SI[40] = u_; FMAC_BC(yi0, rq2, u_, 8); } \
    { float t_, u_; MUL_BC(t_, wq2, SR[41], 9); FMAC_BC(t_, bq2, sar, 9); FMAC_BC(t_, kq2, vcur, 9); SR[41] = t_; FMAC_BC(yr1, rq2, t_, 9); MUL_BC(u_, wq2, SI[41], 9); FMAC_BC(u_, bq2, sai, 9); SI[41] = u_; FMAC_BC(yi1, rq2, u_, 9); } \
    { float t_, u_; MUL_BC(t_, wq2, SR[42], 10); FMAC_BC(t_, bq2, sar, 10); FMAC_BC(t_, kq2, vcur, 10); SR[42] = t_; FMAC_BC(yr2, rq2, t_, 10); MUL_BC(u_, wq2, SI[42], 10); FMAC_BC(u_, bq2, sai, 10); SI[42] = u_; FMAC_BC(yi2, rq2, u_, 10); } \
    { float t_, u_; MUL_BC(t_, wq2, SR[43], 11); FMAC_BC(t_, bq2, sar, 11); FMAC_BC(t_, kq2, vcur, 11); SR[43] = t_; FMAC_BC(yr3, rq2, t_, 11); MUL_BC(u_, wq2, SI[43], 11); FMAC_BC(u_, bq2, sai, 11); SI[43] = u_; FMAC_BC(yi3, rq2, u_, 11); } \
    { float t_, u_; MUL_BC(t_, wq2, SR[44], 12); FMAC_BC(t_, bq2, sar, 12); FMAC_BC(t_, kq2, vcur, 12); SR[44] = t_; FMAC_BC(yr0, rq2, t_, 12); MUL_BC(u_, wq2, SI[44], 12); FMAC_BC(u_, bq2, sai, 12); SI[44] = u_; FMAC_BC(yi0, rq2, u_, 12); } \
    { float t_, u_; MUL_BC(t_, wq2, SR[45], 13); FMAC_BC(t_, bq2, sar, 13); FMAC_BC(t_, kq2, vcur, 13); SR[45] = t_; FMAC_BC(yr1, rq2, t_, 13); MUL_BC(u_, wq2, SI[45], 13); FMAC_BC(u_, bq2, sai, 13); SI[45] = u_; FMAC_BC(yi1, rq2, u_, 13); } \
    { float t_, u_; MUL_BC(t_, wq2, SR[46], 14); FMAC_BC(t_, bq2, sar, 14); FMAC_BC(t_, kq2, vcur, 14); SR[46] = t_; FMAC_BC(yr2, rq2, t_, 14); MUL_BC(u_, wq2, SI[46], 14); FMAC_BC(u_, bq2, sai, 14); SI[46] = u_; FMAC_BC(yi2, rq2, u_, 14); } \
    { float t_, u_; MUL_BC(t_, wq2, SR[47], 15); FMAC_BC(t_, bq2, sar, 15); FMAC_BC(t_, kq2, vcur, 15); SR[47] = t_; FMAC_BC(yr3, rq2, t_, 15); MUL_BC(u_, wq2, SI[47], 15); FMAC_BC(u_, bq2, sai, 15); SI[47] = u_; FMAC_BC(yi3, rq2, u_, 15); } \
    { float t_, u_; MUL_BC(t_, wq3, SR[48], 0); FMAC_BC(t_, bq3, sar, 0); FMAC_BC(t_, kq3, vcur, 0); SR[48] = t_; FMAC_BC(yr0, rq3, t_, 0); MUL_BC(u_, wq3, SI[48], 0); FMAC_BC(u_, bq3, sai, 0); SI[48] = u_; FMAC_BC(yi0, rq3, u_, 0); } \
    { float t_, u_; MUL_BC(t_, wq3, SR[49], 1); FMAC_BC(t_, bq3, sar, 1); FMAC_BC(t_, kq3, vcur, 1); SR[49] = t_; FMAC_BC(yr1, rq3, t_, 1); MUL_BC(u_, wq3, SI[49], 1); FMAC_BC(u_, bq3, sai, 1); SI[49] = u_; FMAC_BC(yi1, rq3, u_, 1); } \
    { float t_, u_; MUL_BC(t_, wq3, SR[50], 2); FMAC_BC(t_, bq3, sar, 2); FMAC_BC(t_, kq3, vcur, 2); SR[50] = t_; FMAC_BC(yr2, rq3, t_, 2); MUL_BC(u_, wq3, SI[50], 2); FMAC_BC(u_, bq3, sai, 2); SI[50] = u_; FMAC_BC(yi2, rq3, u_, 2); } \
    { float t_, u_; MUL_BC(t_, wq3, SR[51], 3); FMAC_BC(t_, bq3, sar, 3); FMAC_BC(t_, kq3, vcur, 3); SR[51] = t_; FMAC_BC(yr3, rq3, t_, 3); MUL_BC(u_, wq3, SI[51], 3); FMAC_BC(u_, bq3, sai, 3); SI[51] = u_; FMAC_BC(yi3, rq3, u_, 3); } \
    { float t_, u_; MUL_BC(t_, wq3, SR[52], 4); FMAC_BC(t_, bq3, sar, 4); FMAC_BC(t_, kq3, vcur, 4); SR[52] = t_; FMAC_BC(yr0, rq3, t_, 4); MUL_BC(u_, wq3, SI[52], 4); FMAC_BC(u_, bq3, sai, 4); SI[52] = u_; FMAC_BC(yi0, rq3, u_, 4); } \
    { float t_, u_; MUL_BC(t_, wq3, SR[53], 5); FMAC_BC(t_, bq3, sar, 5); FMAC_BC(t_, kq3, vcur, 5); SR[53] = t_; FMAC_BC(yr1, rq3, t_, 5); MUL_BC(u_, wq3, SI[53], 5); FMAC_BC(u_, bq3, sai, 5); SI[53] = u_; FMAC_BC(yi1, rq3, u_, 5); } \
    { float t_, u_; MUL_BC(t_, wq3, SR[54], 6); FMAC_BC(t_, bq3, sar, 6); FMAC_BC(t_, kq3, vcur, 6); SR[54] = t_; FMAC_BC(yr2, rq3, t_, 6); MUL_BC(u_, wq3, SI[54], 6); FMAC_BC(u_, bq3, sai, 6); SI[54] = u_; FMAC_BC(yi2, rq3, u_, 6); } \
    { float t_, u_; MUL_BC(t_, wq3, SR[55], 7); FMAC_BC(t_, bq3, sar, 7); FMAC_BC(t_, kq3, vcur, 7); SR[55] = t_; FMAC_BC(yr3, rq3, t_, 7); MUL_BC(u_, wq3, SI[55], 7); FMAC_BC(u_, bq3, sai, 7); SI[55] = u_; FMAC_BC(yi3, rq3, u_, 7); } \
    { float t_, u_; MUL_BC(t_, wq3, SR[56], 8); FMAC_BC(t_, bq3, sar, 8); FMAC_BC(t_, kq3, vcur, 8); SR[56] = t_; FMAC_BC(yr0, rq3, t_, 8); MUL_BC(u_, wq3, SI[56], 8); FMAC_BC(u_, bq3, sai, 8); SI[56] = u_; FMAC_BC(yi0, rq3, u_, 8); } \
    { float t_, u_; MUL_BC(t_, wq3, SR[57], 9); FMAC_BC(t_, bq3, sar, 9); FMAC_BC(t_, kq3, vcur, 9); SR[57] = t_; FMAC_BC(yr1, rq3, t_, 9); MUL_BC(u_, wq3, SI[57], 9); FMAC_BC(u_, bq3, sai, 9); SI[57] = u_; FMAC_BC(yi1, rq3, u_, 9); } \
    { float t_, u_; MUL_BC(t_, wq3, SR[58], 10); FMAC_BC(t_, bq3, sar, 10); FMAC_BC(t_, kq3, vcur, 10); SR[58] = t_; FMAC_BC(yr2, rq3, t_, 10); MUL_BC(u_, wq3, SI[58], 10); FMAC_BC(u_, bq3, sai, 10); SI[58] = u_; FMAC_BC(yi2, rq3, u_, 10); } \
    { float t_, u_; MUL_BC(t_, wq3, SR[59], 11); FMAC_BC(t_, bq3, sar, 11); FMAC_BC(t_, kq3, vcur, 11); SR[59] = t_; FMAC_BC(yr3, rq3, t_, 11); MUL_BC(u_, wq3, SI[59], 11); FMAC_BC(u_, bq3, sai, 11); SI[59] = u_; FMAC_BC(yi3, rq3, u_, 11); } \
    { float t_, u_; MUL_BC(t_, wq3, SR[60], 12); FMAC_BC(t_, bq3, sar, 12); FMAC_BC(t_, kq3, vcur, 12); SR[60] = t_; FMAC_BC(yr0, rq3, t_, 12); MUL_BC(u_, wq3, SI[60], 12); FMAC_BC(u_, bq3, sai, 12); SI[60] = u_; FMAC_BC(yi0, rq3, u_, 12); } \
    { float t_, u_; MUL_BC(t_, wq3, SR[61], 13); FMAC_BC(t_, bq3, sar, 13); FMAC_BC(t_, kq3, vcur, 13); SR[61] = t_; FMAC_BC(yr1, rq3, t_, 13); MUL_BC(u_, wq3, SI[61], 13); FMAC_BC(u_, bq3, sai, 13); SI[61] = u_; FMAC_BC(yi1, rq3, u_, 13); } \
    { float t_, u_; MUL_BC(t_, wq3, SR[62], 14); FMAC_BC(t_, bq3, sar, 14); FMAC_BC(t_, kq3, vcur, 14); SR[62] = t_; FMAC_BC(yr2, rq3, t_, 14); MUL_BC(u_, wq3, SI[62], 14); FMAC_BC(u_, bq3, sai, 14); SI[62] = u_; FMAC_BC(yi2, rq3, u_, 14); } \
    { float t_, u_; MUL_BC(t_, wq3, SR[63], 15); FMAC_BC(t_, bq3, sar, 15); FMAC_BC(t_, kq3, vcur, 15); SR[63] = t_; FMAC_BC(yr3, rq3, t_, 15); MUL_BC(u_, wq3, SI[63], 15); FMAC_BC(u_, bq3, sai, 15); SI[63] = u_; FMAC_BC(yi3, rq3, u_, 15); }
#define L3_DOT FMAC_BC(a0, qq0, R[0], 0); \
    FMAC_BC(a1, qq0, R[1], 1); \
    FMAC_BC(a2, qq0, R[2], 2); \
    FMAC_BC(a3, qq0, R[3], 3); \
    FMAC_BC(a0, qq0, R[4], 4); \
    FMAC_BC(a1, qq0, R[5], 5); \
    FMAC_BC(a2, qq0, R[6], 6); \
    FMAC_BC(a3, qq0, R[7], 7); \
    FMAC_BC(a0, qq0, R[8], 8); \
    FMAC_BC(a1, qq0, R[9], 9); \
    FMAC_BC(a2, qq0, R[10], 10); \
    FMAC_BC(a3, qq0, R[11], 11); \
    FMAC_BC(a0, qq0, R[12], 12); \
    FMAC_BC(a1, qq0, R[13], 13); \
    FMAC_BC(a2, qq0, R[14], 14); \
    FMAC_BC(a3, qq0, R[15], 15); \
    FMAC_BC(a0, qq1, R[16], 0); \
    FMAC_BC(a1, qq1, R[17], 1); \
    FMAC_BC(a2, qq1, R[18], 2); \
    FMAC_BC(a3, qq1, R[19], 3); \
    FMAC_BC(a0, qq1, R[20], 4); \
    FMAC_BC(a1, qq1, R[21], 5); \
    FMAC_BC(a2, qq1, R[22], 6); \
    FMAC_BC(a3, qq1, R[23], 7); \
    FMAC_BC(a0, qq1, R[24], 8); \
    FMAC_BC(a1, qq1, R[25], 9); \
    FMAC_BC(a2, qq1, R[26], 10); \
    FMAC_BC(a3, qq1, R[27], 11); \
    FMAC_BC(a0, qq1, R[28], 12); \
    FMAC_BC(a1, qq1, R[29], 13); \
    FMAC_BC(a2, qq1, R[30], 14); \
    FMAC_BC(a3, qq1, R[31], 15); \
    FMAC_BC(a0, qq2, R[32], 0); \
    FMAC_BC(a1, qq2, R[33], 1); \
    FMAC_BC(a2, qq2, R[34], 2); \
    FMAC_BC(a3, qq2, R[35], 3); \
    FMAC_BC(a0, qq2, R[36], 4); \
    FMAC_BC(a1, qq2, R[37], 5); \
    FMAC_BC(a2, qq2, R[38], 6); \
    FMAC_BC(a3, qq2, R[39], 7); \
    FMAC_BC(a0, qq2, R[40], 8); \
    FMAC_BC(a1, qq2, R[41], 9); \
    FMAC_BC(a2, qq2, R[42], 10); \
    FMAC_BC(a3, qq2, R[43], 11); \
    FMAC_BC(a0, qq2, R[44], 12); \
    FMAC_BC(a1, qq2, R[45], 13); \
    FMAC_BC(a2, qq2, R[46], 14); \
    FMAC_BC(a3, qq2, R[47], 15); \
    FMAC_BC(a0, qq3, R[48], 0); \
    FMAC_BC(a1, qq3, R[49], 1); \
    FMAC_BC(a2, qq3, R[50], 2); \
    FMAC_BC(a3, qq3, R[51], 3); \
    FMAC_BC(a0, qq3, R[52], 4); \
    FMAC_BC(a1, qq3, R[53], 5); \
    FMAC_BC(a2, qq3, R[54], 6); \
    FMAC_BC(a3, qq3, R[55], 7); \
    FMAC_BC(a0, qq3, R[56], 8); \
    FMAC_BC(a1, qq3, R[57], 9); \
    FMAC_BC(a2, qq3, R[58], 10); \
    FMAC_BC(a3, qq3, R[59], 11); \
    FMAC_BC(a0, qq3, R[60], 12); \
    FMAC_BC(a1, qq3, R[61], 13); \
    FMAC_BC(a2, qq3, R[62], 14); \
    FMAC_BC(a3, qq3, R[63], 15);

__device__ __forceinline__ ConvItem any_item(int it, ArgP A, unsigned char* ws, int layer) {
    if (it < 32 * 768) return moe_item(it, A->in[32] + (size_t)layer * 32 * 2048 * 512, A->in[33] + (size_t)layer * 32 * 2048 * 512, A->in[34] + (size_t)layer * 32 * 512 * 2048, A->in[3] + layer * D, (bf16*)(ws + WS_WGU), (bf16*)(ws + WS_WD));
    it -= 32 * 768;
    if (it < 32 * 101) return ConvItem{A->in[5], (bf16*)(ws + WS_WIN) + (size_t)PPITCH * D, A->in[2] + D, 6464, 64 * (it / 101), 64 * (it % 101), 6464, D, 3392, 0, 192, 0};
    it -= 32 * 101;
    if (it < 2048) { const int l = it >> 10, q = it & 1023; return ConvItem{A->in[27] + (size_t)l * D * D, (bf16*)(ws + WS_WOUT) + (size_t)l * D * D, nullptr, D, 64 * (q >> 5), 64 * (q & 31), D, D, 1 << 30, 0, 0, 0}; }
    it -= 2048;
    if (it < 2048) { const int l = it >> 10, q = it & 1023; return ConvItem{A->in[35] + (size_t)l * D * D, (bf16*)(ws + WS_WPG) + (size_t)l * D * D, nullptr, D, 64 * (q >> 5), 64 * (q & 31), D, D, 1 << 30, 0, 0, 0}; }
    it -= 2048;
    { const int l = it >> 7, q = it & 127; return ConvItem{A->in[37] + (size_t)l * 256 * D, (bf16*)(ws + WS_WPP) + (size_t)l * D * 256, nullptr, D, 64 * (q >> 5), 64 * (q & 31), D, 256, 1 << 30, 0, 0, 0}; }
}
constexpr int N_CONV_L0 = 32 * 768 + 32 * 101 + 2048 + 2048 + 256, N_CONV_L1 = 32 * 768;
__device__ __forceinline__ void tp_level1_producer(Frame& F, ArgP A, int layer) {
    unsigned char* ws = F.ws;
    const int lane = F.lane, slot = F.wave & 3; const bool producer = F.wave >= 4;
    constexpr int BUFB = TP_TB * 1280 + TP_TB * 256, NB = TP_LC / TP_TB;
    LAS unsigned char* wl = F.lds + RING_OFF + slot * (2 * BUFB); LAS int* fl = (LAS int*)(F.lds + L1FLAG_OFF);
    const int nconv = layer ? N_CONV_L1 : N_CONV_L0; int cit = F.vcu * 4 + slot; const int cstep = F.G * 4;
    const int nrounds = (32 * TP_NC + F.G * 4 - 1) / (F.G * 4);
#pragma unroll 1
    for (int rd = 0; rd < nrounds; ++rd) {
        const int u = (rd * F.G + F.vcu) * 4 + slot; const bool act = u < 32 * TP_NC;
        __syncthreads(); if (F.tid < 8) fl[F.tid] = 0; __syncthreads();
        const int bh = act ? (u >> 5) : 0, c = u & 31, b = bh >> 4, h = bh & 15; const size_t m0 = (size_t)b * T + (size_t)c * TP_LC; const int col = h * 64, ch = col + lane;
            const bf16* proj = (const bf16*)(ws + WS_PROJ); const bf16* lo = (const bf16*)(ws + WS_LORAO); float* SV = (float*)(ws + WS_SV); float* vfirst = (float*)(ws + WS_VFIRST); float* bonus = (float*)(ws + WS_BONUS);
            const float* mu = layer ? A->in[7] : A->in[6];
            const float p_w0 = A->in[8][layer * C + ch], p_a0 = A->in[10][layer * C + ch], p_v0 = layer ? A->in[13][ch] : 0.f, p_kk = A->in[15][layer * C + ch], p_ka = A->in[16][layer * C + ch], p_rk = A->in[17][layer * C + ch];
            const float mu_r = mu[ch], mu_k = mu[1024 + ch], mu_v = mu[2048 + ch];
#define L1_LOADRAW(blk, raw, vfr) do { _Pragma("unroll") for (int s2 = 0; s2 < TP_TB; ++s2) { const size_t m = m0 + (size_t)(blk) * TP_TB + s2; const bool hp = (m & (T - 1)) != 0; const bf16* pr = proj + m * PPITCH + ch; \
                    raw[s2][0] = pr[PC_R]; raw[s2][1] = pr[PC_K]; raw[s2][2] = pr[PC_V]; raw[s2][3] = hp ? pr[PC_R - PPITCH] : (bf16)0; raw[s2][4] = hp ? pr[PC_K - PPITCH] : (bf16)0; raw[s2][5] = hp ? pr[PC_V - PPITCH] : (bf16)0; \
                    raw[s2][6] = lo[m * 4096 + ch]; raw[s2][7] = lo[m * 4096 + 1024 + ch]; raw[s2][8] = lo[m * 4096 + 3072 + ch]; vfr[s2] = layer ? vfirst[m * C + ch] : 0.f; } } while (0)
#define L1_PRODUCE(blk, raw, vfr) do { LAS unsigned char* lw_ = wl + ((blk) & 1) * BUFB; \
                _Pragma("unroll") for (int s2 = 0; s2 < TP_TB; ++s2) { const size_t m = m0 + (size_t)(blk) * TP_TB + s2; \
                    const float r_c = bflo((unsigned)raw[s2][0]), k_c = bflo((unsigned)raw[s2][1]), v_c = bflo((unsigned)raw[s2][2]), r_p = bflo((unsigned)raw[s2][3]), k_p = bflo((unsigned)raw[s2][4]), v_p = bflo((unsigned)raw[s2][5]); \
                    const float lw = bflo((unsigned)raw[s2][6]), la = bflo((unsigned)raw[s2][7]), lv = bflo((unsigned)raw[s2][8]); const float vf = vfr[s2]; \
                    const float xr = r_c + (r_p - r_c) * mu_r, xk = k_c + (k_p - k_c) * mu_k, xv = v_c + (v_p - v_c) * mu_v; \
                    const float zz = -(p_w0 + lw); const float sp = fmaxf(zz, 0.f) + log1pf(__expf(-fabsf(zz))); const float dec = __expf(-__expf(-sp - 0.5f)); \
                    const float av = sigmoidf_(p_a0 + la); const float vv = layer ? xv + (vf - xv) * sigmoidf_(p_v0 + lv) : xv; \
                    const float kkn = xk * p_kk; const float k2 = xk * (1.0f + (av - 1.0f) * p_ka); \
                    const float ssq = wave_bcast63(wave_total63(kkn * kkn)), bs = wave_bcast63(wave_total63(xr * k2 * p_rk)); \
                    const float kn = kkn * (1.0f / fmaxf(sqrtf(ssq), 1e-12f)); \
                    LAS float* ls_ = (LAS float*)(lw_ + s2 * 1280) + lane; ls_[0] = -kn; ls_[64] = dec; ls_[128] = kn * av; ls_[192] = k2; ls_[256] = xr; \
                    ((LAS float*)(lw_ + TP_TB * 1280 + s2 * 256))[lane] = vv; \
                    SV[m * C + ch] = vv; if (!layer) vfirst[m * C + ch] = xv; if (lane == 0) bonus[m * 16 + h] = bs; __builtin_amdgcn_sched_barrier(0); } } while (0)
            bf16 rawa[TP_TB][9], rawb[TP_TB][9]; float vfa[TP_TB], vfb[TP_TB];
#define L1_ITER(n_, RC, VC, RN, VN) do { f32x4 cv[16]; ConvItem it; const bool hc = cit < nconv; \
                if (hc) { it = any_item(cit, A, ws, layer); conv_load(it, lane, cv); }        \
                if (act) { if ((n_) + 1 < NB) L1_LOADRAW((n_) + 1, RN, VN); __builtin_amdgcn_sched_barrier(0); \
                    if ((n_) >= 2) { while (*(volatile LAS int*)(fl + 4 + slot) < (n_) - 1) __builtin_amdgcn_s_sleep(2); asm volatile("" ::: "memory"); } \
                    L1_PRODUCE(n_, RC, VC); \
                    asm volatile("s_waitcnt lgkmcnt(0)" ::: "memory"); if (lane == 0) *(volatile LAS int*)(fl + slot) = (n_) + 1; } \
                if (hc) { conv_store(it, lane, cv); cit += cstep; } } while (0)
            if (act) L1_LOADRAW(0, rawa, vfa);
#pragma unroll 1
            for (int n = 0; n < NB; n += 2) { L1_ITER(n, rawa, vfa, rawb, vfb); L1_ITER(n + 1, rawb, vfb, rawa, vfa); }
#undef L1_ITER
#undef L1_LOADRAW
#undef L1_PRODUCE
    }
    { for (; cit < nconv; cit += cstep) { const ConvItem it = any_item(cit, A, ws, layer); conv_half(it, lane, 0); conv_half(it, lane, 1); }
        if (!layer) { bf16* w1 = (bf16*)(ws + WS_WIN) + (size_t)PPITCH * D; const size_t n16 = (size_t)(3584 - 3392) * D / 8; GAS v4u* p = (GAS v4u*)(w1 + (size_t)3392 * D);
            for (size_t i = (size_t)(F.vcu * 4 + slot) * 64 + lane; i < n16; i += (size_t)cstep * 64) p[i] = (v4u){0u, 0u, 0u, 0u}; } }
}

__device__ __forceinline__ void tp_level1_consumer(Frame& F, ArgP A, int layer) {
    unsigned char* ws = F.ws;
    const int lane = F.lane, slot = F.wave & 3; const bool producer = F.wave >= 4;
    constexpr int BUFB = TP_TB * 1280 + TP_TB * 256, NB = TP_LC / TP_TB;
    LAS unsigned char* wl = F.lds + RING_OFF + slot * (2 * BUFB); LAS int* fl = (LAS int*)(F.lds + L1FLAG_OFF);
    const int nconv = layer ? N_CONV_L1 : N_CONV_L0; int cit = F.vcu * 4 + slot; const int cstep = F.G * 4;
    const int nrounds = (32 * TP_NC + F.G * 4 - 1) / (F.G * 4);
#pragma unroll 1
    for (int rd = 0; rd < nrounds; ++rd) {
        const int u = (rd * F.G + F.vcu) * 4 + slot; const bool act = u < 32 * TP_NC;
        __syncthreads(); if (F.tid < 8) fl[F.tid] = 0; __syncthreads();
        const int bh = act ? (u >> 5) : 0, c = u & 31, b = bh >> 4, h = bh & 15; const size_t m0 = (size_t)b * T + (size_t)c * TP_LC; const int col = h * 64, ch = col + lane;
            float* Yout = (float*)(ws + WS_Y); float* Qout = (float*)(ws + (layer ? WS_TPQ1 : WS_TPQ0)); float* Zout = (float*)(ws + WS_TPZ); float* Pout = (float*)(ws + WS_TPP);
            float SR[64], SI[64]; int ln = lane; asm volatile("" : "+v"(ln));
#pragma unroll
            for (int k = 0; k < 64; ++k) { SR[k] = 0.f; SI[k] = (k == ln) ? 1.f : 0.f; }
            const int l16 = (lane & 15) * 4;
#pragma unroll 1
            for (int n = 0; n < NB; ++n) {
                if (act) { const size_t mb = m0 + (size_t)n * TP_TB; const LAS unsigned char* lb = wl + (n & 1) * BUFB;
                    while (*(volatile LAS int*)(fl + slot) < n + 1) __builtin_amdgcn_s_sleep(2);
                    asm volatile("" ::: "memory");
#pragma unroll
                    for (int s2 = 0; s2 < TP_TB; ++s2) {
                        const LAS unsigned char* ls = lb + s2 * 1280 + l16;
#define LDQ(arr, q) (*(const LAS float*)(ls + (arr) * 256 + (q) * 64))
                        const float aq0 = LDQ(0, 0), aq1 = LDQ(0, 1), aq2 = LDQ(0, 2), aq3 = LDQ(0, 3), wq0 = LDQ(1, 0), wq1 = LDQ(1, 1), wq2 = LDQ(1, 2), wq3 = LDQ(1, 3);
                        const float bq0 = LDQ(2, 0), bq1 = LDQ(2, 1), bq2 = LDQ(2, 2), bq3 = LDQ(2, 3), kq0 = LDQ(3, 0), kq1 = LDQ(3, 1), kq2 = LDQ(3, 2), kq3 = LDQ(3, 3);
                        const float rq0 = LDQ(4, 0), rq1 = LDQ(4, 1), rq2 = LDQ(4, 2), rq3 = LDQ(4, 3);
#undef LDQ
                        const float vcur = *(const LAS float*)(lb + TP_TB * 1280 + s2 * 256 + lane * 4);
                        float sar0 = 0.f, sar1 = 0.f, sar2 = 0.f, sar3 = 0.f, sai0 = 0.f, sai1 = 0.f, sai2 = 0.f, sai3 = 0.f;
                        L1_PASS1
                        const float sar = (sar0 + sar1) + (sar2 + sar3), sai = (sai0 + sai1) + (sai2 + sai3);
                        float yr0 = 0.f, yr1 = 0.f, yr2 = 0.f, yr3 = 0.f, yi0 = 0.f, yi1 = 0.f, yi2 = 0.f, yi3 = 0.f;
                        L1_PASS2
                        Yout[(mb + s2) * C + col + lane] = (yr0 + yr1) + (yr2 + yr3);
                        Qout[((size_t)bh * T + (size_t)c * TP_LC + n * TP_TB + s2) * 64 + lane] = (yi0 + yi1) + (yi2 + yi3);
                    }
                    asm volatile("s_waitcnt lgkmcnt(0)" ::: "memory"); if (lane == 0) *(volatile LAS int*)(fl + 4 + slot) = n + 1; } }
            if (act) {
#pragma unroll
                for (int k = 0; k < 64; ++k) { const size_t zo = (((size_t)bh * TP_NC + c) * 64 + k) * 64 + lane;
                    Zout[zo] = SR[k]; Pout[zo] = SI[k]; } }
    }
}

__device__ __forceinline__ void tp_level1_fused(Frame& F, ArgP A, int layer) {
    if (F.wave >= 4) tp_level1_producer(F, A, layer); else tp_level1_consumer(F, A, layer);
}

__device__ __forceinline__ void tp_level2(Frame& F, int layer) {
    unsigned char* ws = F.ws; const float* TPP = (const float*)(ws + WS_TPP); const float* TPZ = (const float*)(ws + WS_TPZ); float* SC = (float*)(ws + WS_TPS + (layer ? 16 * MiB : 0));
    LAS float* PL = (LAS float*)(F.lds + RING_OFF);
    for (int u = F.vcu; u < 256; u += F.G) { const int bh = u >> 3, v = (u & 7) * 8 + F.wave;
        float S = 0.f; SC[(((size_t)bh * TP_NC + 0) * 64 + v) * 64 + F.lane] = 0.f;
        float pa[8], pb[8], za, zb;
#define L2_LOAD(P_, Z_, c_) do { Z_ = TPZ[(((size_t)bh * TP_NC + (c_)) * 64 + F.lane) * 64 + v]; \
            _Pragma("unroll") for (int q = 0; q < 8; ++q) P_[q] = TPP[((size_t)bh * TP_NC + (c_)) * 4096 + F.tid + 512 * q]; } while (0)
#define L2_STEP(P_, Z_, c_) do { LAS float* Pc = PL + ((c_) & 1) * (64 * 65); \
            _Pragma("unroll") for (int q = 0; q < 8; ++q) { const int idx = F.tid + 512 * q; Pc[(idx >> 6) * 65 + (idx & 63)] = P_[q]; } \
            const float z = Z_; \
            __syncthreads(); \
            if ((c_) + 2 < TP_NC - 1) L2_LOAD(P_, Z_, (c_) + 2); \
            float a0 = z, a1 = 0.f, a2 = 0.f, a3 = 0.f; const LAS float* prow = Pc + F.lane * 65; \
            _Pragma("unroll") for (int i = 0; i < 64; i += 4) { \
                a0 = fmaf(__int_as_float(__builtin_amdgcn_readlane(__float_as_int(S), i)), prow[i], a0); a1 = fmaf(__int_as_float(__builtin_amdgcn_readlane(__float_as_int(S), i + 1)), prow[i + 1], a1); \
                a2 = fmaf(__int_as_float(__builtin_amdgcn_readlane(__float_as_int(S), i + 2)), prow[i + 2], a2); a3 = fmaf(__int_as_float(__builtin_amdgcn_readlane(__float_as_int(S), i + 3)), prow[i + 3], a3); } \
            S = (a0 + a1) + (a2 + a3); SC[(((size_t)bh * TP_NC + (c_) + 1) * 64 + v) * 64 + F.lane] = S; } while (0)
        L2_LOAD(pa, za, 0); L2_LOAD(pb, zb, 1);
#pragma unroll 1
        for (int c = 0; c + 1 < TP_NC; c += 2) { L2_STEP(pa, za, c); if (c + 2 < TP_NC) L2_STEP(pb, zb, c + 1); }
#undef L2_LOAD
#undef L2_STEP
        __syncthreads();
    }
}
__device__ __forceinline__ void tp_level3_post(Frame& F, ArgP A, int layer) {
    unsigned char* ws = F.ws; const float* SC = (const float*)(ws + WS_TPS + (layer ? 16 * MiB : 0)); const float* Q = (const float*)(ws + (layer ? WS_TPQ1 : WS_TPQ0)); const float* Y = (const float*)(ws + WS_Y);
    const float* SV = (const float*)(ws + WS_SV); const bf16* lo = (const bf16*)(ws + WS_LORAO); const float* bonus = (const float*)(ws + WS_BONUS); bf16* cc = (bf16*)(ws + WS_CONCAT);
    const float* gng = A->in[18] + layer * C; const float* gnb = A->in[19] + layer * C;
    const int lane = F.lane; constexpr int TB3 = 8, NB3 = 64 / TB3;
    LAS unsigned char* wl = F.lds + RING_OFF + F.wave * (2 * TB3 * 256);
    const int half = F.wave >> 2;
#pragma unroll 1
    for (int u = F.vcu * 4 + (F.wave & 3); u < 32 * TP_NC; u += F.G * 4) { const int bh = u >> 5, c = u & 31; const bool corr = c != 0;
        float R[64];
        if (corr) { const f32x4* rp = (const f32x4*)(SC + (((size_t)bh * TP_NC + c) * 64 + lane) * 64);
#pragma unroll
            for (int i = 0; i < 16; ++i) { const f32x4 x = rp[i]; R[4 * i] = x[0]; R[4 * i + 1] = x[1]; R[4 * i + 2] = x[2]; R[4 * i + 3] = x[3]; } }
        else {
#pragma unroll
            for (int i = 0; i < 64; ++i) R[i] = 0.f; }
        const int l16 = (lane & 15) * 4;
        const int b = bh >> 4, h = bh & 15, col = h * 64 + lane; const size_t m0 = (size_t)b * T + (size_t)c * TP_LC + half * 64; const float* qb = Q + ((size_t)bh * T + (size_t)c * TP_LC + half * 64) * 64;
        const float gg = gng[col], gb = gnb[col];
        int vz; asm volatile("v_mov_b32 %0, 0" : "=v"(vz));
        float ya[TB3], va[TB3], ga[TB3], ba[TB3], yb[TB3], vb[TB3], gbv[TB3], bb[TB3];
#define L3_LOADV(Y_, V_, G_, B_, n_) do { _Pragma("unroll") for (int s2 = 0; s2 < TB3; ++s2) { const size_t m = m0 + (size_t)(n_) * TB3 + s2; Y_[s2] = Y[m * C + col]; V_[s2] = SV[m * C + col]; G_[s2] = bflo((unsigned)lo[m * 4096 + 2048 + col]); B_[s2] = bonus[m * 16 + h + vz]; } } while (0)
#define L3_DMA(n_) do { LAS unsigned char* lw_ = wl + ((n_) & 1) * (TB3 * 256); _Pragma("unroll") for (int i = 0; i < 2; ++i) __builtin_amdgcn_global_load_lds((const unsigned*)(qb + (size_t)(n_) * TB3 * 64 + i * 256 + lane * 4), (LAS unsigned*)(lw_ + i * 1024), 16, 0, 0); } while (0)
#define L3_BLOCK(Y_, V_, G_, B_, Yn_, Vn_, Gn_, Bn_, n_) do { \
            if ((n_) + 1 < NB3) L3_LOADV(Yn_, Vn_, Gn_, Bn_, (n_) + 1); \
              \
            if ((n_) == 0) asm volatile("s_waitcnt vmcnt(32)" ::: "memory"); else if ((n_) + 1 < NB3) asm volatile("s_waitcnt vmcnt(40)" ::: "memory"); else asm volatile("s_waitcnt vmcnt(8)" ::: "memory"); \
            if ((n_) + 1 < NB3) L3_DMA((n_) + 1); \
            const LAS unsigned char* lb = wl + ((n_) & 1) * (TB3 * 256); const size_t mb = m0 + (size_t)(n_) * TB3; \
            _Pragma("unroll") for (int s2 = 0; s2 < TB3; ++s2) { const LAS unsigned char* lq_ = lb + s2 * 256 + l16; float a0 = 0.f, a1 = 0.f, a2 = 0.f, a3 = 0.f; \
                if (corr) { const float qq0 = *(const LAS float*)(lq_), qq1 = *(const LAS float*)(lq_ + 64), qq2 = *(const LAS float*)(lq_ + 128), qq3 = *(const LAS float*)(lq_ + 192); L3_DOT } \
                const float y = Y_[s2] + ((a0 + a1) + (a2 + a3)); \
                const float mean = wave_bcast63(wave_total63(y)) * (1.0f / 64.0f); const float d = y - mean; const float var = wave_bcast63(wave_total63(d * d)) * (1.0f / 64.0f); const float rs = rsqrtf(var + 64e-5f); \
                const float o = (d * rs * gg + gb + B_[s2] * V_[s2]) * G_[s2]; \
                cc[(mb + s2) * 2048 + col] = (bf16)f2bf(o); } } while (0)
        asm volatile("s_waitcnt vmcnt(0)" ::: "memory");
        L3_LOADV(ya, va, ga, ba, 0); L3_DMA(0);
#pragma unroll 1
        for (int n = 0; n < NB3; n += 2) { L3_BLOCK(ya, va, ga, ba, yb, vb, gbv, bb, n); L3_BLOCK(yb, vb, gbv, bb, ya, va, ga, ba, n + 1); }
#undef L3_LOADV
#undef L3_DMA
#undef L3_BLOCK
    }
}
__device__ __forceinline__ f32x4 ld_bf4(const bf16* p) { const v2u r = *(const GAS v2u*)p; return (f32x4){bflo(r.x), bfhi(r.x), bflo(r.y), bfhi(r.y)}; }
__device__ __forceinline__ void post_attn(Frame& F, ArgP A, int layer) {
    unsigned char* ws = F.ws; bf16* cc = (bf16*)(ws + WS_CONCAT); const bf16* ob = (const bf16*)(ws + WS_OB); const float* sg = A->in[26] + layer * 128;
    const float lam_init = layer ? (0.8f - 0.6f * 0.74081822068171788f) : 0.2f;
    const float s1 = red64(A->in[22][layer * 64 + F.lane] * A->in[23][layer * 64 + F.lane]), s2 = red64(A->in[24][layer * 64 + F.lane] * A->in[25][layer * 64 + F.lane]);
    const float lam = expf(s1) - expf(s2) + lam_init;
    const int gw = F.vcu * NWAVES + F.wave, NGW = F.G * NWAVES;
    for (int m = gw; m < NTOK; m += NGW) {
#pragma unroll
        for (int j = 0; j < 4; ++j) { const int hd = j * 2 + (F.lane >> 5), e0 = (F.lane & 31) * 4; const size_t o = (size_t)m * 1024 + hd * 128 + e0;
            const f32x4 o0 = ld_bf4(ob + o), o1 = ld_bf4(ob + (size_t)NTOK * 1024 + o); const f32x4 d = o0 - o1 * lam;
            const float ss = red32((d[0] * d[0] + d[1] * d[1]) + (d[2] * d[2] + d[3] * d[3])); const float rs = rsqrtf(ss * (1.0f / 128.0f) + 1e-6f) * (1.0f - lam_init);
            const f32x4 gv = *(const f32x4*)(sg + e0);
            *(GAS v2u*)(cc + (size_t)m * 2048 + 1024 + hd * 128 + e0) = (v2u){pk2(d[0] * rs * gv[0], d[1] * rs * gv[1]), pk2(d[2] * rs * gv[2], d[3] * rs * gv[3])}; }
    }
}

__device__ __forceinline__ void attn_phase_all(Frame& F, char* ldsc) {
    unsigned char* ws = F.ws; const attn_body::bf16* proj = (const attn_body::bf16*)(ws + WS_PROJ); attn_body::bf16* ob = (attn_body::bf16*)(ws + WS_OB);
    const int per = (F.G == 256) ? 4 : 0;
    for (int i = 0;; ++i) { int inst, qb;
        if (per) { if (i >= 4) break; const int s = F.vcu & 3; inst = F.vcu >> 2; qb = (i == 0) ? 15 - s : (i == 1) ? 8 + s : (i == 2) ? 7 - s : s; }
        else { const int L = i * F.G + F.vcu; if (L >= 1024) break; inst = L >> 4; qb = 15 - (L & 15); }
        const int b = inst >> 5, h = (inst >> 2) & 7, c = (inst >> 1) & 1, e = inst & 1;
        attn_body::attn_unit<8>(b, qb, proj + PC_Q + h * 128 + c * 64, proj + PC_KA + h * 128 + c * 64, proj + PC_VA + h * 128 + e * 64, ob + (size_t)c * NTOK * 1024 + h * 128 + e * 64, ldsc);
    }
}

typedef float f32x16 __attribute__((ext_vector_type(16)));
__device__ __forceinline__ void router_phase(Frame& F, ArgP A, int layer, const bf16* hcur) {
    unsigned char* ws = F.ws;
    const float* rw = (const float*)(ws + WS_RW) + (size_t)layer * 36 * D; const float* brg = A->in[29] + layer * 4; const float* bre = A->in[31] + layer * 32;
    int* toks = (int*)(ws + WS_TOKS); int* ecnt = (int*)(ws + WS_ECNT) + layer * 32; int* etok = (int*)(ws + WS_MOETAB); float* ers = (float*)(ws + WS_MOETAB + 1 * MiB); float* ewt = (float*)(ws + WS_MOETAB + 2 * MiB);
    LAS int* lbase = (LAS int*)(F.lds + RING_OFF + 100 * 1024);
    constexpr int ST = 260;
    LAS float* HS = (LAS float*)(F.lds + RING_OFF);
    LAS float* WT = (LAS float*)(F.lds + RING_OFF + 33280);
    LAS float* RED = (LAS float*)(F.lds + RING_OFF);
    LAS float* GRED = (LAS float*)(F.lds + RING_OFF + 73728);
    LAS float* lg = (LAS float*)(F.lds + RING_OFF + 90 * 1024);
    const int tok = F.tid & 31, ks = F.tid >> 5, r32 = F.lane & 31, hi = F.lane >> 5;
    for (int tile = F.vcu; tile < NTOK / 32; tile += F.G) { const int m0 = tile * 32;
        f32x16 acc = (f32x16){0.f, 0.f, 0.f, 0.f, 0.f, 0.f, 0.f, 0.f, 0.f, 0.f, 0.f, 0.f, 0.f, 0.f, 0.f, 0.f}; float g0 = 0.f, g1 = 0.f, g2 = 0.f, g3 = 0.f, ssq = 0.f;
        v2u ph[4]; f32x4 pw[5];
#define RT_LOAD(kc_) do { const int k0_ = (kc_) * 256; \
            _Pragma("unroll") for (int q = 0; q < 4; ++q) { const int idx = F.tid + 512 * q, row = idx >> 6, c4 = idx & 63; ph[q] = *(const GAS v2u*)(hcur + (size_t)(m0 + row) * D + k0_ + c4 * 4); } \
            _Pragma("unroll") for (int q = 0; q < 5; ++q) { const int idx = F.tid + 512 * q; if (idx < 36 * 64) { const int row = idx >> 6, c4 = idx & 63; pw[q] = *(const f32x4*)(rw + (size_t)row * D + k0_ + c4 * 4); } } } while (0)
        RT_LOAD(0);
#pragma unroll 1
        for (int kc = 0; kc < 8; ++kc) {
            __syncthreads();
#pragma unroll
            for (int q = 0; q < 4; ++q) { const int idx = F.tid + 512 * q, row = idx >> 6, c4 = idx & 63; *(LAS f32x4*)(HS + row * ST + c4 * 4) = (f32x4){bflo(ph[q].x), bfhi(ph[q].x), bflo(ph[q].y), bfhi(ph[q].y)}; }
#pragma unroll
            for (int q = 0; q < 5; ++q) { const int idx = F.tid + 512 * q; if (idx < 36 * 64) { const int row = idx >> 6, c4 = idx & 63; *(LAS f32x4*)(WT + row * ST + c4 * 4) = pw[q]; } }
            __syncthreads();
            if (kc + 1 < 8) RT_LOAD(kc + 1);
#pragma unroll
            for (int q = 0; q < 4; ++q) { const int kb = 32 * F.wave + 8 * q + 4 * hi; const f32x4 a4 = *(const LAS f32x4*)(HS + r32 * ST + kb), b4 = *(const LAS f32x4*)(WT + r32 * ST + kb);
#pragma unroll
                for (int e = 0; e < 4; ++e) acc = __builtin_amdgcn_mfma_f32_32x32x2f32(a4[e], b4[e], acc, 0, 0, 0); }
#pragma unroll
            for (int q = 0; q < 4; ++q) { const int kb = 16 * ks + 4 * q; const f32x4 x4 = *(const LAS f32x4*)(HS + tok * ST + kb);
                const f32x4 w0 = *(const LAS f32x4*)(WT + 32 * ST + kb), w1 = *(const LAS f32x4*)(WT + 33 * ST + kb), w2 = *(const LAS f32x4*)(WT + 34 * ST + kb), w3 = *(const LAS f32x4*)(WT + 35 * ST + kb);
#pragma unroll
                for (int e = 0; e < 4; ++e) { g0 = fmaf(x4[e], w0[e], g0); g1 = fmaf(x4[e], w1[e], g1); g2 = fmaf(x4[e], w2[e], g2); g3 = fmaf(x4[e], w3[e], g3); ssq = fmaf(x4[e], x4[e], ssq); } }
        }
#undef RT_LOAD
        __syncthreads();
#pragma unroll
        for (int r = 0; r < 16; ++r) RED[(F.wave * 32 + (r & 3) + 8 * (r >> 2) + 4 * hi) * 33 + r32] = acc[r];
        { LAS float* gp = GRED + (ks * 32 + tok) * 5; gp[0] = g0; gp[1] = g1; gp[2] = g2; gp[3] = g3; gp[4] = ssq; }
        __syncthreads();
        for (int idx = F.tid; idx < 1024; idx += 512) { const int i = idx >> 5, j = idx & 31; float sum = 0.f;
#pragma unroll
            for (int w = 0; w < 8; ++w) sum += RED[(w * 32 + i) * 33 + j];
            lg[i * 40 + 4 + j] = sum; }
        if (F.tid < 160) { const int tk = F.tid / 5, c = F.tid % 5; float sum = 0.f;
#pragma unroll
            for (int q = 0; q < 16; ++q) sum += GRED[(q * 32 + tk) * 5 + c];
            lg[tk * 40 + (c < 4 ? c : 36)] = sum; }
        __syncthreads();
        if (F.wave == 0) { const bool act = F.lane < 32; const int tk = F.lane & 31; const int m = m0 + tk;
            const float rs = rsqrtf(lg[tk * 40 + 36] * (1.0f / 2048.0f) + 1e-6f);
            float l0 = lg[tk * 40 + 0] * rs + brg[0], l1 = lg[tk * 40 + 1] * rs + brg[1], l2 = lg[tk * 40 + 2] * rs + brg[2], l3 = lg[tk * 40 + 3] * rs + brg[3];
            int grp = 0; float lm = l0; if (l1 > lm) { lm = l1; grp = 1; } if (l2 > lm) { lm = l2; grp = 2; } if (l3 > lm) { lm = l3; grp = 3; }
            const float gp = 1.0f / (__expf(l0 - lm) + __expf(l1 - lm) + __expf(l2 - lm) + __expf(l3 - lm));
            int i1 = 0, i2 = 0; float b1 = -3.0e38f, b2 = -3.0e38f;
#pragma unroll
            for (int q = 0; q < 8; ++q) { const float v = lg[tk * 40 + 4 + grp * 8 + q] * rs + bre[grp * 8 + q];
                if (v > b1) { b2 = b1; i2 = i1; b1 = v; i1 = q; } else if (v > b2) { b2 = v; i2 = q; } }
            const float ex = __expf(b2 - b1); const float p1 = 1.0f / (1.0f + ex), p2 = ex / (1.0f + ex);
            const int e1 = grp * 8 + i1, e2 = grp * 8 + i2; int r1 = 0, r2 = 0, mycnt = 0;
            const unsigned long long lt = (1ull << tk) - 1ull;
#pragma unroll 1
            for (int e = 0; e < 32; ++e) { const unsigned long long bm = __ballot(act && (e1 == e || e2 == e)) & 0xffffffffull;
                if (e1 == e) r1 = __popcll(bm & lt); if (e2 == e) r2 = __popcll(bm & lt); if (tk == e) mycnt = __popcll(bm); }
            int mybase = 0; if (act && mycnt > 0) mybase = atomicAdd(ecnt + tk, mycnt);
            if (act) lbase[tk] = mybase; asm volatile("s_waitcnt lgkmcnt(0)" ::: "memory");
            if (act) { const int x1 = e1 * ECAP + lbase[e1] + r1, x2 = e2 * ECAP + lbase[e2] + r2;
                toks[m * 2] = x1; toks[m * 2 + 1] = x2; etok[x1] = m; etok[x2] = m; ers[x1] = rs; ers[x2] = rs; ewt[x1] = gp * p1; ewt[x2] = gp * p2; }
        }
    }
}

__device__ __forceinline__ void moe_meta(Frame& F, int layer) {
    LAS int* meta = (LAS int*)(F.lds + META_OFF); LAS int* tot = meta, *tbase = meta + 32, *tile_e = meta + 97, *ntl = meta + 193;
    const int* ecnt = (const int*)(F.ws + WS_ECNT) + layer * 32;
    __syncthreads();
    if (F.tid < 32) tot[F.tid] = ecnt[F.tid];
    __syncthreads();
    if (F.tid == 0) { int nt = 0; for (int e = 0; e < 32; ++e) { tbase[e] = nt; const int np = (tot[e] + 255) >> 8; for (int q = 0; q < np; ++q) tile_e[nt++] = e; } tbase[32] = nt; *ntl = nt; }
    __syncthreads();
}
__device__ __forceinline__ void combine_phase(Frame& F, const bf16* hsrc, bf16* hbdst, int layer) {
    moe_meta(F, layer);
    unsigned char* ws = F.ws; const int* toks = (const int*)(ws + WS_TOKS); const bf16* os = (const bf16*)(ws + WS_OSLOT); LAS int* tbase = (LAS int*)(F.lds + META_OFF) + 32;
    const int gw = F.vcu * NWAVES + F.wave, NGW = F.G * NWAVES;
    for (int m = gw; m < NTOK; m += NGW) { const int x0 = toks[m * 2], x1 = toks[m * 2 + 1]; const int s0 = tbase[x0 / ECAP] * 256 + (x0 % ECAP), s1 = tbase[x1 / ECAP] * 256 + (x1 % ECAP);
#pragma unroll
        for (int p = 0; p < 4; ++p) { const int c0 = (F.lane + 64 * p) * 8; const v4u a = *(const GAS v4u*)(os + (size_t)s0 * D + c0), b = *(const GAS v4u*)(os + (size_t)s1 * D + c0), g = *(const GAS v4u*)(hsrc + (size_t)m * D + c0);
            *(GAS v4u*)(hbdst + (size_t)m * D + c0) = (v4u){pk2(bflo(g.x) + (bflo(a.x) + bflo(b.x)), bfhi(g.x) + (bfhi(a.x) + bfhi(b.x))), pk2(bflo(g.y) + (bflo(a.y) + bflo(b.y)), bfhi(g.y) + (bfhi(a.y) + bfhi(b.y))),
                                                             pk2(bflo(g.z) + (bflo(a.z) + bflo(b.z)), bfhi(g.z) + (bfhi(a.z) + bfhi(b.z))), pk2(bflo(g.w) + (bflo(a.w) + bflo(b.w)), bfhi(g.w) + (bfhi(a.w) + bfhi(b.w)))}; } }
}

#ifndef PHMASK
#define PHMASK 0x3FFF
#endif
#define PHBIT(k) ((k) == 0 ? 0 : (((k) - 1) % NPH_LAYER) + 1)
#define IN(k) (lo <= (k) && (k) < hi && ((PHMASK >> PHBIT(k)) & 1))
#define SEAM(k) do { if (IN(k) && IN((k) + 1)) { ArgP A_ = get_args(); XcdBarrier b_; b_.bar = (unsigned*)(A_->ws + WS_CTL) + CW_BAR; b_.x = xb_xcc_id(); b_.st = (volatile LAS unsigned*)((LAS unsigned char*)lds_dyn + MISC_OFF) + 8; xcd_barrier(b_); } } while (0)
#define PHASE_BEGIN ArgP A = get_args(); unsigned char* ws = A->ws; Frame F = mk_frame(ws);
#ifndef PROBE_SET
#define PROBE_SET 0
#endif
#ifndef PROBE_MULT
#define PROBE_MULT 4
#endif
#define PRB_ON(bit) ((PROBE_SET >> (bit)) & 1)
#define PRB_T0(bit) unsigned long long prb_t0_ = 0; if (PRB_ON(bit)) prb_t0_ = __builtin_amdgcn_s_memrealtime();
#define PRB_T1(bit) if (PRB_ON(bit)) prb_acc += __builtin_amdgcn_s_memrealtime() - prb_t0_;

template <int layer> __device__ __forceinline__ void run_layer(const int lo, const int hi, unsigned long long& prb_acc) {
        const int pb = 1 + layer * NPH_LAYER;
        { PRB_T0(1)
        if (IN(pb + 0)) { PHASE_BEGIN bf16* hb_in = (bf16*)(ws + (layer ? WS_HBB : WS_HBA));
            pg8::Gemm g{hb_in, (const bf16*)(ws + WS_WIN) + (size_t)layer * PPITCH * D, NTOK, PPITCH, D, D}; pg8::WinMainOrder S; S.init(NTOK, PPITCH - 512, F.G, (int)blockIdx.x);
            LAS float* rstab = (LAS float*)(F.lds + RSTAB_OFF);
            { const float* part = (const float*)(ws + WS_PART); pg8::Unit uu;
              for (int i = 0; i < 4 && S.next(i, uu); ++i) { if (F.tid < 256) { const f32x4* pp = (const f32x4*)(part + (size_t)(uu.pm * 256 + F.tid) * 32); f32x4 sm = pp[0];
#pragma unroll
                      for (int j = 1; j < 8; ++j) sm = sm + pp[j];
                      rstab[i * 256 + F.tid] = rsqrtf(((sm[0] + sm[1]) + (sm[2] + sm[3])) * (1.0f / 2048.0f) + 1e-6f); } }
              __syncthreads(); }
            pg8::EpiProj E{(bf16*)(ws + WS_PROJ), PPITCH, (const PG8_LAS float*)rstab, (float*)(ws + WS_RSTD1)};
            pg8::gemm_phase<pg8::EpiProj, pg8::WinMainOrder, PG8_ALIGN, PG8_SP2>(F.lds + RING_OFF, g, S, E); }
        if (IN(pb + 0)) { PHASE_BEGIN bf16* hb_in = (bf16*)(ws + (layer ? WS_HBB : WS_HBA));
            pg8::Gemm g{hb_in, (const bf16*)(ws + WS_WIN) + (size_t)layer * PPITCH * D, NTOK, 512, 512, D}; pg8::WinLoraOrder S; S.G = F.G; S.c = F.vcu;
            pg8::EpiPartF32 E{(float*)(ws + WS_LORAO), NTOK};
            pg8::gemm_phase<pg8::EpiPartF32, pg8::WinLoraOrder, PG8_ALIGN, PG8_SP2>(F.lds + RING_OFF, g, S, E); }
        SEAM(pb + 0); PRB_T1(1) }
        { PRB_T0(2)
        if (IN(pb + 1)) { PHASE_BEGIN prep1_phase(F, A, layer); }
        SEAM(pb + 1); PRB_T1(2) }
        { PRB_T0(3)
        if (IN(pb + 2)) { PHASE_BEGIN pg8::Gemm g{(const bf16*)(ws + WS_LORAA), (const bf16*)(ws + WS_WL2) + (size_t)layer * 4096 * LK, NTOK, 4096, 256, LK}; pg8::Lora2Order S; S.init(NTOK, 4096, F.G, (int)blockIdx.x);
            pg8::EpiBf16s E{(bf16*)(ws + WS_LORAO), 4096};
            pg8::gemm_phase<pg8::EpiBf16s, pg8::Lora2Order, PG8_ALIGN, PG8_SP2>(F.lds + RING_OFF, g, S, E); }
        SEAM(pb + 2); PRB_T1(3) }
        { PRB_T0(4)
#ifndef NOSCAN
        if (IN(pb + 3)) { PRB_T0(16) { PHASE_BEGIN tp_level1_fused(F, A, layer); __syncthreads(); } PRB_T1(16) }
#endif
#ifndef NOATTN
        if (IN(pb + 3)) { PRB_T0(17) { PHASE_BEGIN attn_phase_all(F, (char*)lds_dyn + RING_OFF); } PRB_T1(17) }
#endif
        SEAM(pb + 3); PRB_T1(4) }
        { PRB_T0(5)
        if (IN(pb + 4)) { PHASE_BEGIN tp_level2(F, layer); }
        SEAM(pb + 4); PRB_T1(5) }
        { PRB_T0(6)
        if (IN(pb + 5)) { PRB_T0(18) { PHASE_BEGIN tp_level3_post(F, A, layer); __syncthreads(); } PRB_T1(18) } if (IN(pb + 5)) { PRB_T0(19) { PHASE_BEGIN post_attn(F, A, layer); } PRB_T1(19) }
        SEAM(pb + 5); PRB_T1(6) }
        { PRB_T0(7)
        if (IN(pb + 6)) { PHASE_BEGIN bf16* hb_mid = (bf16*)(ws + (layer ? WS_HBA : WS_HBB));
            pg8::Gemm g{(const bf16*)(ws + WS_CONCAT), (const bf16*)(ws + WS_WOUT) + (size_t)layer * D * D, NTOK, D, D, D}; pg8::StaticOrder S; S.init(NTOK, D, F.G, (int)blockIdx.x);
            pg8::EpiResid E{layer ? (const float*)nullptr : A->in[0], (const bf16*)(ws + (layer ? WS_HBB : WS_HBA)), hb_mid};
            pg8::gemm_phase<pg8::EpiResid, pg8::StaticOrder, PG8_ALIGN, PG8_SP2>(F.lds + RING_OFF, g, S, E); }
        SEAM(pb + 6); PRB_T1(7) }
        { PRB_T0(8)
        if (IN(pb + 7)) { PHASE_BEGIN router_phase(F, A, layer, (const bf16*)(ws + (layer ? WS_HBA : WS_HBB))); __syncthreads(); }
        if (IN(pb + 7)) { PHASE_BEGIN
            pg8::Gemm g{(const bf16*)(ws + WS_PB) + (size_t)layer * NTOK * 256, (const bf16*)(ws + WS_WPP) + (size_t)layer * D * 256, NTOK, D, 256, 256}; pg8::StaticOrder S; S.init(NTOK, D, F.G, (int)blockIdx.x);
            pg8::EpiBf16s E{(bf16*)(ws + WS_PPB), D};
            pg8::gemm_phase<pg8::EpiBf16s, pg8::StaticOrder, PG8_ALIGN, PG8_SP2>(F.lds + RING_OFF, g, S, E); }
        SEAM(pb + 7); PRB_T1(8) }
        { PRB_T0(9)
        if (IN(pb + 8)) { PHASE_BEGIN moe_meta(F, layer); LAS int* meta = (LAS int*)(F.lds + META_OFF); const int nt = __builtin_amdgcn_readfirstlane(meta[193]);
            pg8::Gemm g{(const bf16*)(ws + (layer ? WS_HBA : WS_HBB)), (const bf16*)(ws + WS_WGU), nt * 256, 1024, D, D}; pg8::MoeGatherOrder S; S.init(nt, 2, F.G, F.vcu); S.tile_e = (const PG8_LAS int*)(meta + 97); S.NE = 1024; S.etok = (const int*)(ws + WS_MOETAB); S.tot = (const PG8_LAS int*)meta; S.tbase = (const PG8_LAS int*)(meta + 32);
            pg8::EpiGLU E{(bf16*)(ws + WS_HG), (const float*)(ws + WS_MOETAB + 1 * MiB), (const float*)(ws + WS_MOETAB + 2 * MiB), (const PG8_LAS int*)(meta + 97), (const PG8_LAS int*)(meta + 32)};
            pg8::gemm_phase<pg8::EpiGLU, pg8::MoeGatherOrder, PG8_ALIGN, PG8_SP2>(F.lds + RING_OFF, g, S, E); }
        SEAM(pb + 8); PRB_T1(9) }
        { PRB_T0(10)
        if (IN(pb + 9)) { PHASE_BEGIN moe_meta(F, layer); LAS int* meta = (LAS int*)(F.lds + META_OFF); const int nt = __builtin_amdgcn_readfirstlane(meta[193]);
            pg8::Gemm g{(const bf16*)(ws + WS_HG), (const bf16*)(ws + WS_WD), nt * 256, D, DEXP, DEXP}; pg8::MoeOrder S; S.init(nt, 3, F.G, F.vcu); S.tile_e = (const PG8_LAS int*)(meta + 97); S.NE = D; S.etok = nullptr; S.tot = (const PG8_LAS int*)meta; S.tbase = (const PG8_LAS int*)(meta + 32);
            pg8::EpiBf16s E{(bf16*)(ws + WS_OSLOT), D};
            pg8::gemm_phase<pg8::EpiBf16s, pg8::MoeOrder, PG8_ALIGN, PG8_SP2>(F.lds + RING_OFF, g, S, E); }
        SEAM(pb + 9); PRB_T1(10) }
        { PRB_T0(11)
        if (IN(pb + 10)) { PHASE_BEGIN combine_phase(F, (const bf16*)(ws + (layer ? WS_HBA : WS_HBB)), (bf16*)(ws + (layer ? WS_HBB : WS_HBA)), layer); }
        SEAM(pb + 10); PRB_T1(11) }
        { PRB_T0(12)
        if (IN(pb + 11)) { PHASE_BEGIN bf16* hb_in = (bf16*)(ws + (layer ? WS_HBB : WS_HBA)); bf16* hb_mid = (bf16*)(ws + (layer ? WS_HBA : WS_HBB));
            pg8::Gemm g{hb_in, (const bf16*)(ws + WS_WPG) + (size_t)layer * D * D, NTOK, D, D, D}; pg8::StaticOrder S; S.init(NTOK, D, F.G, (int)blockIdx.x);
            pg8::EpiPLE E{hb_in, hb_mid, layer ? A->out : (float*)nullptr, (const bf16*)(ws + WS_PPB), A->in[36] + layer * D, layer ? (float*)nullptr : (float*)(ws + WS_PART)};
            pg8::gemm_phase<pg8::EpiPLE, pg8::StaticOrder, PG8_ALIGN, PG8_SP2>(F.lds + RING_OFF, g, S, E); }
        SEAM(pb + 11); PRB_T1(12) }
    }

__global__ void __launch_bounds__(NWAVES * 64, 2) mk_fwd(Args args_unused) {
    { LAS unsigned char* l = (LAS unsigned char*)lds_dyn; const int t0 = threadIdx.x;
      for (int u = t0; u < (LDS_BYTES - LDSCTL_OFF) / 4; u += NWAVES * 64) ((LAS unsigned*)(l + LDSCTL_OFF))[u] = 0u; }
    __syncthreads();
    int lo, hi; { ArgP A = get_args(); lo = A->ph_lo; hi = A->ph_hi; }
    if (hi - lo > 1) { ArgP A = get_args(); (void)xcd_barrier_post((unsigned*)(A->ws + WS_CTL) + CW_BAR, (volatile LAS unsigned*)((LAS unsigned char*)lds_dyn + MISC_OFF) + 8); }
    unsigned long long prb_acc = 0ull;
    { PRB_T0(0) if (IN(0)) { PHASE_BEGIN p0_prologue(F, A); }
    SEAM(0); PRB_T1(0) }
    run_layer<0>(lo, hi, prb_acc);
    run_layer<1>(lo, hi, prb_acc);
    if (PROBE_SET) { const unsigned long long te = __builtin_amdgcn_s_memrealtime(); while (__builtin_amdgcn_s_memrealtime() - te < (unsigned long long)PROBE_MULT * prb_acc) __builtin_amdgcn_s_sleep(8); }
#undef IN
#undef SEAM
}

#ifndef MK_PER_PHASE
#define MK_PER_PHASE 0
#endif
extern "C" void kernel_launch(void* const* d_in, const int* in_sizes, int n_in, void* d_out, int out_size, void* d_ws, size_t ws_size, hipStream_t stream) {
    static int grid = 0;
    if (grid == 0) {
        if (n_in != 38 || out_size != NTOK * D || ws_size < WS_END) { fprintf(stderr, "kernel_launch: unexpected shapes (n_in %d out %d ws %zu need %zu)\n", n_in, out_size, ws_size, (size_t)WS_END); grid = -1; return; }
        int dev = 0, cus = 0, per_cu = 0;
        if (hipGetDevice(&dev) != hipSuccess || hipDeviceGetAttribute(&cus, hipDeviceAttributeMultiprocessorCount, dev) != hipSuccess) { grid = -1; return; }
        if (hipFuncSetAttribute((const void*)mk_fwd, hipFuncAttributeMaxDynamicSharedMemorySize, LDS_BYTES) != hipSuccess) { grid = -1; return; }
        if (hipOccupancyMaxActiveBlocksPerMultiprocessor(&per_cu, (const void*)mk_fwd, NWAVES * 64, LDS_BYTES) != hipSuccess || per_cu < 1) fprintf(stderr, "kernel_launch: occupancy query says %d\n", per_cu);
        (void)hipGetLastError();
        grid = cus;
    }
    if (grid < 0) return;
    if (hipMemsetAsync((char*)d_ws + WS_CTL, 0, CTL_ZERO_BYTES, stream) != hipSuccess) return;
    Args a{};
    for (int i = 0; i < 38; ++i) a.in[i] = (const float*)d_in[i];
    a.out = (float*)d_out; a.ws = (unsigned char*)d_ws;
#if MK_PER_PHASE
    for (int ph = 0; ph < NPHASES; ++ph) { a.ph_lo = ph; a.ph_hi = ph + 1; hipLaunchKernelGGL(mk_fwd, dim3(grid), dim3(NWAVES * 64), LDS_BYTES, stream, a); }
#else
    a.ph_lo = 0; a.ph_hi = NPHASES;
    hipLaunchKernelGGL(mk_fwd, dim3(grid), dim3(NWAVES * 64), LDS_BYTES, stream, a);
#endif
}
```

```cpp
#include <hip/hip_runtime.h>
#include <hip/hip_bf16.h>
#include <cstdio>
#include <cstdint>
namespace pg8 {
#define PG8_LAS __attribute__((address_space(3)))
typedef unsigned short bf16_t;
typedef short bf16x8 __attribute__((ext_vector_type(8)));
typedef float f32x4 __attribute__((ext_vector_type(4)));
typedef unsigned u32x4 __attribute__((ext_vector_type(4)));
constexpr int BM = 256, BK = 64, HALF = 128, HTB = HALF * BK * 2  , STAGE_BYTES = 8 * HTB, NXCD = 8, WGM = 8;

__host__ __device__ __forceinline__ int lds_byte(int r, int c) { const int st = (r >> 4) * 2 + (c >> 5), rr = r & 15, cc = c & 31, ob = rr * 64 + cc * 2; return st * 1024 + (ob ^ (((ob >> 9) & 1) << 5)); }
__host__ __device__ __forceinline__ void stage_rc(int b, int& R, int& C) { const int st = b / 1024, sb = b % 1024, swz = sb ^ (((sb >> 9) & 1) << 5); R = (st >> 1) * 16 + swz / 64; C = (st & 1) * 32 + (swz % 64) / 2; }
__host__ __device__ __forceinline__ int perm32(int rho) { const int n = rho >> 4, i = rho & 15; return 8 * (i >> 2) + 4 * n + (i & 3); }

struct Unit { int pm, pn, ord; };
struct Gemm { const bf16_t* A; const bf16_t* Bt; int M, N, K, ld; };

struct StaticOrder {
    static constexpr bool GATHER = false; static constexpr int A_AUX = 0;
    int nM, nN, nwg, G, c;
    __host__ __device__ void init(int M, int N, int G_, int c_) { nM = M / BM; nN = N / BM; nwg = nM * nN; G = G_; c = c_; }
    __host__ __device__ bool next(int i, Unit& u) const {
        const long L = (long)i * G + c; if (L >= nwg) return false;
        int wgid = (int)L; { const int q = nwg / NXCD, r = nwg % NXCD, xcd = wgid % NXCD, off = wgid / NXCD; wgid = (xcd < r ? xcd * (q + 1) : r * (q + 1) + (xcd - r) * q) + off; }
        const int nig = WGM * nN, gid = wgid / nig, fm = gid * WGM, gsz = (nM - fm) < WGM ? (nM - fm) : WGM;
        u.pm = fm + ((wgid % nig) % gsz); u.pn = (wgid % nig) / gsz; u.ord = i; return true;
    }
    __device__ __forceinline__ void a_ready(const Unit&) const {}
    __device__ __forceinline__ void done(const Unit&) const {}
    __device__ __forceinline__ const char* aptr(const Gemm& g, const Unit& u, size_t tstep) const { return (const char*)g.A + (size_t)u.pm * tstep; }
    __device__ __forceinline__ const char* bptr(const Gemm& g, const Unit& u, size_t tstep) const { return (const char*)g.Bt + (size_t)u.pn * tstep; }
};
__device__ __forceinline__ unsigned cvt_pk_bf16(float lo, float hi) { unsigned r; asm volatile("v_cvt_pk_bf16_f32 %0, %1, %2" : "=v"(r) : "v"(lo), "v"(hi)); return r; }
typedef float f32x2 __attribute__((ext_vector_type(2)));


__device__ __forceinline__ u32x4 pack8(const f32x4& v0, const f32x4& v1) { u32x4 w; w.x = cvt_pk_bf16(v0[0], v0[1]); w.y = cvt_pk_bf16(v0[2], v0[3]); w.z = cvt_pk_bf16(v1[0], v1[1]); w.w = cvt_pk_bf16(v1[2], v1[3]); return w; }
__device__ __forceinline__ float bf_lo(unsigned u) { return __builtin_bit_cast(float, u << 16); }
__device__ __forceinline__ float bf_hi(unsigned u) { return __builtin_bit_cast(float, u & 0xffff0000u); }

struct EpiBf16s {
    static constexpr bool PERM = true, AFTER_DRAIN = false;
    bf16_t* O; int ldc;
    __device__ __forceinline__ void operator()(const f32x4 (&acc)[2][2][4][2], const Unit& u, int wr, int wc, int fr, int fq) const {
        const int row0 = u.pm * BM + wr * 64 + fr, col0 = u.pn * BM + wc * 32 + 8 * fq;
#pragma unroll
        for (int ai = 0; ai < 2; ++ai)
#pragma unroll
            for (int m = 0; m < 4; ++m) { bf16_t* rowp = O + (size_t)(row0 + ai * HALF + m * 16) * ldc + col0;
#pragma unroll
                for (int bj = 0; bj < 2; ++bj) *(u32x4*)(rowp + bj * HALF) = pack8(acc[ai][bj][m][0], acc[ai][bj][m][1]); }
    }
};
struct EpiProj {
    static constexpr bool PERM = true, AFTER_DRAIN = false;
    bf16_t* O; int ldc; const PG8_LAS float* rstab; float* rstd_out;
    __device__ __forceinline__ void operator()(const f32x4 (&acc)[2][2][4][2], const Unit& u, int wr, int wc, int fr, int fq) const {
        const int row0 = u.pm * BM + wr * 64 + fr, col0 = u.pn * BM + wc * 32 + 8 * fq; const PG8_LAS float* tb = rstab + u.ord * BM + wr * 64 + fr;
#pragma unroll
        for (int ai = 0; ai < 2; ++ai)
#pragma unroll
            for (int m = 0; m < 4; ++m) { const int row = row0 + ai * HALF + m * 16;
                const float rs = tb[ai * HALF + m * 16];
                if (u.pn == 0 && wc == 0 && fq == 0) rstd_out[row] = rs;
                bf16_t* rowp = O + (size_t)row * ldc + col0;
#pragma unroll
                for (int bj = 0; bj < 2; ++bj) *(u32x4*)(rowp + bj * HALF) = pack8(acc[ai][bj][m][0] * rs, acc[ai][bj][m][1] * rs); }
    }
};
struct EpiResid {
    static constexpr bool PERM = true, AFTER_DRAIN = false;
    const float* hin32; const bf16_t* hinb; bf16_t* hb;
    __device__ __forceinline__ void operator()(const f32x4 (&acc)[2][2][4][2], const Unit& u, int wr, int wc, int fr, int fq) const {
        const int row0 = u.pm * BM + wr * 64 + fr, col0 = u.pn * BM + wc * 32 + 8 * fq;
#pragma unroll
        for (int ai = 0; ai < 2; ++ai) { f32x4 a[4][2][2];
            if (hin32) {
#pragma unroll
                for (int m = 0; m < 4; ++m) { const size_t ro = (size_t)(row0 + ai * HALF + m * 16) * 2048 + col0;
#pragma unroll
                    for (int bj = 0; bj < 2; ++bj) { a[m][bj][0] = *(const f32x4*)(hin32 + ro + bj * HALF); a[m][bj][1] = *(const f32x4*)(hin32 + ro + bj * HALF + 4); } }
            } else { u32x4 q[4][2];
#pragma unroll
                for (int m = 0; m < 4; ++m) { const size_t ro = (size_t)(row0 + ai * HALF + m * 16) * 2048 + col0;
#pragma unroll
                    for (int bj = 0; bj < 2; ++bj) q[m][bj] = *(const u32x4*)(hinb + ro + bj * HALF); }
#pragma unroll
                for (int m = 0; m < 4; ++m)
#pragma unroll
                    for (int bj = 0; bj < 2; ++bj) { const u32x4 w = q[m][bj]; a[m][bj][0] = (f32x4){bf_lo(w.x), bf_hi(w.x), bf_lo(w.y), bf_hi(w.y)}; a[m][bj][1] = (f32x4){bf_lo(w.z), bf_hi(w.z), bf_lo(w.w), bf_hi(w.w)}; } }
#pragma unroll
            for (int m = 0; m < 4; ++m) { const size_t ro = (size_t)(row0 + ai * HALF + m * 16) * 2048 + col0;
#pragma unroll
                for (int bj = 0; bj < 2; ++bj) *(u32x4*)(hb + ro + bj * HALF) = pack8(a[m][bj][0] + acc[ai][bj][m][0], a[m][bj][1] + acc[ai][bj][m][1]); } }
    }
};
struct EpiPLE {
    static constexpr bool PERM = true, AFTER_DRAIN = false;
    const bf16_t* hin; bf16_t* hb; float* out32; const bf16_t* pp; const float* bg; float* part;
    __device__ __forceinline__ void operator()(const f32x4 (&acc)[2][2][4][2], const Unit& u, int wr, int wc, int fr, int fq) const {
        const int row0 = u.pm * BM + wr * 64 + fr, col0 = u.pn * BM + wc * 32 + 8 * fq;
        f32x4 bv[2][2];
#pragma unroll
        for (int bj = 0; bj < 2; ++bj) { bv[bj][0] = *(const f32x4*)(bg + col0 + bj * HALF); bv[bj][1] = *(const f32x4*)(bg + col0 + bj * HALF + 4); }
#pragma unroll
        for (int ai = 0; ai < 2; ++ai)
#pragma unroll
            for (int mh = 0; mh < 2; ++mh) { u32x4 hw[2][2], pw[2][2];
#pragma unroll
                for (int mm = 0; mm < 2; ++mm) { const size_t ro = (size_t)(row0 + ai * HALF + (2 * mh + mm) * 16) * 2048 + col0;
#pragma unroll
                    for (int bj = 0; bj < 2; ++bj) { hw[mm][bj] = *(const u32x4*)(hin + ro + bj * HALF); pw[mm][bj] = *(const u32x4*)(pp + ro + bj * HALF); } }
#pragma unroll
                for (int mm = 0; mm < 2; ++mm) { const int m = 2 * mh + mm, row = row0 + ai * HALF + m * 16; const size_t ro = (size_t)row * 2048 + col0; float ss = 0.f;
#pragma unroll
                    for (int bj = 0; bj < 2; ++bj) { const u32x4 q = pw[mm][bj], g = hw[mm][bj];
                        const f32x4 p0 = (f32x4){bf_lo(q.x), bf_hi(q.x), bf_lo(q.y), bf_hi(q.y)}, p1 = (f32x4){bf_lo(q.z), bf_hi(q.z), bf_lo(q.w), bf_hi(q.w)};
                        const f32x4 a0 = (f32x4){bf_lo(g.x), bf_hi(g.x), bf_lo(g.y), bf_hi(g.y)}, a1 = (f32x4){bf_lo(g.z), bf_hi(g.z), bf_lo(g.w), bf_hi(g.w)};
                        const f32x4 z0 = acc[ai][bj][m][0] + bv[bj][0], z1 = acc[ai][bj][m][1] + bv[bj][1]; f32x4 r0, r1;
#pragma unroll
                        for (int j = 0; j < 4; ++j) { r0[j] = a0[j] + p0[j] / (1.0f + __expf(-z0[j])); r1[j] = a1[j] + p1[j] / (1.0f + __expf(-z1[j])); ss += r0[j] * r0[j] + r1[j] * r1[j]; }
                        if (out32) { *(f32x4*)(out32 + ro + bj * HALF) = r0; *(f32x4*)(out32 + ro + bj * HALF + 4) = r1; }
                        else *(u32x4*)(hb + ro + bj * HALF) = pack8(r0, r1); }
                    ss += __shfl_xor(ss, 16); ss += __shfl_xor(ss, 32);
                    if (part != nullptr && fq == 0) part[(size_t)row * 32 + u.pn * 4 + wc] = ss; } }
    }
};
struct EpiGLU {
    static constexpr bool PERM = true, AFTER_DRAIN = false;
    bf16_t* HG; const float* ers; const float* ewt; const PG8_LAS int* tile_e; const PG8_LAS int* tbase;
    __device__ __forceinline__ void operator()(const f32x4 (&acc)[2][2][4][2], const Unit& u, int wr, int wc, int fr, int fq) const {
        const int row0 = u.pm * BM + wr * 64 + fr, col0 = u.pn * HALF + wc * 32 + 8 * fq;
        float rsv[2][4], wtv[2][4]; const int e_ = __builtin_amdgcn_readfirstlane(tile_e[u.pm]); const int xb = e_ * 8192 + (u.pm - __builtin_amdgcn_readfirstlane(tbase[e_])) * BM;
#pragma unroll
        for (int ai = 0; ai < 2; ++ai)
#pragma unroll
            for (int m = 0; m < 4; ++m) { const int x = xb + wr * 64 + fr + ai * HALF + m * 16; rsv[ai][m] = ers[x]; wtv[ai][m] = ewt[x]; }
#pragma unroll
        for (int ai = 0; ai < 2; ++ai)
#pragma unroll
            for (int m = 0; m < 4; ++m) { const int row = row0 + ai * HALF + m * 16; const float rs = rsv[ai][m], wt = wtv[ai][m]; f32x4 o0, o1;
#pragma unroll
                for (int j = 0; j < 4; ++j) { const float g0 = acc[ai][0][m][0][j] * rs, g1 = acc[ai][0][m][1][j] * rs, u0 = acc[ai][1][m][0][j] * rs, u1 = acc[ai][1][m][1][j] * rs;
                    o0[j] = g0 / (1.0f + __expf(-g0)) * u0 * wt; o1[j] = g1 / (1.0f + __expf(-g1)) * u1 * wt; }
                *(u32x4*)(HG + (size_t)row * 512 + col0) = pack8(o0, o1); }
    }
};
struct WinMainOrder : StaticOrder {
    __device__ __forceinline__ bool next(int i, Unit& u) const { if (!StaticOrder::next(i, u)) return false; if (u.pn >= 12) u.pn += 2; return true; }
};
struct Lora2Order : StaticOrder {
    __device__ __forceinline__ const char* aptr(const Gemm& g, const Unit& u, size_t tstep) const { return (const char*)g.A + (size_t)u.pm * tstep + ((u.pn >= 8) ? 256 : 0); }
    __device__ __forceinline__ const char* bptr(const Gemm& g, const Unit& u, size_t tstep) const { return (const char*)g.Bt + (size_t)u.pn * tstep + ((u.pn >= 8) ? 256 : 0); }
};
struct WinLoraOrder {
    static constexpr bool GATHER = false; static constexpr int A_AUX = 0;
    int G, c;
    __device__ __forceinline__ bool next(int i, Unit& u) const { const int L = i * G + c; if (L >= 256) return false; u.pm = L >> 3; u.pn = 12 + ((L >> 2) & 1) + 16 * (L & 3); u.ord = i; return true; }
    __device__ __forceinline__ void a_ready(const Unit&) const {}
    __device__ __forceinline__ void done(const Unit&) const {}
    __device__ __forceinline__ const char* aptr(const Gemm& g, const Unit& u, size_t tstep) const { return (const char*)g.A + (size_t)u.pm * tstep + (size_t)(u.pn >> 4) * 512 * 2; }
    __device__ __forceinline__ const char* bptr(const Gemm& g, const Unit& u, size_t tstep) const { return (const char*)g.Bt + (size_t)(u.pn & 15) * tstep + (size_t)(u.pn >> 4) * 512 * 2; }
};
struct EpiPartF32 {
    static constexpr bool PERM = true, AFTER_DRAIN = false;
    float* LP; int M;
    __device__ __forceinline__ void operator()(const f32x4 (&acc)[2][2][4][2], const Unit& u, int wr, int wc, int fr, int fq) const {
        const int ks = u.pn >> 4, t = (u.pn & 15) - 12; const int row0 = u.pm * BM + wr * 64 + fr, col0 = t * BM + wc * 32 + 8 * fq;
#pragma unroll
        for (int ai = 0; ai < 2; ++ai)
#pragma unroll
            for (int m = 0; m < 4; ++m) { float* rowp = LP + ((size_t)ks * M + row0 + ai * HALF + m * 16) * 512 + col0;
#pragma unroll
                for (int bj = 0; bj < 2; ++bj) { *(f32x4*)(rowp + bj * HALF) = acc[ai][bj][m][0]; *(f32x4*)(rowp + bj * HALF + 4) = acc[ai][bj][m][1]; } }
    }
};
template <bool GATHER_> struct MoeOrderT {
    static constexpr int A_AUX = 0;
    static constexpr bool GATHER = GATHER_;
    int lg, nunits, G, c; const PG8_LAS int* tile_e; int NE; const int* etok; const PG8_LAS int* tot; const PG8_LAS int* tbase;
    __device__ __forceinline__ void init(int ntiles, int lg_, int G_, int c_) { lg = lg_; nunits = ntiles << lg_; G = G_; c = c_; }
    __device__ __forceinline__ bool next(int i, Unit& u) const { const int L = i * G + c; if (L >= nunits) return false; u.pm = L >> lg; u.pn = L & ((1 << lg) - 1); u.ord = i; return true; }
    __device__ __forceinline__ void a_ready(const Unit&) const {}
    __device__ __forceinline__ void done(const Unit&) const {}
    __device__ __forceinline__ const char* aptr(const Gemm& g, const Unit& u, size_t tstep) const { return GATHER_ ? (const char*)g.A : (const char*)g.A + (size_t)u.pm * tstep; }
    __device__ __forceinline__ void rowoffs(const Gemm& g, const Unit& u, const int (&R)[2], const int (&Cc)[2], unsigned (&vo)[2][2]) const {
#pragma unroll
        for (int h = 0; h < 2; ++h)
#pragma unroll
            for (int i = 0; i < 2; ++i) { const int e = __builtin_amdgcn_readfirstlane(tile_e[u.pm]); const int idx = (u.pm - __builtin_amdgcn_readfirstlane(tbase[e])) * BM + h * HALF + R[i];
                const int tk = (idx < __builtin_amdgcn_readfirstlane(tot[e])) ? etok[e * 8192 + idx] : 0; vo[h][i] = (unsigned)(tk * g.ld + Cc[i]) * 2u; } }
    __device__ __forceinline__ const char* bptr(const Gemm& g, const Unit& u, size_t tstep) const { const int e = __builtin_amdgcn_readfirstlane(tile_e[u.pm]); return (const char*)g.Bt + ((size_t)e * NE + (size_t)u.pn * BM) * (size_t)g.ld * 2; }
};
typedef MoeOrderT<false> MoeOrder; typedef MoeOrderT<true> MoeGatherOrder;
struct MoeUpOrder : MoeOrderT<true> {
    unsigned* cnt; PG8_LAS unsigned* lcnt;
    __device__ __forceinline__ void done(const Unit& u) const { asm volatile("s_waitcnt vmcnt(0)" ::: "memory");
        unsigned old = 0u; if (__builtin_amdgcn_mbcnt_hi(~0u, __builtin_amdgcn_mbcnt_lo(~0u, 0u)) == 0u) old = __hip_atomic_fetch_add(lcnt, 1u, __ATOMIC_RELAXED, __HIP_MEMORY_SCOPE_WORKGROUP);
        if ((__builtin_amdgcn_readfirstlane(old) & 7u) == 7u) {
            __builtin_amdgcn_fence(__ATOMIC_RELEASE, "agent"); asm volatile("s_waitcnt vmcnt(0)" ::: "memory");
            if (__builtin_amdgcn_mbcnt_hi(~0u, __builtin_amdgcn_mbcnt_lo(~0u, 0u)) == 0u) __hip_atomic_fetch_add(cnt + u.pm * 16, 1u, __ATOMIC_RELAXED, __HIP_MEMORY_SCOPE_AGENT); } }
};
struct MoeDownOrder : MoeOrderT<false> {
#ifdef BISECT_NOSC1LD
    static constexpr int A_AUX = 0;
#else
    static constexpr int A_AUX = 16;
#endif
    const unsigned* cnt; int n1, n0s;
    __device__ __forceinline__ void init2(int ntiles, int G_, int c_) { lg = 3; nunits = ntiles << 3; G = G_; c = c_; n1 = (ntiles << 2) % G_; n0s = n1 ? 3 * (G_ - n1) : 0; }
    __device__ __forceinline__ bool next(int i, Unit& u) const { int L;
#ifdef BISECT_OLDDEAL
        return MoeOrderT<false>::next(i, u);
#endif
        if (c < n1) L = n0s + i * G + c; else if (n1 && i < 3) L = i * (G - n1) + (c - n1); else L = n0s + (i - (n1 ? 3 : 0)) * G + c;
        if (L >= nunits) return false; u.pm = L >> 3; u.pn = L & 7; u.ord = i; return true; }
    __device__ __forceinline__ void a_ready(const Unit& u) const {
#ifdef BISECT_NOPOLL
        return;
#endif
        const __attribute__((address_space(1))) unsigned* w = (const __attribute__((address_space(1))) unsigned*)(cnt + u.pm * 16); unsigned spins = 0;
        while ((unsigned)__builtin_amdgcn_readfirstlane(__hip_atomic_load(w, __ATOMIC_RELAXED, __HIP_MEMORY_SCOPE_AGENT)) < 4u) { __builtin_amdgcn_s_sleep(1); if (++spins > (1u << 20)) break; }
        __builtin_amdgcn_fence(__ATOMIC_ACQUIRE, "agent"); asm volatile("s_waitcnt vmcnt(0)" ::: "memory"); }
};

template <class Epi, class Sched, bool ALIGN_EPI = false, bool SP2 = false>
__device__ __forceinline__ void gemm_phase(PG8_LAS unsigned char* lds, const Gemm g, const Sched& S, const Epi& E) {
    int tid_ = threadIdx.x; asm volatile("" : "+v"(tid_)); const int tid = tid_, wid = __builtin_amdgcn_readfirstlane(tid >> 6), lane = tid & 63, wr = wid >> 2, wc = wid & 3, fr = lane & 15, fq = lane >> 4;
    const int K = g.ld, nt = g.K / BK;
    unsigned voffA[2], voffB[2]; int RA[2], CA[2];
#pragma unroll
    for (int i = 0; i < 2; ++i) { int R, C; stage_rc(tid * 16 + i * 8192, R, C); RA[i] = R; CA[i] = C; const int Rb = Epi::PERM ? ((R & ~31) + perm32(R & 31)) : R;
        voffA[i] = (unsigned)(R * K + C) * 2u; voffB[i] = (unsigned)(Rb * K + C) * 2u; }
    const size_t kstep = (size_t)(BK * 2);
    const size_t hstep = (size_t)HALF * K * 2;
    const size_t tstep = 2 * hstep;
    const size_t hstepA = Sched::GATHER ? 0 : hstep;
    unsigned cvo[2][2], nvo[2][2];
#pragma unroll
    for (int h_ = 0; h_ < 2; ++h_)
#pragma unroll
        for (int i = 0; i < 2; ++i) { cvo[h_][i] = voffA[i]; nvo[h_][i] = voffA[i]; }
    const unsigned ldsw = (unsigned)wid * 1024u;
    const int aoff = lds_byte(wr * 64 + fr, fq * 8), boff = lds_byte(wc * 32 + fr, fq * 8);
#define PG8_SA(b, h) (((b) * 2 + (h)) * HTB)
#define PG8_SB(b, h) ((4 + (b) * 2 + (h)) * HTB)
#define PG8_STAGE(bufoff, gbase, voff) do { _Pragma("unroll") for (int _i = 0; _i < 2; ++_i) \
        __builtin_amdgcn_global_load_lds((const unsigned*)((const char*)(gbase) + (voff)[_i]), (PG8_LAS unsigned*)(lds + (bufoff) + ldsw + _i * 8192), 16, 0, 0); } while (0)
#define PG8_STAGEA(bufoff, gbase, voff) do { _Pragma("unroll") for (int _i = 0; _i < 2; ++_i) \
        __builtin_amdgcn_global_load_lds((const unsigned*)((const char*)(gbase) + (voff)[_i]), (PG8_LAS unsigned*)(lds + (bufoff) + ldsw + _i * 8192), 16, 0, Sched::A_AUX); } while (0)
#define PG8_LDA(dst, b, h) do { _Pragma("unroll") for (int m = 0; m < 4; ++m) _Pragma("unroll") for (int k = 0; k < 2; ++k) dst[m][k] = *(const PG8_LAS bf16x8*)(lds + PG8_SA(b, h) + aoff + m * 2048 + k * 1024); } while (0)
#define PG8_LDB(dst, b, h) do { _Pragma("unroll") for (int n = 0; n < 2; ++n) _Pragma("unroll") for (int k = 0; k < 2; ++k) dst[n][k] = *(const PG8_LAS bf16x8*)(lds + PG8_SB(b, h) + boff + n * 2048 + k * 1024); } while (0)
#define PG8_MMA(ai, bj, At, Bt) do { __builtin_amdgcn_s_setprio(1); _Pragma("unroll") for (int m = 0; m < 4; ++m) _Pragma("unroll") for (int n = 0; n < 2; ++n) _Pragma("unroll") for (int k = 0; k < 2; ++k) \
        acc[ai][bj][m][n] = __builtin_amdgcn_mfma_f32_16x16x32_bf16(Bt[n][k], At[m][k], acc[ai][bj][m][n], 0, 0, 0); __builtin_amdgcn_s_setprio(0); } while (0)
#define PG8_WAIT_V(n) asm volatile("s_waitcnt vmcnt(" #n ")" ::: "memory")
#define PG8_WAIT_L(n) asm volatile("s_waitcnt lgkmcnt(" #n ")" ::: "memory")
#define PG8_BAR __builtin_amdgcn_s_barrier()
#define PG8_SCHED __builtin_amdgcn_sched_barrier(0)
    Unit cur, nxt; int ui = 0;
    if (!S.next(0, cur)) return;
    f32x4 acc[2][2][4][2];
#pragma unroll
    for (int a = 0; a < 2; ++a)
#pragma unroll
        for (int b = 0; b < 2; ++b)
#pragma unroll
            for (int m = 0; m < 4; ++m)
#pragma unroll
                for (int n = 0; n < 2; ++n) acc[a][b][m][n] = (f32x4){0.f, 0.f, 0.f, 0.f};
    bf16x8 At[4][2], B0[2][2], B1[2][2];
    const char* cA = S.aptr(g, cur, tstep); const char* cB = S.bptr(g, cur, tstep);
    S.a_ready(cur);
    if constexpr (Sched::GATHER) S.rowoffs(g, cur, RA, CA, cvo);
    if constexpr (SP2) {
        PG8_STAGE(PG8_SB(0, 0), cB, voffB); PG8_STAGE(PG8_SB(0, 1), cB + hstep, voffB); PG8_STAGEA(PG8_SA(0, 0), cA, cvo[0]); PG8_STAGEA(PG8_SA(0, 1), cA + hstepA, cvo[1]);
        if (wr == 1) PG8_BAR;
        PG8_WAIT_V(2); PG8_BAR;
        PG8_STAGE(PG8_SB(1, 0), cB + kstep, voffB); PG8_STAGEA(PG8_SA(1, 0), cA + kstep, cvo[0]); PG8_STAGE(PG8_SB(1, 1), cB + hstep + kstep, voffB);
        PG8_WAIT_V(6); PG8_BAR;
    } else {
        PG8_STAGE(PG8_SB(0, 0), cB, voffB); PG8_STAGEA(PG8_SA(0, 0), cA, cvo[0]); PG8_STAGE(PG8_SB(0, 1), cB + hstep, voffB); PG8_STAGEA(PG8_SA(0, 1), cA + hstepA, cvo[1]);
        if (wr == 1) PG8_BAR;
        PG8_WAIT_V(4); PG8_BAR;
        PG8_STAGE(PG8_SB(1, 0), cB + kstep, voffB); PG8_STAGEA(PG8_SA(1, 0), cA + kstep, cvo[0]); PG8_STAGE(PG8_SB(1, 1), cB + hstep + kstep, voffB);
        PG8_WAIT_V(6); PG8_BAR;
    }
    for (;;) {
        const bool has_next = S.next(ui + 1, nxt);
        const char* nA = has_next ? S.aptr(g, nxt, tstep) : cA; const char* nB = has_next ? S.bptr(g, nxt, tstep) : cB;
        if constexpr (Sched::GATHER) { if (has_next) S.rowoffs(g, nxt, RA, CA, nvo); }
        for (int t = 0; t < nt; t += 2) {
            const bool last = (t == nt - 2);
            const char* a1 = cA + (size_t)(t + 1) * kstep;
            const char* a2 = last ? nA : cA + (size_t)(t + 2) * kstep; const char* b2 = last ? nB : cB + (size_t)(t + 2) * kstep;
            const char* a3 = a2 + kstep; const char* b3 = b2 + kstep;
            if (last && has_next) S.a_ready(nxt);
            const bool nx_ = Sched::GATHER && last && has_next;
            const unsigned v0s[2] = {nx_ ? nvo[0][0] : cvo[0][0], nx_ ? nvo[0][1] : cvo[0][1]}, v1s[2] = {nx_ ? nvo[1][0] : cvo[1][0], nx_ ? nvo[1][1] : cvo[1][1]};
            if constexpr (SP2) {
            PG8_LDB(B0, 0, 0); PG8_LDB(B1, 0, 1); PG8_SCHED; PG8_LDA(At, 0, 0); PG8_STAGEA(PG8_SA(1, 1), a1 + hstepA, cvo[1]);
            PG8_WAIT_V(8); PG8_WAIT_L(0); PG8_BAR; PG8_MMA(0, 0, At, B0); PG8_MMA(0, 1, At, B1); PG8_BAR; PG8_SCHED;
            PG8_LDA(At, 0, 1); PG8_STAGE(PG8_SB(0, 0), b2, voffB); PG8_STAGE(PG8_SB(0, 1), b2 + hstep, voffB); PG8_STAGEA(PG8_SA(0, 0), a2, v0s);
            PG8_WAIT_V(8); PG8_WAIT_L(0); PG8_BAR; PG8_MMA(1, 0, At, B0); PG8_MMA(1, 1, At, B1); PG8_BAR; PG8_SCHED;
            PG8_LDB(B0, 1, 0); PG8_LDB(B1, 1, 1); PG8_SCHED; PG8_LDA(At, 1, 0); PG8_STAGEA(PG8_SA(0, 1), a2 + hstepA, v1s);
            PG8_WAIT_V(8); PG8_WAIT_L(0); PG8_BAR; PG8_MMA(0, 0, At, B0); PG8_MMA(0, 1, At, B1); PG8_BAR; PG8_SCHED;
            PG8_LDA(At, 1, 1); PG8_STAGE(PG8_SB(1, 0), b3, voffB); PG8_STAGE(PG8_SB(1, 1), b3 + hstep, voffB); PG8_STAGEA(PG8_SA(1, 0), a3, v0s);
            PG8_WAIT_V(8); PG8_WAIT_L(0); PG8_BAR; PG8_MMA(1, 0, At, B0); PG8_MMA(1, 1, At, B1); PG8_BAR; PG8_SCHED;
            } else {
            PG8_LDB(B0, 0, 0); PG8_SCHED; PG8_LDA(At, 0, 0); PG8_STAGEA(PG8_SA(1, 1), a1 + hstepA, cvo[1]);
            PG8_WAIT_L(8); PG8_BAR; PG8_WAIT_L(0); PG8_MMA(0, 0, At, B0); PG8_BAR; PG8_SCHED;
            PG8_LDB(B1, 0, 1); PG8_STAGE(PG8_SB(0, 0), b2, voffB);
            PG8_BAR; PG8_WAIT_L(0); PG8_MMA(0, 1, At, B1); PG8_BAR;
            PG8_LDA(At, 0, 1); PG8_STAGEA(PG8_SA(0, 0), a2, v0s);
            PG8_BAR; PG8_WAIT_L(0); PG8_MMA(1, 0, At, B0); PG8_BAR; PG8_SCHED;
            PG8_STAGE(PG8_SB(0, 1), b2 + hstep, voffB);
            PG8_WAIT_V(6); PG8_BAR; PG8_MMA(1, 1, At, B1); PG8_BAR;
            PG8_LDB(B0, 1, 0); PG8_SCHED; PG8_LDA(At, 1, 0); PG8_STAGEA(PG8_SA(0, 1), a2 + hstepA, v1s);
            PG8_WAIT_L(8); PG8_BAR; PG8_WAIT_L(0); PG8_MMA(0, 0, At, B0); PG8_BAR; PG8_SCHED;
            PG8_LDB(B1, 1, 1); PG8_STAGE(PG8_SB(1, 0), b3, voffB);
            PG8_BAR; PG8_WAIT_L(0); PG8_MMA(0, 1, At, B1); PG8_BAR;
            PG8_LDA(At, 1, 1); PG8_STAGEA(PG8_SA(1, 0), a3, v0s);
            PG8_BAR; PG8_WAIT_L(0); PG8_MMA(1, 0, At, B0); PG8_BAR; PG8_SCHED;
            PG8_STAGE(PG8_SB(1, 1), b3 + hstep, voffB);
            PG8_WAIT_V(6); PG8_BAR; PG8_MMA(1, 1, At, B1); PG8_BAR;
            }
        }
        if constexpr (ALIGN_EPI) { if (wr == 0) PG8_BAR; }
        if constexpr (!Epi::AFTER_DRAIN) { E(acc, cur, wr, wc, fr, fq); S.done(cur); }
        if (!has_next) break;
#pragma unroll
        for (int a = 0; a < 2; ++a)
#pragma unroll
            for (int b = 0; b < 2; ++b)
#pragma unroll
                for (int m = 0; m < 4; ++m)
#pragma unroll
                    for (int n = 0; n < 2; ++n) acc[a][b][m][n] = (f32x4){0.f, 0.f, 0.f, 0.f};
        cur = nxt; cA = nA; cB = nB; ++ui;
#pragma unroll
        for (int h_ = 0; h_ < 2; ++h_)
#pragma unroll
            for (int i = 0; i < 2; ++i) cvo[h_][i] = nvo[h_][i];
        if constexpr (ALIGN_EPI) { if (wr == 1) PG8_BAR; }
    }
    PG8_WAIT_V(0);
    if constexpr (!ALIGN_EPI) { if (wr == 0) PG8_BAR; }
    PG8_BAR;
    if constexpr (Epi::AFTER_DRAIN) { E.fused(acc, cur, wr, wc, fr, fq, lds, wid, lane); S.done(cur); }
#undef PG8_SA
#undef PG8_SB
#undef PG8_STAGE
#undef PG8_LDA
#undef PG8_LDB
#undef PG8_MMA
#undef PG8_WAIT_V
#undef PG8_WAIT_L
#undef PG8_BAR
#undef PG8_SCHED
}
}


#define PG8_SP2 true
#define PG8_ALIGN true
#include <hip/hip_bf16.h>
#include <cmath>
namespace attn_body {
using bf16=__hip_bfloat16;
using bf16x8=__attribute__((ext_vector_type(8)))short;
using s16x4=__attribute__((ext_vector_type(4)))short;
using f32x16=__attribute__((ext_vector_type(16)))float;
using u32x4=__attribute__((ext_vector_type(4)))unsigned;
constexpr int BATCH=2,NHEAD=16,SEQ=4096,D=64,DM=6656,DMO=1024;
constexpr int NW=8,QBLK=32,QB=QBLK*NW,KVBLK=64,NQB=SEQ/QB;
constexpr int ATTN_PITCH=DM, ATTN_UNIT_ROWS=QB;
__device__ __forceinline__ int crow(int r,int hi){return (r&3)+8*(r>>2)+4*hi;}
#define SBAR() __builtin_amdgcn_sched_barrier(0)
__device__ __forceinline__ void cmask(f32x16&p0,f32x16&p1,int jb,int qrel,int hi){
  const float NEG=-INFINITY; int kb=64*jb+4*hi;
  #pragma unroll
  for(int r=0;r<16;++r){int kv=kb+(r&3)+8*(r>>2); if(kv>qrel)p0[r]=NEG; if(kv+32>qrel)p1[r]=NEG;}
}

constexpr int NSLOT=3, SLOTB=8192;
constexpr int LDS_K=0, LDS_V=NSLOT*SLOTB, LDS_WS=2*NSLOT*SLOTB, LDS_OST=LDS_WS+NW*64*4, LDS_BYTES=LDS_OST+NW*4096;
constexpr float C2=0.125f*1.4426950408889634f;
__device__ __forceinline__ void glds16(const void*gsrc,unsigned lds_dst){unsigned keep;
  asm volatile("s_mov_b32 %0, m0\n\ts_mov_b32 m0, %2\n\ts_nop 0\n\tglobal_load_lds_dwordx4 %1, off\n\ts_mov_b32 m0, %0":"=&s"(keep):"v"(gsrc),"s"(lds_dst):"memory");}
__device__ __forceinline__ float max3f(float a,float b,float c){float r;asm("v_max3_f32 %0, %1, %2, %3":"=v"(r):"v"(a),"v"(b),"v"(c));return r;}
__device__ __forceinline__ float max2f(float a,float b){float r;asm("v_max_f32_e32 %0, %1, %2":"=v"(r):"v"(a),"v"(b));return r;}
__device__ __forceinline__ float fadd_s(float a,float b){float r;asm("v_add_f32_e32 %0, %1, %2":"=v"(r):"v"(a),"v"(b));return r;}
__device__ __forceinline__ float fsub_s(float a,float b){float r;asm("v_sub_f32_e32 %0, %1, %2":"=v"(r):"v"(a),"v"(b));return r;}
typedef float f32x2_t __attribute__((ext_vector_type(2))); typedef __bf16 bf16x2_t __attribute__((ext_vector_type(2)));
__device__ __forceinline__ unsigned cvtpk_s(float lo,float hi){f32x2_t v={lo,hi};bf16x2_t b=__builtin_convertvector(v,bf16x2_t);return __builtin_bit_cast(unsigned,b);}
#define WAIT_BAR(N) asm volatile("s_waitcnt vmcnt(" #N ") lgkmcnt(0)\n\ts_barrier":::"memory")

__device__ __forceinline__ void qkt(f32x16&p0,f32x16&p1,const char*Kslot,const bf16x8*qr,const f32x16&negm,int r32,int hi){
  const char*kb=Kslot+hi*1024+r32*16;
  #pragma unroll
  for(int d0=0;d0<4;++d0){
    const bf16x8 b0=*reinterpret_cast<const bf16x8*>(kb+d0*2048);
    const bf16x8 b1=*reinterpret_cast<const bf16x8*>(kb+d0*2048+512);
    if(d0==0){p0=__builtin_amdgcn_mfma_f32_32x32x16_bf16(b0,qr[0],negm,0,0,0);p1=__builtin_amdgcn_mfma_f32_32x32x16_bf16(b1,qr[0],negm,0,0,0);}
    else{p0=__builtin_amdgcn_mfma_f32_32x32x16_bf16(b0,qr[d0],p0,0,0,0);p1=__builtin_amdgcn_mfma_f32_32x32x16_bf16(b1,qr[d0],p1,0,0,0);}}
}
typedef __attribute__((address_space(3))) const char* lds_cptr;
typedef short v4i16_t __attribute__((ext_vector_type(4)));
__device__ __forceinline__ void kload8(bf16x8*kf,lds_cptr kp){
  kf[0]=*(const __attribute__((address_space(3))) bf16x8*)(kp);      kf[1]=*(const __attribute__((address_space(3))) bf16x8*)(kp+512);
  kf[2]=*(const __attribute__((address_space(3))) bf16x8*)(kp+2048); kf[3]=*(const __attribute__((address_space(3))) bf16x8*)(kp+2560);
  kf[4]=*(const __attribute__((address_space(3))) bf16x8*)(kp+4096); kf[5]=*(const __attribute__((address_space(3))) bf16x8*)(kp+4608);
  kf[6]=*(const __attribute__((address_space(3))) bf16x8*)(kp+6144); kf[7]=*(const __attribute__((address_space(3))) bf16x8*)(kp+6656);
}
__device__ __forceinline__ void kload2(bf16x8*kf,lds_cptr kp,int j){ kf[2*j]=*(const __attribute__((address_space(3))) bf16x8*)(kp+j*2048); kf[2*j+1]=*(const __attribute__((address_space(3))) bf16x8*)(kp+j*2048+512); }
__device__ __forceinline__ s16x4 vtr(lds_cptr p){ return __builtin_bit_cast(s16x4,__builtin_amdgcn_ds_read_tr16_b64_v4i16((__attribute__((address_space(3))) v4i16_t*)p)); }
__device__ __forceinline__ float rowmax(const f32x16&p0,const f32x16&p1){
  float a=max3f(p0[0],p0[1],p1[0]),b=max3f(p0[2],p0[3],p1[1]);a=max3f(a,p1[2],p1[3]);
  #pragma unroll
  for(int r=4;r<16;r+=4){a=max3f(a,p0[r],p0[r+1]);b=max3f(b,p0[r+2],p0[r+3]);a=max3f(a,p1[r],p1[r+1]);b=max3f(b,p1[r+2],p1[r+3]);}
  const float m=max2f(a,b);
  auto rr=__builtin_amdgcn_permlane32_swap(__float_as_uint(m),__float_as_uint(m),false,false);
  return max2f(__uint_as_float(rr[0]),__uint_as_float(rr[1]));
}
__device__ __forceinline__ void pv(f32x16*o,int vb,bf16x8 pa0,bf16x8 pa1,bf16x8 pa2,bf16x8 pa3){
  #pragma unroll
  for(int d0=0;d0<2;++d0){s16x4 lo[4],hi[4];
    #pragma unroll
    for(int ks=0;ks<4;++ks){
      asm volatile("ds_read_b64_tr_b16 %0,%1 offset:%c2":"=&v"(lo[ks]):"v"(vb),"i"(d0*4096+ks*1024):"memory");
      asm volatile("ds_read_b64_tr_b16 %0,%1 offset:%c2":"=&v"(hi[ks]):"v"(vb),"i"(d0*4096+ks*1024+512):"memory");}
    asm volatile("s_waitcnt lgkmcnt(0)":::"memory");SBAR();
    #define PK(k) (bf16x8){lo[k][0],lo[k][1],lo[k][2],lo[k][3],hi[k][0],hi[k][1],hi[k][2],hi[k][3]}
    o[d0]=__builtin_amdgcn_mfma_f32_32x32x16_bf16(pa0,PK(0),o[d0],0,0,0);
    o[d0]=__builtin_amdgcn_mfma_f32_32x32x16_bf16(pa1,PK(1),o[d0],0,0,0);
    o[d0]=__builtin_amdgcn_mfma_f32_32x32x16_bf16(pa2,PK(2),o[d0],0,0,0);
    o[d0]=__builtin_amdgcn_mfma_f32_32x32x16_bf16(pa3,PK(3),o[d0],0,0,0);
    #undef PK
  }
}

#ifndef ATTN_STORE16
#define ATTN_STORE16(p,v) (*(u32x4*)(p)=(v))
#endif
template<int THRL> __device__ __forceinline__ void attn_unit(int b,int qb,const bf16*Q,const bf16*__restrict__ K,const bf16*__restrict__ V,bf16*O,char*shm){
  int tid_=threadIdx.x; asm volatile("":"+v"(tid_)); const int tid=tid_,lane=tid&63,r32=lane&31,hi=lane>>5; const int wid=__builtin_amdgcn_readfirstlane(tid>>6);
  const long rowbase=(long)b*SEQ; const int q0=qb*QB;
  const bf16*Qw=Q+(rowbase+q0+wid*QBLK)*DM;
  const bf16*Kh=K+rowbase*DM,*Vh=V+rowbase*DM;
  const unsigned lds0=(unsigned)(uintptr_t)shm;
  float*wsf=(float*)(shm+LDS_WS)+wid*64;
  const bf16*ksrc=Kh+(long)lane*DM+wid*8;
  const bf16*vsrc=Vh+(long)(16*(wid&3)+(lane>>2))*DM+(wid>>2)*32+(lane&3)*8;
  const unsigned kdst=lds0+LDS_K+wid*1024, vdst=lds0+LDS_V+wid*1024;
  #define DMA_K(t,slot) glds16(ksrc+(long)(t)*KVBLK*DM,(unsigned)__builtin_amdgcn_readfirstlane(kdst+(slot)))
  #define DMA_V(t,slot) glds16(vsrc+(long)(t)*KVBLK*DM,(unsigned)__builtin_amdgcn_readfirstlane(vdst+(slot)))
  const int vb0=(int)(lds0+LDS_V)+((lane>>4)&1)*32+(lane&3)*8+(4*hi+((lane&15)>>2))*64;
  const char*Kbase=shm+LDS_K; bf16x8 kf[8];
  const lds_cptr shm3=(lds_cptr)shm; const lds_cptr kp0=shm3+LDS_K+hi*1024+r32*16; const lds_cptr vp0=shm3+LDS_V+((lane>>4)&1)*32+(lane&3)*8+(4*hi+((lane&15)>>2))*64;
  const int NT=(q0+QB)/KVBLK;
  DMA_K(0,0);DMA_V(0,0);DMA_K(1,SLOTB);
  bf16x8 qr[4];
  #pragma unroll
  for(int d0=0;d0<4;++d0)qr[d0]=*reinterpret_cast<const bf16x8*>(&Qw[(long)r32*DM+d0*16+hi*8]);
  float mhat=0.f,l_reg=0.f;f32x16 o[2];o[0]=f32x16{};o[1]=f32x16{};f32x16 negm=f32x16{};asm volatile("":"+v"(negm));
  const int qrel=wid*QBLK+r32;
  #define CMASK(P0,P1,t) do{int jb_=(t)-(NT-4); if(jb_>=0)cmask(P0,P1,jb_,qrel,hi);}while(0)
  bool resc=false;
  #define START(P0,P1) do{ const float rm=rowmax(P0,P1); resc=false; \
    { const float dl=rm; mhat=fadd_s(mhat,dl); \
      _Pragma("unroll") for(int r=0;r<16;++r){P0[r]=fsub_s(P0[r],dl);P1[r]=fsub_s(P1[r],dl);} \
      _Pragma("unroll") for(int r=0;r<16;++r)negm[r]=-mhat; asm volatile("":"+v"(negm)); } \
    _Pragma("unroll") for(int r=0;r<16;++r)P0[r]=__builtin_amdgcn_exp2f(P0[r]); }while(0)
  #define RESC() do{ if(resc){ asm volatile("s_waitcnt lgkmcnt(0)":::"memory"); \
      _Pragma("unroll") for(int d_=0;d_<2;++d_) _Pragma("unroll") for(int r=0;r<16;++r)o[d_][r]*=wsf[crow(r,hi)]; } }while(0)
  f32x16 pA0,pA1,pB0,pB1;
  int sl_prev=0,sl_cur=0,sl_next=SLOTB;
  #define ROT() do{sl_prev=sl_cur;sl_cur=sl_next;sl_next=(sl_next==(NSLOT-1)*SLOTB)?0:sl_next+SLOTB;}while(0)
  DMA_K(2,2*SLOTB);
  WAIT_BAR(3);
  qkt(pA0,pA1,Kbase,qr,negm,r32,hi);asm volatile("s_nop 15\n\ts_nop 7":"+v"(pA0),"+v"(pA1));CMASK(pA0,pA1,0);
  START(pA0,pA1);
  _Pragma("unroll") for(int r=0;r<16;++r)pA1[r]=__builtin_amdgcn_exp2f(pA1[r]);
  WAIT_BAR(0);
  DMA_K(3,0);DMA_V(1,SLOTB);
  ROT();
  kload8(kf,kp0+sl_cur);
  WAIT_BAR(2);
  s16x4 vlo[8],vhi[8]; u32x4 pw0,pw1,pw2,pw3;
  #define PKW(P,B) cvtpk_s(P[B],P[B+1])
  #define PAF(k) __builtin_bit_cast(bf16x8,pw##k)
  #define VFR(i) (bf16x8){vlo[i][0],vlo[i][1],vlo[i][2],vlo[i][3],vhi[i][0],vhi[i][1],vhi[i][2],vhi[i][3]}
  #define PIN(x) asm volatile("":"+v"(x))
  #define MX3(a,b,c) __builtin_fmaxf(__builtin_fmaxf((a),(b)),(c))
  #define GAPA(MF,A0,A1,A2,A3,W0,W1,PW) do{ MF; sacc+=A0; sacc+=A1; sacc+=A2; sacc+=A3; PIN(sacc); W0; W1; PIN(PW); SBAR(); }while(0)
  #define EX(v) __builtin_amdgcn_exp2f(v)
  #define GAPB(MF,X,B) do{ MF; X[B]=EX(X[B]); X[B+1]=EX(X[B+1]); X[B+2]=EX(X[B+2]); X[B+3]=EX(X[B+3]); PIN(X); SBAR(); }while(0)
  #define VRD(i) do{ vlo[i]=vtr(vp_+(((i)>>2)*4096+((i)&3)*1024)); vhi[i]=vtr(vp_+(((i)>>2)*4096+((i)&3)*1024+512)); }while(0)
  #define KRD(G,j) do{ if(G){ kload2(kf,kp0+sl_next,j); SBAR(); } }while(0)
  #define STEP(C0,C1,P0,P1,t,GK,GV,GL) do{ SBAR(); \
    const lds_cptr vp_=vp0+sl_prev; \
    VRD(0); SBAR(); float sacc=(P0[0]+P0[1]); \
    GAPA(C0=__builtin_amdgcn_mfma_f32_32x32x16_bf16(kf[0],qr[0],negm,0,0,0), P0[2],P0[3],P0[4],P0[5],     pw0[0]=PKW(P0,0), pw0[1]=PKW(P0,2), pw0); \
    VRD(4); SBAR(); GAPA(C1=__builtin_amdgcn_mfma_f32_32x32x16_bf16(kf[1],qr[0],negm,0,0,0), P0[6],P0[7],P0[8],P0[9],     pw0[2]=PKW(P0,4), pw0[3]=PKW(P0,6), pw0); \
    VRD(1); SBAR(); GAPA(C0=__builtin_amdgcn_mfma_f32_32x32x16_bf16(kf[2],qr[1],C0,0,0,0),   P0[10],P0[11],P0[12],P0[13], pw1[0]=PKW(P0,8), pw1[1]=PKW(P0,10), pw1); \
    VRD(5); SBAR(); GAPA(C1=__builtin_amdgcn_mfma_f32_32x32x16_bf16(kf[3],qr[1],C1,0,0,0),   P0[14],P0[15],P1[0],P1[1],   pw1[2]=PKW(P0,12),pw1[3]=PKW(P0,14), pw1); \
    VRD(2); SBAR(); GAPA(C0=__builtin_amdgcn_mfma_f32_32x32x16_bf16(kf[4],qr[2],C0,0,0,0),   P1[2],P1[3],P1[4],P1[5],     pw2[0]=PKW(P1,0), pw2[1]=PKW(P1,2), pw2); \
    VRD(6); SBAR(); GAPA(C1=__builtin_amdgcn_mfma_f32_32x32x16_bf16(kf[5],qr[2],C1,0,0,0),   P1[6],P1[7],P1[8],P1[9],     pw2[2]=PKW(P1,4), pw2[3]=PKW(P1,6), pw2); \
    VRD(3); SBAR(); GAPA(C0=__builtin_amdgcn_mfma_f32_32x32x16_bf16(kf[6],qr[3],C0,0,0,0),   P1[10],P1[11],P1[12],P1[13], pw3[0]=PKW(P1,8), pw3[1]=PKW(P1,10), pw3); \
    VRD(7); SBAR(); GAPA(C1=__builtin_amdgcn_mfma_f32_32x32x16_bf16(kf[7],qr[3],C1,0,0,0),   P1[14],P1[15],0.f,0.f,       pw3[2]=PKW(P1,12),pw3[3]=PKW(P1,14), pw3); \
    l_reg+=sacc; \
    if(GK){DMA_K((t)+3,sl_cur);} if(GV){DMA_V((t)+1,sl_next);} \
    CMASK(C0,C1,t); \
    { float a=MX3(C0[0],C0[1],C1[0]),b=MX3(C0[2],C0[3],C1[1]); a=MX3(a,C1[2],C1[3]); \
      _Pragma("unroll") for(int r=4;r<16;r+=4){a=MX3(a,C0[r],C0[r+1]);b=MX3(b,C0[r+2],C0[r+3]);a=MX3(a,C1[r],C1[r+1]);b=MX3(b,C1[r+2],C1[r+3]);} \
      float rm=__builtin_fmaxf(a,b); { auto rr=__builtin_amdgcn_permlane32_swap(__float_as_uint(rm),__float_as_uint(rm),false,false); rm=__builtin_fmaxf(__uint_as_float(rr[0]),__uint_as_float(rr[1])); } \
      resc=false; \
      if(__builtin_expect(__any(rm>(float)THRL),0)){ const float dl=__builtin_fmaxf(rm,0.f); mhat+=dl; \
        _Pragma("unroll") for(int r=0;r<16;++r){C0[r]-=dl;C1[r]-=dl;} \
        _Pragma("unroll") for(int r=0;r<16;++r)negm[r]=-mhat; asm volatile("":"+v"(negm)); \
        const float f=__builtin_amdgcn_exp2f(-dl); l_reg*=f; if(hi==0)wsf[r32]=f; resc=true; } } \
    SBAR(); \
    GAPB(o[0]=__builtin_amdgcn_mfma_f32_32x32x16_bf16(PAF(0),VFR(0),o[0],0,0,0), C0,0); \
    GAPB(o[1]=__builtin_amdgcn_mfma_f32_32x32x16_bf16(PAF(0),VFR(4),o[1],0,0,0), C0,4); \
    KRD(GL,0); GAPB(o[0]=__builtin_amdgcn_mfma_f32_32x32x16_bf16(PAF(1),VFR(1),o[0],0,0,0), C0,8); \
    KRD(GL,1); GAPB(o[1]=__builtin_amdgcn_mfma_f32_32x32x16_bf16(PAF(1),VFR(5),o[1],0,0,0), C0,12); \
    KRD(GL,2); GAPB(o[0]=__builtin_amdgcn_mfma_f32_32x32x16_bf16(PAF(2),VFR(2),o[0],0,0,0), C1,0); \
    KRD(GL,3); GAPB(o[1]=__builtin_amdgcn_mfma_f32_32x32x16_bf16(PAF(2),VFR(6),o[1],0,0,0), C1,4); \
    GAPB(o[0]=__builtin_amdgcn_mfma_f32_32x32x16_bf16(PAF(3),VFR(3),o[0],0,0,0), C1,8); \
    GAPB(o[1]=__builtin_amdgcn_mfma_f32_32x32x16_bf16(PAF(3),VFR(7),o[1],0,0,0), C1,12); \
    }while(0)
  int t=1;
  #undef CMASK
  #define CMASK(P0,P1,t) do{}while(0)
  for(;t+5<NT;t+=2){
    STEP(pB0,pB1,pA0,pA1,t,true,true,true);     WAIT_BAR(2); RESC(); ROT();
    STEP(pA0,pA1,pB0,pB1,t+1,true,true,true);   WAIT_BAR(2); RESC(); ROT();
  }
  #undef CMASK
  #define CMASK(P0,P1,t) do{int jb_=(t)-(NT-4); if(jb_>=0)cmask(P0,P1,jb_,qrel,hi);}while(0)
  #define ENDW(tt) do{ if((tt)+3<NT){WAIT_BAR(2);} else if((tt)+2<NT){WAIT_BAR(1);} else {WAIT_BAR(0);} }while(0)
  for(;t+1<NT;t+=2){
    STEP(pB0,pB1,pA0,pA1,t,(t+3<NT),(t+1<NT),(t+1<NT));       ENDW(t);   RESC(); ROT();
    STEP(pA0,pA1,pB0,pB1,t+1,(t+4<NT),(t+2<NT),(t+2<NT));     ENDW(t+1); RESC(); ROT();
  }
  STEP(pB0,pB1,pA0,pA1,NT-1,false,false,false); RESC();
  { float sacc=pB0[0]+pB0[1]; _Pragma("unroll") for(int r=2;r<16;++r)sacc+=pB0[r]; _Pragma("unroll") for(int r=0;r<16;++r)sacc+=pB1[r]; l_reg+=sacc;
    pw0=(u32x4){PKW(pB0,0),PKW(pB0,2),PKW(pB0,4),PKW(pB0,6)};pw1=(u32x4){PKW(pB0,8),PKW(pB0,10),PKW(pB0,12),PKW(pB0,14)};pw2=(u32x4){PKW(pB1,0),PKW(pB1,2),PKW(pB1,4),PKW(pB1,6)};pw3=(u32x4){PKW(pB1,8),PKW(pB1,10),PKW(pB1,12),PKW(pB1,14)};
    SBAR(); pv(o,vb0+sl_cur,PAF(0),PAF(1),PAF(2),PAF(3)); }
  #undef PKW
  #undef PAF
  #undef VFR
  #undef PIN
  #undef MX3
  #undef GAPA
  #undef GAPB
  #undef EX
  #undef VRD
  #undef KRD
  #undef STEP
  #undef ENDW
  {auto rr=__builtin_amdgcn_permlane32_swap(__float_as_uint(l_reg),__float_as_uint(l_reg),false,false);l_reg=__uint_as_float(rr[0])+__uint_as_float(rr[1]);}
  if(hi==0)wsf[32+r32]=l_reg;asm volatile("s_waitcnt lgkmcnt(0)":::"memory");
  float rli[16];
  #pragma unroll
  for(int r=0;r<16;++r)rli[r]=__builtin_amdgcn_rcpf(wsf[32+crow(r,hi)]);
  bf16*Ow=O+(rowbase+q0+wid*QBLK)*DMO;
  { bf16*stg=(bf16*)(shm+LDS_OST)+wid*2048;
    #pragma unroll
    for(int r=0;r<16;++r){const int orow=crow(r,hi);
      #pragma unroll
      for(int d0=0;d0<2;++d0)stg[orow*64+d0*32+r32]=__float2bfloat16(o[d0][r]*rli[r]);}
    asm volatile("s_waitcnt lgkmcnt(0)":::"memory");
    #pragma unroll
    for(int i=0;i<4;++i){const int row=i*8+(lane>>3),ch=lane&7; const u32x4 v=*(const u32x4*)(stg+row*64+ch*8); ATTN_STORE16(Ow+(long)row*DMO+ch*8,v);} }
  asm volatile("s_waitcnt lgkmcnt(0)\n\ts_barrier":::"memory");
  #undef DMA_K
  #undef DMA_V
  #undef CMASK
  #undef START
  #undef RESC
  #undef ROT
}
constexpr int ATTN_LDS_BYTES=LDS_BYTES;
#undef SBAR
#undef WAIT_BAR
}


constexpr int NWAVES = 8;
constexpr int NB = 2, T = 4096, NTOK = NB * T, D = 2048, C = 1024, NH = 16, HD = 64;
constexpr int PPITCH = 6656;
constexpr int PC_R = 0, PC_K = 1024, PC_V = 2048, PC_L = 3072, PC_Q = 3584, PC_KA = 4608, PC_VA = 5632;
constexpr int LK = 384;
constexpr int NEXP = 32, DEXP = 512, RMAX = 24576;
constexpr int NPH_LAYER = 11, NPHASES = 1 + 2 * NPH_LAYER;

constexpr size_t MiB = 1u << 20, KiB = 1u << 10;
constexpr size_t WS_CTL = 0, CTL_ZERO_BYTES = 1 * MiB;
constexpr size_t WS_ROPE = 1 * MiB;
constexpr size_t WS_PART = WS_ROPE + 256 * KiB;
constexpr size_t WS_TOKE = WS_PART + 1 * MiB;
constexpr size_t WS_TOKW = WS_TOKE + 64 * KiB;
constexpr size_t WS_TOKR = WS_TOKW + 64 * KiB;
constexpr size_t WS_TOKS = WS_TOKR + 64 * KiB;
constexpr size_t WS_RSTD2 = WS_TOKS + 64 * KiB;
constexpr size_t WS_CNT = WS_RSTD2 + 32 * KiB;
constexpr size_t WS_SRS = WS_CNT + 32 * KiB;
constexpr size_t WS_SWT = WS_SRS + 96 * KiB;
constexpr size_t WS_BONUS = WS_SWT + 96 * KiB;
constexpr size_t WS_RSTD1 = WS_BONUS + 512 * KiB;
constexpr size_t WS_RW = WS_RSTD1 + 32 * KiB;
constexpr size_t WS_SMALL_END = WS_RW + 576 * KiB;
static_assert(WS_SMALL_END <= 4 * MiB, "small tables");
constexpr size_t WS_HBA = 4 * MiB, WS_HBB = WS_HBA + 32 * MiB;
constexpr size_t WS_VFIRST = WS_HBB + 32 * MiB;
constexpr size_t WS_PB = WS_VFIRST + 32 * MiB;
constexpr size_t WS_WIN = WS_PB + 8 * MiB;
constexpr size_t WS_WOUT = WS_WIN + 52 * MiB;
constexpr size_t WS_WPG = WS_WOUT + 16 * MiB;
constexpr size_t WS_WPP = WS_WPG + 16 * MiB;
constexpr size_t WS_WL2 = WS_WPP + 2 * MiB;
constexpr size_t WS_WGU = WS_WL2 + 6 * MiB;
constexpr size_t WS_WD = WS_WGU + 128 * MiB;
constexpr size_t WS_PROJ = WS_WD + 64 * MiB;
constexpr size_t WS_LORAA = WS_PROJ + 104 * MiB;
constexpr size_t WS_LORAO = WS_LORAA + 6 * MiB;
constexpr size_t WS_OB = WS_LORAO + 64 * MiB;
constexpr size_t WS_CONCAT = WS_OB + 32 * MiB;
constexpr size_t WS_PPB = WS_CONCAT + 32 * MiB;
constexpr size_t WS_SCAN = WS_PPB + 32 * MiB;
constexpr size_t WS_Y = WS_SCAN + 192 * MiB;
constexpr size_t WS_ASORT = WS_SCAN;
constexpr size_t WS_HG = WS_ASORT + 96 * MiB;
constexpr size_t WS_OSLOT = WS_HG + 24 * MiB;
constexpr size_t WS_TPS = WS_SCAN + 224 * MiB;
constexpr size_t WS_MOETAB = WS_TPS + 32 * MiB;
constexpr int ECAP = 8192;
constexpr size_t WS_END = WS_MOETAB + 3 * MiB;
constexpr size_t WS_TPQ0 = WS_PPB, WS_TPQ1 = WS_PPB;
constexpr size_t WS_SCIN0 = WS_SCAN, WS_SCIN1 = WS_SCAN;
constexpr size_t WS_SV = WS_SCAN + 160 * MiB;
constexpr size_t WS_TPP = WS_CONCAT, WS_TPZ = WS_CONCAT + 16 * MiB;
static_assert(WS_OSLOT + 96 * MiB <= WS_TPS, "MoE overlay fits the scan region");
constexpr int CW_BAR = 4096;
constexpr size_t WS_ECNT = 768 * KiB;
constexpr size_t WS_JCNT = 772 * KiB;
constexpr size_t WS_SLOTTOK = 640 * KiB;


constexpr int RING_OFF = 0, RING_BYTES = 131072;
constexpr int LDSCTL_OFF = RING_BYTES, MISC_OFF = LDSCTL_OFF + 320;
constexpr int L1FLAG_OFF = LDSCTL_OFF + 512;
constexpr int JDONE_OFF = LDSCTL_OFF + 768;
constexpr int RSTAB_OFF = LDSCTL_OFF + 8192;
constexpr int META_OFF = LDSCTL_OFF + 1024;
constexpr int LDS_BYTES = 147456;
static_assert(attn_body::ATTN_LDS_BYTES <= RING_BYTES, "attention scratch fits the ring");

#define GAS __attribute__((address_space(1)))
#define LAS __attribute__((address_space(3)))
typedef unsigned short bf16;
typedef unsigned v4u __attribute__((ext_vector_type(4)));
typedef unsigned v2u __attribute__((ext_vector_type(2)));
typedef float f32x4 __attribute__((ext_vector_type(4)));
typedef GAS unsigned gu32;
#define RLX_AGENT __ATOMIC_RELAXED, __HIP_MEMORY_SCOPE_AGENT
#define LDS_WAIT() asm volatile("s_waitcnt lgkmcnt(0)" ::: "memory")
__device__ __forceinline__ unsigned f2bf(float f) { unsigned u = __builtin_bit_cast(unsigned, f); return (u + 0x7fffu + ((u >> 16) & 1u)) >> 16; }
__device__ __forceinline__ unsigned pk2(float lo, float hi) { return f2bf(lo) | (f2bf(hi) << 16); }
__device__ __forceinline__ float bflo(unsigned u) { return __builtin_bit_cast(float, u << 16); }
__device__ __forceinline__ float bfhi(unsigned u) { return __builtin_bit_cast(float, u & 0xffff0000u); }
__device__ __forceinline__ float sigmoidf_(float x) { return 1.0f / (1.0f + __expf(-x)); }

#define XB_TMO      128
#define XB_XCNT(j)  (256  + 64 * (j))
#define XB_XSUB(j)  (1280 + 64 * (j))
#define XB_XGEN(j)  (2304 + 64 * (j))
#define XB_TOP      3328
#define XB_TOPGEN   3392
#define XCD_BAR_WORDS 3456
#define XB_SPIN_CAP (1u << 18)

__device__ __forceinline__ unsigned xb_ld(unsigned* p)              { return __hip_atomic_load(p, __ATOMIC_RELAXED, __HIP_MEMORY_SCOPE_AGENT); }
__device__ __forceinline__ unsigned xb_add(unsigned* p, unsigned v) { return __hip_atomic_fetch_add(p, v, __ATOMIC_RELAXED, __HIP_MEMORY_SCOPE_AGENT); }
__device__ __forceinline__ unsigned xb_xcc_id() { return (unsigned)__builtin_amdgcn_s_getreg((3 << 11) | 20) & 0xFu; }
#define XB_SPIN(cond, bar) do { unsigned _sp = 0; while (cond) { __builtin_amdgcn_s_sleep(1); \
    if ((++_sp & 255u) == 0u) { if (xb_ld(&(bar)[XB_TMO])) break; if (_sp > XB_SPIN_CAP) { atomicAdd(&(bar)[XB_TMO], 1u); break; } } } } while (0)

struct XcdBarrier {
    unsigned* bar; unsigned x;
    volatile LAS unsigned* st;
};

__device__ __forceinline__ XcdBarrier xcd_barrier_post(unsigned* bar, volatile LAS unsigned* st) {
    XcdBarrier b; b.bar = bar; b.x = xb_xcc_id(); b.st = st;
    if (threadIdx.x == 0) (void)xb_add(&bar[XB_XCNT(b.x)], 1u);
    return b;
}
__device__ __forceinline__ void xcd_barrier_complete(unsigned* bar, unsigned x, unsigned& nloc, unsigned& nx) {
    const unsigned G = gridDim.x * gridDim.y * gridDim.z;
    unsigned sum, cnt, mine, sp = 0u;
    for (;;) {
        sum = 0u; cnt = 0u; mine = 0u;
#pragma unroll
        for (unsigned j = 0; j < 16; ++j) { const unsigned c = xb_ld(&bar[XB_XCNT(j)]); sum += c; cnt += (c > 0u) ? 1u : 0u; mine = (j == x) ? c : mine; }
        if (sum == G) break;
        __builtin_amdgcn_s_sleep(1);
        if ((++sp & 255u) == 0u) { if (xb_ld(&bar[XB_TMO])) break; if (sp > XB_SPIN_CAP) { atomicAdd(&bar[XB_TMO], 1u); break; } }
    }
    nloc = mine > 0u ? mine : 1u; nx = cnt > 0u ? cnt : 1u;
}

__device__ __forceinline__ void xcd_barrier(const XcdBarrier& b) {
    asm volatile("s_waitcnt vmcnt(0)" ::: "memory");
    __syncthreads();
    if (threadIdx.x == 0) {
        unsigned* bar = b.bar;
        __builtin_amdgcn_s_waitcnt(0);
        unsigned nloc = b.st[0], nx = b.st[1];
        if (nloc == 0u) { xcd_barrier_complete(bar, b.x, nloc, nx); b.st[0] = nloc; b.st[1] = nx; }
        const unsigned old = xb_add(&bar[XB_XSUB(b.x)], 1u);
        const unsigned gen = old / nloc;
        if (old + 1u == (gen + 1u) * nloc) {
            __builtin_amdgcn_fence(__ATOMIC_RELEASE, "agent");
            asm volatile("s_waitcnt vmcnt(0)" ::: "memory");
            const unsigned og = xb_add(&bar[XB_TOP], 1u);
            const unsigned tg = og / nx;
            if (og + 1u == (tg + 1u) * nx) xb_add(&bar[XB_TOPGEN], 1u);
            else XB_SPIN(xb_ld(&bar[XB_TOPGEN]) == tg, bar);
            __builtin_amdgcn_fence(__ATOMIC_ACQUIRE, "agent");
            xb_add(&bar[XB_XGEN(b.x)], 1u);
            asm volatile("s_waitcnt vmcnt(0)" ::: "memory");
        } else {
            XB_SPIN(xb_ld(&bar[XB_XGEN(b.x)]) == gen, bar);
            __builtin_amdgcn_fence(__ATOMIC_ACQUIRE, "agent");
            asm volatile("s_waitcnt vmcnt(0)" ::: "memory");
        }
    }
    __syncthreads();
}


__device__ __forceinline__ int fresh_tid() { int t = threadIdx.x; asm volatile("" : "+v"(t)); return t; }
struct Frame {
    LAS unsigned char* lds;
    int tid, lane, wave, vcu, G;
    unsigned char* ws;
};
extern __shared__ __attribute__((aligned(16))) unsigned char lds_dyn[];
__device__ __forceinline__ Frame mk_frame(unsigned char* ws) {
    Frame F; F.lds = (LAS unsigned char*)lds_dyn; F.tid = fresh_tid(); F.lane = F.tid & 63; F.wave = __builtin_amdgcn_readfirstlane(F.tid >> 6);
    F.G = gridDim.x; { const int bx = blockIdx.x; F.vcu = (F.G % 8 == 0) ? (bx % 8) * (F.G / 8) + bx / 8 : bx; }
    F.ws = ws; return F;
}
template <int CTRL, int RM> __device__ __forceinline__ float dpp_get(float v) { return __int_as_float(__builtin_amdgcn_update_dpp(0, __float_as_int(v), CTRL, RM, 0xf, false)); }
__device__ __forceinline__ float wave_total63(float v) {
    v += dpp_get<0xB1, 0xf>(v);
    v += dpp_get<0x4E, 0xf>(v);
    v += dpp_get<0x141, 0xf>(v);
    v += dpp_get<0x140, 0xf>(v);
    v += dpp_get<0x142, 0xa>(v);
    v += dpp_get<0x143, 0xc>(v);
    return v;
}
__device__ __forceinline__ float wave_bcast63(float v) { return __int_as_float(__builtin_amdgcn_readlane(__float_as_int(v), 63)); }
__device__ __forceinline__ float red16(float v) { v += __shfl_xor(v, 1); v += __shfl_xor(v, 2); v += __shfl_xor(v, 4); v += __shfl_xor(v, 8); return v; }
__device__ __forceinline__ float red32(float v) { v = red16(v); v += __shfl_xor(v, 16); return v; }
__device__ __forceinline__ float red64(float v) { v = red32(v); v += __shfl_xor(v, 32); return v; }

struct ConvItem { const float* W; bf16* WT; const float* gain; int ldw, k0, n0, n_end, Kd, split, shift0, shift1, map; };
__device__ __forceinline__ void conv_load(const ConvItem& p, int lane, f32x4 (&v)[16]) {
    const int kq = lane >> 4, nq = lane & 15, n = p.n0 + nq * 4;
    if (n < p.n_end) { const float* src = p.W + (size_t)(p.k0 + kq * 16) * p.ldw + n;
#pragma unroll
        for (int i = 0; i < 16; ++i) v[i] = *(const f32x4*)(src + (size_t)i * p.ldw); }
}
__device__ __forceinline__ void conv_store(const ConvItem& p, int lane, f32x4 (&v)[16]) {
    const int kq = lane >> 4, nq = lane & 15, n = p.n0 + nq * 4;
    if (n >= p.n_end) return;
    if (p.gain) { const f32x4* gp = (const f32x4*)(p.gain + p.k0 + kq * 16);
#pragma unroll
        for (int i4 = 0; i4 < 4; ++i4) { const f32x4 g = gp[i4];
#pragma unroll
            for (int e = 0; e < 4; ++e) v[4 * i4 + e] = v[4 * i4 + e] * g[e]; } }
#pragma unroll
    for (int e = 0; e < 4; ++e) { const int nn = n + e; const int dr = (p.map == 0) ? nn + ((nn >= p.split) ? p.shift1 : p.shift0) : ((nn >> 7) * 256 + p.shift0 + (nn & 127));
        GAS v4u* dst = (GAS v4u*)(p.WT + (size_t)dr * p.Kd + p.k0 + kq * 16);
        dst[0] = (v4u){pk2(v[0][e], v[1][e]), pk2(v[2][e], v[3][e]), pk2(v[4][e], v[5][e]), pk2(v[6][e], v[7][e])};
        dst[1] = (v4u){pk2(v[8][e], v[9][e]), pk2(v[10][e], v[11][e]), pk2(v[12][e], v[13][e]), pk2(v[14][e], v[15][e])}; }
}
__device__ __forceinline__ void conv_half(const ConvItem& p, int lane, int hf) {
    const int kq = lane >> 4, nq = lane & 15, n = p.n0 + nq * 4;
    if (n >= p.n_end) return;
    const float* src = p.W + (size_t)(p.k0 + kq * 16 + 8 * hf) * p.ldw + n; f32x4 v[8];
#pragma unroll
    for (int i = 0; i < 8; ++i) v[i] = *(const f32x4*)(src + (size_t)i * p.ldw);
    if (p.gain) { const f32x4* gp = (const f32x4*)(p.gain + p.k0 + kq * 16 + 8 * hf);
#pragma unroll
        for (int i4 = 0; i4 < 2; ++i4) { const f32x4 g = gp[i4];
#pragma unroll
            for (int e = 0; e < 4; ++e) v[4 * i4 + e] = v[4 * i4 + e] * g[e]; } }
#pragma unroll
    for (int e = 0; e < 4; ++e) { const int nn = n + e; const int dr = (p.map == 0) ? nn + ((nn >= p.split) ? p.shift1 : p.shift0) : ((nn >> 7) * 256 + p.shift0 + (nn & 127));
        *(GAS v4u*)(p.WT + (size_t)dr * p.Kd + p.k0 + kq * 16 + 8 * hf) = (v4u){pk2(v[0][e], v[1][e]), pk2(v[2][e], v[3][e]), pk2(v[4][e], v[5][e]), pk2(v[6][e], v[7][e])}; }
}
__device__ __forceinline__ void conv_half_load(const ConvItem& p, int lane, int hf, f32x4 (&v)[8]) {
    const int kq = lane >> 4, nq = lane & 15, n = p.n0 + nq * 4;
    if (n < p.n_end) { const float* src = p.W + (size_t)(p.k0 + kq * 16 + 8 * hf) * p.ldw + n;
#pragma unroll
        for (int i = 0; i < 8; ++i) v[i] = *(const f32x4*)(src + (size_t)i * p.ldw); }
}
__device__ __forceinline__ void conv_half_store(const ConvItem& p, int lane, int hf, f32x4 (&v)[8]) {
    const int kq = lane >> 4, nq = lane & 15, n = p.n0 + nq * 4;
    if (n >= p.n_end) return;
    if (p.gain) { const f32x4* gp = (const f32x4*)(p.gain + p.k0 + kq * 16 + 8 * hf);
#pragma unroll
        for (int i4 = 0; i4 < 2; ++i4) { const f32x4 g = gp[i4];
#pragma unroll
            for (int e = 0; e < 4; ++e) v[4 * i4 + e] = v[4 * i4 + e] * g[e]; } }
#pragma unroll
    for (int e = 0; e < 4; ++e) { const int nn = n + e; const int dr = (p.map == 0) ? nn + ((nn >= p.split) ? p.shift1 : p.shift0) : ((nn >> 7) * 256 + p.shift0 + (nn & 127));
        *(GAS v4u*)(p.WT + (size_t)dr * p.Kd + p.k0 + kq * 16 + 8 * hf) = (v4u){pk2(v[0][e], v[1][e]), pk2(v[2][e], v[3][e]), pk2(v[4][e], v[5][e]), pk2(v[6][e], v[7][e])}; }
}
#define CONV_PIPELINE(NIT, GW, NGW_, MK) do { f32x4 va_[16], vb_[16]; ConvItem pa_, pb_; int it_ = (GW); \
    if (it_ < (NIT)) { pa_ = MK(it_); conv_load(pa_, F.lane, va_); } \
    for (; it_ < (NIT); it_ += 2 * (NGW_)) { const int i1_ = it_ + (NGW_), i2_ = it_ + 2 * (NGW_); \
        if (i1_ < (NIT)) { pb_ = MK(i1_); conv_load(pb_, F.lane, vb_); } \
        conv_store(pa_, F.lane, va_); \
        if (i2_ < (NIT)) { pa_ = MK(i2_); conv_load(pa_, F.lane, va_); } \
        if (i1_ < (NIT)) conv_store(pb_, F.lane, vb_); } } while (0)
__device__ __forceinline__ void conv_plain(Frame& F, const float* W, int ldw, int K, int n_lo, int n_hi, bf16* WT, int split, int shift0, int shift1, const float* gain, int gw, int NGW) {
    const int nblk = (n_hi - n_lo + 63) / 64, nit = (K / 64) * nblk;
#define MK_PLAIN(it) (ConvItem{W, WT, gain, ldw, 64 * ((it) / nblk), n_lo + 64 * ((it) % nblk), n_hi, K, split, shift0, shift1, 0})
    CONV_PIPELINE(nit, gw, NGW, MK_PLAIN);
#undef MK_PLAIN
}
__device__ __forceinline__ void zero_rows(Frame& F, bf16* WT, int K, int r0, int r1) {
    const size_t n16 = (size_t)(r1 - r0) * K / 8; GAS v4u* p = (GAS v4u*)(WT + (size_t)r0 * K);
    for (size_t i = (size_t)F.vcu * 512 + F.tid; i < n16; i += (size_t)F.G * 512) p[i] = (v4u){0u, 0u, 0u, 0u};
}
__device__ __forceinline__ ConvItem moe_item(int it, const float* wg, const float* wu, const float* wd, const float* gain, bf16* WGU, bf16* WD) {
    const int e = it / 768, r = it % 768;
    if (r < 512) { const int up = r >> 8, q = r & 255, kb = q >> 3, nb = q & 7;
        return ConvItem{(up ? wu : wg) + (size_t)e * 2048 * 512, WGU + (size_t)e * 1024 * 2048, gain, 512, 64 * kb, 64 * nb, 512, 2048, 0, up * 128, 0, 1}; }
    const int q = r - 512, kb = q >> 5, nb = q & 31;
    return ConvItem{wd + (size_t)e * 512 * 2048, WD + (size_t)e * 2048 * 512, nullptr, 2048, 64 * kb, 64 * nb, 2048, 512, 1 << 30, 0, 0, 0};
}
__device__ __forceinline__ void conv_moe(Frame& F, const float* wg, const float* wu, const float* wd, const float* gain, bf16* WGU, bf16* WD, int gw, int NGW) {
#define MK_MOE(it) moe_item((it), wg, wu, wd, gain, WGU, WD)
    CONV_PIPELINE(32 * 768, gw, NGW, MK_MOE);
#undef MK_MOE
}

struct Args { const float* in[38]; float* out; unsigned char* ws; int ph_lo, ph_hi; };
typedef const __attribute__((address_space(4))) Args* ArgP;
__device__ __forceinline__ ArgP get_args() { ArgP p = (ArgP)__builtin_amdgcn_kernarg_segment_ptr(); asm volatile("" : "+s"(p)); return p; }

__device__ __forceinline__ void p0_prologue(Frame& F, ArgP A) {
    unsigned char* ws = F.ws;
    const int gt = F.vcu * 512 + F.tid, NGT = F.G * 512;
    const int gw = F.vcu * NWAVES + F.wave, NGW = F.G * NWAVES;
    { float* rope = (float*)(ws + WS_ROPE);
      for (int i = gt; i < T * 8; i += NGT) { const int t = i >> 3, j = i & 7; const float inv = powf(500000.0f, -((float)(2 * j) / 16.0f)); const float ang = (float)t * inv;
          rope[t * 16 + j] = cosf(ang); rope[t * 16 + 8 + j] = sinf(ang); } }
    { const float* x = A->in[0]; bf16* hb = (bf16*)(ws + WS_HBA); float* part = (float*)(ws + WS_PART);
      for (int m = gw; m < NTOK; m += NGW) { const GAS f32x4* xr = (const GAS f32x4*)(x + (size_t)m * D); GAS v2u* o = (GAS v2u*)(hb + (size_t)m * D); float ss = 0.f;
#pragma unroll
          for (int j = 0; j < 8; ++j) { const f32x4 v = xr[F.lane + 64 * j]; ss += (v[0] * v[0] + v[1] * v[1]) + (v[2] * v[2] + v[3] * v[3]); o[F.lane + 64 * j] = (v2u){pk2(v[0], v[1]), pk2(v[2], v[3])}; }
          ss = red64(ss);
          if (F.lane < 32) part[(size_t)m * 32 + F.lane] = (F.lane == 0) ? ss : 0.f; } }
    { const GAS f32x4* p = (const GAS f32x4*)A->in[1]; GAS v2u* o = (GAS v2u*)(ws + WS_PB);
      for (int i = gt; i < 2 * NTOK * 256 / 4; i += NGT) { const f32x4 v = p[i]; o[i] = (v2u){pk2(v[0], v[1]), pk2(v[2], v[3])}; } }
    { float* rw = (float*)(ws + WS_RW);
      for (int i = gt; i < 2 * 36 * D; i += NGT) { const int l = i / (36 * D), r = i % (36 * D), row = r / D, k = r % D;
          const float w = (row < 32) ? A->in[30][((size_t)l * D + k) * 32 + row] : A->in[28][((size_t)l * D + k) * 4 + (row - 32)];
          rw[i] = w * A->in[3][l * D + k]; } }
    { bf16* wl2 = (bf16*)(ws + WS_WL2);
      for (int i = gt; i < 2 * 4096 * LK; i += NGT) { const int l = i / (4096 * LK), r = i % (4096 * LK), c = r / LK, j = r % LK, seg = c >> 10, cc = c & 1023; float v = 0.f;
          if (seg == 0 && j < 64) v = A->in[9][(size_t)l * 64 * 1024 + (size_t)j * 1024 + cc];
          else if (seg == 1 && j >= 64 && j < 128) v = A->in[11][(size_t)l * 64 * 1024 + (size_t)(j - 64) * 1024 + cc];
          else if (seg == 2 && j >= 128 && j < 288) v = A->in[12][(size_t)l * 160 * 1024 + (size_t)(j - 128) * 1024 + cc];
          else if (seg == 3 && j >= 288 && j < 320 && l == 1) v = A->in[14][(size_t)(j - 288) * 1024 + cc];
          wl2[i] = (bf16)f2bf(v); } }
    { bf16* w0 = (bf16*)(ws + WS_WIN);
      conv_plain(F, A->in[4], 6432, D, 0, 6432, w0, 3360, 0, 224, A->in[2], gw, NGW);
      zero_rows(F, w0, D, 3360, 3584); }
}

__device__ __forceinline__ void conv_deferred(Frame& F, ArgP A, int gw, int NGW) {
    unsigned char* ws = F.ws;
    { bf16* w1 = (bf16*)(ws + WS_WIN) + (size_t)PPITCH * D;
      conv_plain(F, A->in[5], 6464, D, 0, 6464, w1, 3392, 0, 192, A->in[2] + D, gw, NGW);
      const size_t n16 = (size_t)(3584 - 3392) * D / 8; GAS v4u* p = (GAS v4u*)(w1 + (size_t)3392 * D);
      for (size_t i = (size_t)gw * 64 + F.lane; i < n16; i += (size_t)NGW * 64) p[i] = (v4u){0u, 0u, 0u, 0u}; }
    for (int l = 0; l < 2; ++l) {
        conv_plain(F, A->in[27] + (size_t)l * D * D, D, D, 0, D, (bf16*)(ws + WS_WOUT) + (size_t)l * D * D, 1 << 30, 0, 0, nullptr, gw, NGW);
        conv_plain(F, A->in[35] + (size_t)l * D * D, D, D, 0, D, (bf16*)(ws + WS_WPG) + (size_t)l * D * D, 1 << 30, 0, 0, nullptr, gw, NGW);
        conv_plain(F, A->in[37] + (size_t)l * 256 * D, D, 256, 0, D, (bf16*)(ws + WS_WPP) + (size_t)l * D * 256, 1 << 30, 0, 0, nullptr, gw, NGW);
    }
}

__device__ __forceinline__ void prep1_phase(Frame& F, ArgP A, int layer) {
    unsigned char* ws = F.ws; bf16* proj = (bf16*)(ws + WS_PROJ); bf16* la = (bf16*)(ws + WS_LORAA);
    const float* mu = layer ? A->in[7] : A->in[6];
    const int gt = F.vcu * 512 + F.tid, NGT = F.G * 512;
    const float* LP = (const float*)(ws + WS_LORAO); const float* rstd1 = (const float*)(ws + WS_RSTD1);
    for (int i = gt; i < NTOK * (LK / 2); i += NGT) { const int m = i / (LK / 2), j = (i % (LK / 2)) * 2; float o0 = 0.f, o1 = 0.f;
        if (j < (layer ? 320 : 288)) { float c0 = 0.f, c1 = 0.f, q0 = 0.f, q1 = 0.f; const bool hp = (m & (T - 1)) != 0;
#pragma unroll
            for (int ks = 0; ks < 4; ++ks) { const float* p = LP + ((size_t)ks * NTOK + m) * 512 + j; c0 += p[0]; c1 += p[1]; if (hp) { q0 += p[-512]; q1 += p[-511]; } }
            const float rc = rstd1[m], rp = hp ? rstd1[m - 1] : 0.f;
            c0 = bflo(f2bf(c0 * rc)); c1 = bflo(f2bf(c1 * rc)); q0 = bflo(f2bf(q0 * rp)); q1 = bflo(f2bf(q1 * rp));
            o0 = c0 + (q0 - c0) * mu[3072 + j]; o1 = c1 + (q1 - c1) * mu[3072 + j + 1];
            if (j < 64) { o0 = tanhf(o0); o1 = tanhf(o1); } else if (j >= 128 && j < 288) { o0 = sigmoidf_(o0); o1 = sigmoidf_(o1); } }
        *(GAS unsigned*)(la + (size_t)m * LK + j) = pk2(o0, o1); }
    const float* qg = A->in[20] + layer * 64; const float* kg = A->in[21] + layer * 64; const float* rope = (const float*)(ws + WS_ROPE);
    const int gw = F.vcu * NWAVES + F.wave, NGW = F.G * NWAVES, sub = F.lane & 15;
    for (int m = gw; m < NTOK; m += NGW) { const int t = m & (T - 1);
#pragma unroll
        for (int j = 0; j < 8; ++j) { const int grp = j * 4 + (F.lane >> 4); const bool isq = grp < 16;
            bf16* p = proj + (size_t)m * PPITCH + (isq ? PC_Q + grp * 64 : PC_KA + (grp - 16) * 64) + sub * 4;
            const v2u raw = *(const GAS v2u*)p; float x[4] = {bflo(raw.x), bfhi(raw.x), bflo(raw.y), bfhi(raw.y)};
            const float ss = red16(x[0] * x[0] + x[1] * x[1] + x[2] * x[2] + x[3] * x[3]); const float rs = rsqrtf(ss * (1.0f / 64.0f) + 1e-6f);
            const float* g = isq ? qg : kg;
#pragma unroll
            for (int e = 0; e < 4; ++e) x[e] = x[e] * rs * g[sub * 4 + e];
            float y[4];
#pragma unroll
            for (int e = 0; e < 4; ++e) { const float other = __shfl_xor(x[e], 2); const int ri = (sub & 1) * 4 + e; const float cs = rope[t * 16 + ri], sn = rope[t * 16 + 8 + ri];
                y[e] = (sub < 2) ? (x[e] * cs - other * sn) : ((sub < 4) ? (x[e] * cs + other * sn) : x[e]); }
            const float sc = isq ? attn_body::C2 : 1.0f;
            *(GAS v2u*)p = (v2u){pk2(y[0] * sc, y[1] * sc), pk2(y[2] * sc, y[3] * sc)}; } }
}

constexpr int TP_NC = 32, TP_LC = 128, TP_TB = 4;
typedef float f32x2 __attribute__((ext_vector_type(2)));
#define FMAC_BC(acc, av, s, K) asm("v_fmac_f32_dpp %0, %1, %2 row_newbcast:" #K " row_mask:0xf bank_mask:0xf" : "+v"(acc) : "v"(av), "v"(s))
#define MUL_BC(dst, av, s, K) asm("v_mul_f32_dpp %0, %1, %2 row_newbcast:" #K " row_mask:0xf bank_mask:0xf" : "=v"(dst) : "v"(av), "v"(s))
#define L1_PASS1 FMAC_BC(sar0, aq0, SR[0], 0); FMAC_BC(sai0, aq0, SI[0], 0); \
    FMAC_BC(sar1, aq0, SR[1], 1); FMAC_BC(sai1, aq0, SI[1], 1); \
    FMAC_BC(sar2, aq0, SR[2], 2); FMAC_BC(sai2, aq0, SI[2], 2); \
    FMAC_BC(sar3, aq0, SR[3], 3); FMAC_BC(sai3, aq0, SI[3], 3); \
    FMAC_BC(sar0, aq0, SR[4], 4); FMAC_BC(sai0, aq0, SI[4], 4); \
    FMAC_BC(sar1, aq0, SR[5], 5); FMAC_BC(sai1, aq0, SI[5], 5); \
    FMAC_BC(sar2, aq0, SR[6], 6); FMAC_BC(sai2, aq0, SI[6], 6); \
    FMAC_BC(sar3, aq0, SR[7], 7); FMAC_BC(sai3, aq0, SI[7], 7); \
    FMAC_BC(sar0, aq0, SR[8], 8); FMAC_BC(sai0, aq0, SI[8], 8); \
    FMAC_BC(sar1, aq0, SR[9], 9); FMAC_BC(sai1, aq0, SI[9], 9); \
    FMAC_BC(sar2, aq0, SR[10], 10); FMAC_BC(sai2, aq0, SI[10], 10); \
    FMAC_BC(sar3, aq0, SR[11], 11); FMAC_BC(sai3, aq0, SI[11], 11); \
    FMAC_BC(sar0, aq0, SR[12], 12); FMAC_BC(sai0, aq0, SI[12], 12); \
    FMAC_BC(sar1, aq0, SR[13], 13); FMAC_BC(sai1, aq0, SI[13], 13); \
    FMAC_BC(sar2, aq0, SR[14], 14); FMAC_BC(sai2, aq0, SI[14], 14); \
    FMAC_BC(sar3, aq0, SR[15], 15); FMAC_BC(sai3, aq0, SI[15], 15); \
    FMAC_BC(sar0, aq1, SR[16], 0); FMAC_BC(sai0, aq1, SI[16], 0); \
    FMAC_BC(sar1, aq1, SR[17], 1); FMAC_BC(sai1, aq1, SI[17], 1); \
    FMAC_BC(sar2, aq1, SR[18], 2); FMAC_BC(sai2, aq1, SI[18], 2); \
    FMAC_BC(sar3, aq1, SR[19], 3); FMAC_BC(sai3, aq1, SI[19], 3); \
    FMAC_BC(sar0, aq1, SR[20], 4); FMAC_BC(sai0, aq1, SI[20], 4); \
    FMAC_BC(sar1, aq1, SR[21], 5); FMAC_BC(sai1, aq1, SI[21], 5); \
    FMAC_BC(sar2, aq1, SR[22], 6); FMAC_BC(sai2, aq1, SI[22], 6); \
    FMAC_BC(sar3, aq1, SR[23], 7); FMAC_BC(sai3, aq1, SI[23], 7); \
    FMAC_BC(sar0, aq1, SR[24], 8); FMAC_BC(sai0, aq1, SI[24], 8); \
    FMAC_BC(sar1, aq1, SR[25], 9); FMAC_BC(sai1, aq1, SI[25], 9); \
    FMAC_BC(sar2, aq1, SR[26], 10); FMAC_BC(sai2, aq1, SI[26], 10); \
    FMAC_BC(sar3, aq1, SR[27], 11); FMAC_BC(sai3, aq1, SI[27], 11); \
    FMAC_BC(sar0, aq1, SR[28], 12); FMAC_BC(sai0, aq1, SI[28], 12); \
    FMAC_BC(sar1, aq1, SR[29], 13); FMAC_BC(sai1, aq1, SI[29], 13); \
    FMAC_BC(sar2, aq1, SR[30], 14); FMAC_BC(sai2, aq1, SI[30], 14); \
    FMAC_BC(sar3, aq1, SR[31], 15); FMAC_BC(sai3, aq1, SI[31], 15); \
    FMAC_BC(sar0, aq2, SR[32], 0); FMAC_BC(sai0, aq2, SI[32], 0); \
    FMAC_BC(sar1, aq2, SR[33], 1); FMAC_BC(sai1, aq2, SI[33], 1); \
    FMAC_BC(sar2, aq2, SR[34], 2); FMAC_BC(sai2, aq2, SI[34], 2); \
    FMAC_BC(sar3, aq2, SR[35], 3); FMAC_BC(sai3, aq2, SI[35], 3); \
    FMAC_BC(sar0, aq2, SR[36], 4); FMAC_BC(sai0, aq2, SI[36], 4); \
    FMAC_BC(sar1, aq2, SR[37], 5); FMAC_BC(sai1, aq2, SI[37], 5); \
    FMAC_BC(sar2, aq2, SR[38], 6); FMAC_BC(sai2, aq2, SI[38], 6); \
    FMAC_BC(sar3, aq2, SR[39], 7); FMAC_BC(sai3, aq2, SI[39], 7); \
    FMAC_BC(sar0, aq2, SR[40], 8); FMAC_BC(sai0, aq2, SI[40], 8); \
    FMAC_BC(sar1, aq2, SR[41], 9); FMAC_BC(sai1, aq2, SI[41], 9); \
    FMAC_BC(sar2, aq2, SR[42], 10); FMAC_BC(sai2, aq2, SI[42], 10); \
    FMAC_BC(sar3, aq2, SR[43], 11); FMAC_BC(sai3, aq2, SI[43], 11); \
    FMAC_BC(sar0, aq2, SR[44], 12); FMAC_BC(sai0, aq2, SI[44], 12); \
    FMAC_BC(sar1, aq2, SR[45], 13); FMAC_BC(sai1, aq2, SI[45], 13); \
    FMAC_BC(sar2, aq2, SR[46], 14); FMAC_BC(sai2, aq2, SI[46], 14); \
    FMAC_BC(sar3, aq2, SR[47], 15); FMAC_BC(sai3, aq2, SI[47], 15); \
    FMAC_BC(sar0, aq3, SR[48], 0); FMAC_BC(sai0, aq3, SI[48], 0); \
    FMAC_BC(sar1, aq3, SR[49], 1); FMAC_BC(sai1, aq3, SI[49], 1); \
    FMAC_BC(sar2, aq3, SR[50], 2); FMAC_BC(sai2, aq3, SI[50], 2); \
    FMAC_BC(sar3, aq3, SR[51], 3); FMAC_BC(sai3, aq3, SI[51], 3); \
    FMAC_BC(sar0, aq3, SR[52], 4); FMAC_BC(sai0, aq3, SI[52], 4); \
    FMAC_BC(sar1, aq3, SR[53], 5); FMAC_BC(sai1, aq3, SI[53], 5); \
    FMAC_BC(sar2, aq3, SR[54], 6); FMAC_BC(sai2, aq3, SI[54], 6); \
    FMAC_BC(sar3, aq3, SR[55], 7); FMAC_BC(sai3, aq3, SI[55], 7); \
    FMAC_BC(sar0, aq3, SR[56], 8); FMAC_BC(sai0, aq3, SI[56], 8); \
    FMAC_BC(sar1, aq3, SR[57], 9); FMAC_BC(sai1, aq3, SI[57], 9); \
    FMAC_BC(sar2, aq3, SR[58], 10); FMAC_BC(sai2, aq3, SI[58], 10); \
    FMAC_BC(sar3, aq3, SR[59], 11); FMAC_BC(sai3, aq3, SI[59], 11); \
    FMAC_BC(sar0, aq3, SR[60], 12); FMAC_BC(sai0, aq3, SI[60], 12); \
    FMAC_BC(sar1, aq3, SR[61], 13); FMAC_BC(sai1, aq3, SI[61], 13); \
    FMAC_BC(sar2, aq3, SR[62], 14); FMAC_BC(sai2, aq3, SI[62], 14); \
    FMAC_BC(sar3, aq3, SR[63], 15); FMAC_BC(sai3, aq3, SI[63], 15);
#define L1_PASS2 { float t_, u_; MUL_BC(t_, wq0, SR[0], 0); FMAC_BC(t_, bq0, sar, 0); FMAC_BC(t_, kq0, vcur, 0); SR[0] = t_; FMAC_BC(yr0, rq0, t_, 0); MUL_BC(u_, wq0, SI[0], 0); FMAC_BC(u_, bq0, sai, 0); SI[0] = u_; FMAC_BC(yi0, rq0, u_, 0); } \
    { float t_, u_; MUL_BC(t_, wq0, SR[1], 1); FMAC_BC(t_, bq0, sar, 1); FMAC_BC(t_, kq0, vcur, 1); SR[1] = t_; FMAC_BC(yr1, rq0, t_, 1); MUL_BC(u_, wq0, SI[1], 1); FMAC_BC(u_, bq0, sai, 1); SI[1] = u_; FMAC_BC(yi1, rq0, u_, 1); } \
    { float t_, u_; MUL_BC(t_, wq0, SR[2], 2); FMAC_BC(t_, bq0, sar, 2); FMAC_BC(t_, kq0, vcur, 2); SR[2] = t_; FMAC_BC(yr2, rq0, t_, 2); MUL_BC(u_, wq0, SI[2], 2); FMAC_BC(u_, bq0, sai, 2); SI[2] = u_; FMAC_BC(yi2, rq0, u_, 2); } \
    { float t_, u_; MUL_BC(t_, wq0, SR[3], 3); FMAC_BC(t_, bq0, sar, 3); FMAC_BC(t_, kq0, vcur, 3); SR[3] = t_; FMAC_BC(yr3, rq0, t_, 3); MUL_BC(u_, wq0, SI[3], 3); FMAC_BC(u_, bq0, sai, 3); SI[3] = u_; FMAC_BC(yi3, rq0, u_, 3); } \
    { float t_, u_; MUL_BC(t_, wq0, SR[4], 4); FMAC_BC(t_, bq0, sar, 4); FMAC_BC(t_, kq0, vcur, 4); SR[4] = t_; FMAC_BC(yr0, rq0, t_, 4); MUL_BC(u_, wq0, SI[4], 4); FMAC_BC(u_, bq0, sai, 4); SI[4] = u_; FMAC_BC(yi0, rq0, u_, 4); } \
    { float t_, u_; MUL_BC(t_, wq0, SR[5], 5); FMAC_BC(t_, bq0, sar, 5); FMAC_BC(t_, kq0, vcur, 5); SR[5] = t_; FMAC_BC(yr1, rq0, t_, 5); MUL_BC(u_, wq0, SI[5], 5); FMAC_BC(u_, bq0, sai, 5); SI[5] = u_; FMAC_BC(yi1, rq0, u_, 5); } \
    { float t_, u_; MUL_BC(t_, wq0, SR[6], 6); FMAC_BC(t_, bq0, sar, 6); FMAC_BC(t_, kq0, vcur, 6); SR[6] = t_; FMAC_BC(yr2, rq0, t_, 6); MUL_BC(u_, wq0, SI[6], 6); FMAC_BC(u_, bq0, sai, 6); SI[6] = u_; FMAC_BC(yi2, rq0, u_, 6); } \
    { float t_, u_; MUL_BC(t_, wq0, SR[7], 7); FMAC_BC(t_, bq0, sar, 7); FMAC_BC(t_, kq0, vcur, 7); SR[7] = t_; FMAC_BC(yr3, rq0, t_, 7); MUL_BC(u_, wq0, SI[7], 7); FMAC_BC(u_, bq0, sai, 7); SI[7] = u_; FMAC_BC(yi3, rq0, u_, 7); } \
    { float t_, u_; MUL_BC(t_, wq0, SR[8], 8); FMAC_BC(t_, bq0, sar, 8); FMAC_BC(t_, kq0, vcur, 8); SR[8] = t_; FMAC_BC(yr0, rq0, t_, 8); MUL_BC(u_, wq0, SI[8], 8); FMAC_BC(u_, bq0, sai, 8); SI[8] = u_; FMAC_BC(yi0, rq0, u_, 8); } \
    { float t_, u_; MUL_BC(t_, wq0, SR[9], 9); FMAC_BC(t_, bq0, sar, 9); FMAC_BC(t_, kq0, vcur, 9); SR[9] = t_; FMAC_BC(yr1, rq0, t_, 9); MUL_BC(u_, wq0, SI[9], 9); FMAC_BC(u_, bq0, sai, 9); SI[9] = u_; FMAC_BC(yi1, rq0, u_, 9); } \
    { float t_, u_; MUL_BC(t_, wq0, SR[10], 10); FMAC_BC(t_, bq0, sar, 10); FMAC_BC(t_, kq0, vcur, 10); SR[10] = t_; FMAC_BC(yr2, rq0, t_, 10); MUL_BC(u_, wq0, SI[10], 10); FMAC_BC(u_, bq0, sai, 10); SI[10] = u_; FMAC_BC(yi2, rq0, u_, 10); } \
    { float t_, u_; MUL_BC(t_, wq0, SR[11], 11); FMAC_BC(t_, bq0, sar, 11); FMAC_BC(t_, kq0, vcur, 11); SR[11] = t_; FMAC_BC(yr3, rq0, t_, 11); MUL_BC(u_, wq0, SI[11], 11); FMAC_BC(u_, bq0, sai, 11); SI[11] = u_; FMAC_BC(yi3, rq0, u_, 11); } \
    { float t_, u_; MUL_BC(t_, wq0, SR[12], 12); FMAC_BC(t_, bq0, sar, 12); FMAC_BC(t_, kq0, vcur, 12); SR[12] = t_; FMAC_BC(yr0, rq0, t_, 12); MUL_BC(u_, wq0, SI[12], 12); FMAC_BC(u_, bq0, sai, 12); SI[12] = u_; FMAC_BC(yi0, rq0, u_, 12); } \
    { float t_, u_; MUL_BC(t_, wq0, SR[13], 13); FMAC_BC(t_, bq0, sar, 13); FMAC_BC(t_, kq0, vcur, 13); SR[13] = t_; FMAC_BC(yr1, rq0, t_, 13); MUL_BC(u_, wq0, SI[13], 13); FMAC_BC(u_, bq0, sai, 13); SI[13] = u_; FMAC_BC(yi1, rq0, u_, 13); } \
    { float t_, u_; MUL_BC(t_, wq0, SR[14], 14); FMAC_BC(t_, bq0, sar, 14); FMAC_BC(t_, kq0, vcur, 14); SR[14] = t_; FMAC_BC(yr2, rq0, t_, 14); MUL_BC(u_, wq0, SI[14], 14); FMAC_BC(u_, bq0, sai, 14); SI[14] = u_; FMAC_BC(yi2, rq0, u_, 14); } \
    { float t_, u_; MUL_BC(t_, wq0, SR[15], 15); FMAC_BC(t_, bq0, sar, 15); FMAC_BC(t_, kq0, vcur, 15); SR[15] = t_; FMAC_BC(yr3, rq0, t_, 15); MUL_BC(u_, wq0, SI[15], 15); FMAC_BC(u_, bq0, sai, 15); SI[15] = u_; FMAC_BC(yi3, rq0, u_, 15); } \
    { float t_, u_; MUL_BC(t_, wq1, SR[16], 0); FMAC_BC(t_, bq1, sar, 0); FMAC_BC(t_, kq1, vcur, 0); SR[16] = t_; FMAC_BC(yr0, rq1, t_, 0); MUL_BC(u_, wq1, SI[16], 0); FMAC_BC(u_, bq1, sai, 0); SI[16] = u_; FMAC_BC(yi0, rq1, u_, 0); } \
    { float t_, u_; MUL_BC(t_, wq1, SR[17], 1); FMAC_BC(t_, bq1, sar, 1); FMAC_BC(t_, kq1, vcur, 1); SR[17] = t_; FMAC_BC(yr1, rq1, t_, 1); MUL_BC(u_, wq1, SI[17], 1); FMAC_BC(u_, bq1, sai, 1); SI[17] = u_; FMAC_BC(yi1, rq1, u_, 1); } \
    { float t_, u_; MUL_BC(t_, wq1, SR[18], 2); FMAC_BC(t_, bq1, sar, 2); FMAC_BC(t_, kq1, vcur, 2); SR[18] = t_; FMAC_BC(yr2, rq1, t_, 2); MUL_BC(u_, wq1, SI[18], 2); FMAC_BC(u_, bq1, sai, 2); SI[18] = u_; FMAC_BC(yi2, rq1, u_, 2); } \
    { float t_, u_; MUL_BC(t_, wq1, SR[19], 3); FMAC_BC(t_, bq1, sar, 3); FMAC_BC(t_, kq1, vcur, 3); SR[19] = t_; FMAC_BC(yr3, rq1, t_, 3); MUL_BC(u_, wq1, SI[19], 3); FMAC_BC(u_, bq1, sai, 3); SI[19] = u_; FMAC_BC(yi3, rq1, u_, 3); } \
    { float t_, u_; MUL_BC(t_, wq1, SR[20], 4); FMAC_BC(t_, bq1, sar, 4); FMAC_BC(t_, kq1, vcur, 4); SR[20] = t_; FMAC_BC(yr0, rq1, t_, 4); MUL_BC(u_, wq1, SI[20], 4); FMAC_BC(u_, bq1, sai, 4); SI[20] = u_; FMAC_BC(yi0, rq1, u_, 4); } \
    { float t_, u_; MUL_BC(t_, wq1, SR[21], 5); FMAC_BC(t_, bq1, sar, 5); FMAC_BC(t_, kq1, vcur, 5); SR[21] = t_; FMAC_BC(yr1, rq1, t_, 5); MUL_BC(u_, wq1, SI[21], 5); FMAC_BC(u_, bq1, sai, 5); SI[21] = u_; FMAC_BC(yi1, rq1, u_, 5); } \
    { float t_, u_; MUL_BC(t_, wq1, SR[22], 6); FMAC_BC(t_, bq1, sar, 6); FMAC_BC(t_, kq1, vcur, 6); SR[22] = t_; FMAC_BC(yr2, rq1, t_, 6); MUL_BC(u_, wq1, SI[22], 6); FMAC_BC(u_, bq1, sai, 6); SI[22] = u_; FMAC_BC(yi2, rq1, u_, 6); } \
    { float t_, u_; MUL_BC(t_, wq1, SR[23], 7); FMAC_BC(t_, bq1, sar, 7); FMAC_BC(t_, kq1, vcur, 7); SR[23] = t_; FMAC_BC(yr3, rq1, t_, 7); MUL_BC(u_, wq1, SI[23], 7); FMAC_BC(u_, bq1, sai, 7); SI[23] = u_; FMAC_BC(yi3, rq1, u_, 7); } \
    { float t_, u_; MUL_BC(t_, wq1, SR[24], 8); FMAC_BC(t_, bq1, sar, 8); FMAC_BC(t_, kq1, vcur, 8); SR[24] = t_; FMAC_BC(yr0, rq1, t_, 8); MUL_BC(u_, wq1, SI[24], 8); FMAC_BC(u_, bq1, sai, 8); SI[24] = u_; FMAC_BC(yi0, rq1, u_, 8); } \
    { float t_, u_; MUL_BC(t_, wq1, SR[25], 9); FMAC_BC(t_, bq1, sar, 9); FMAC_BC(t_, kq1, vcur, 9); SR[25] = t_; FMAC_BC(yr1, rq1, t_, 9); MUL_BC(u_, wq1, SI[25], 9); FMAC_BC(u_, bq1, sai, 9); SI[25] = u_; FMAC_BC(yi1, rq1, u_, 9); } \
    { float t_, u_; MUL_BC(t_, wq1, SR[26], 10); FMAC_BC(t_, bq1, sar, 10); FMAC_BC(t_, kq1, vcur, 10); SR[26] = t_; FMAC_BC(yr2, rq1, t_, 10); MUL_BC(u_, wq1, SI[26], 10); FMAC_BC(u_, bq1, sai, 10); SI[26] = u_; FMAC_BC(yi2, rq1, u_, 10); } \
    { float t_, u_; MUL_BC(t_, wq1, SR[27], 11); FMAC_BC(t_, bq1, sar, 11); FMAC_BC(t_, kq1, vcur, 11); SR[27] = t_; FMAC_BC(yr3, rq1, t_, 11); MUL_BC(u_, wq1, SI[27], 11); FMAC_BC(u_, bq1, sai, 11); SI[27] = u_; FMAC_BC(yi3, rq1, u_, 11); } \
    { float t_, u_; MUL_BC(t_, wq1, SR[28], 12); FMAC_BC(t_, bq1, sar, 12); FMAC_BC(t_, kq1, vcur, 12); SR[28] = t_; FMAC_BC(yr0, rq1, t_, 12); MUL_BC(u_, wq1, SI[28], 12); FMAC_BC(u_, bq1, sai, 12); SI[28] = u_; FMAC_BC(yi0, rq1, u_, 12); } \
    { float t_, u_; MUL_BC(t_, wq1, SR[29], 13); FMAC_BC(t_, bq1, sar, 13); FMAC_BC(t_, kq1, vcur, 13); SR[29] = t_; FMAC_BC(yr1, rq1, t_, 13); MUL_BC(u_, wq1, SI[29], 13); FMAC_BC(u_, bq1, sai, 13); SI[29] = u_; FMAC_BC(yi1, rq1, u_, 13); } \
    { float t_, u_; MUL_BC(t_, wq1, SR[30], 14); FMAC_BC(t_, bq1, sar, 14); FMAC_BC(t_, kq1, vcur, 14); SR[30] = t_; FMAC_BC(yr2, rq1, t_, 14); MUL_BC(u_, wq1, SI[30], 14); FMAC_BC(u_, bq1, sai, 14); SI[30] = u_; FMAC_BC(yi2, rq1, u_, 14); } \
    { float t_, u_; MUL_BC(t_, wq1, SR[31], 15); FMAC_BC(t_, bq1, sar, 15); FMAC_BC(t_, kq1, vcur, 15); SR[31] = t_; FMAC_BC(yr3, rq1, t_, 15); MUL_BC(u_, wq1, SI[31], 15); FMAC_BC(u_, bq1, sai, 15); SI[31] = u_; FMAC_BC(yi3, rq1, u_, 15); } \
    { float t_, u_; MUL_BC(t_, wq2, SR[32], 0); FMAC_BC(t_, bq2, sar, 0); FMAC_BC(t_, kq2, vcur, 0); SR[32] = t_; FMAC_BC(yr0, rq2, t_, 0); MUL_BC(u_, wq2, SI[32], 0); FMAC_BC(u_, bq2, sai, 0); SI[32] = u_; FMAC_BC(yi0, rq2, u_, 0); } \
    { float t_, u_; MUL_BC(t_, wq2, SR[33], 1); FMAC_BC(t_, bq2, sar, 1); FMAC_BC(t_, kq2, vcur, 1); SR[33] = t_; FMAC_BC(yr1, rq2, t_, 1); MUL_BC(u_, wq2, SI[33], 1); FMAC_BC(u_, bq2, sai, 1); SI[33] = u_; FMAC_BC(yi1, rq2, u_, 1); } \
    { float t_, u_; MUL_BC(t_, wq2, SR[34], 2); FMAC_BC(t_, bq2, sar, 2); FMAC_BC(t_, kq2, vcur, 2); SR[34] = t_; FMAC_BC(yr2, rq2, t_, 2); MUL_BC(u_, wq2, SI[34], 2); FMAC_BC(u_, bq2, sai, 2); SI[34] = u_; FMAC_BC(yi2, rq2, u_, 2); } \
    { float t_, u_; MUL_BC(t_, wq2, SR[35], 3); FMAC_BC(t_, bq2, sar, 3); FMAC_BC(t_, kq2, vcur, 3); SR[35] = t_; FMAC_BC(yr3, rq2, t_, 3); MUL_BC(u_, wq2, SI[35], 3); FMAC_BC(u_, bq2, sai, 3); SI[35] = u_; FMAC_BC(yi3, rq2, u_, 3); } \
    { float t_, u_; MUL_BC(t_, wq2, SR[36], 4); FMAC_BC(t_, bq2, sar, 4); FMAC_BC(t_, kq2, vcur, 4); SR[36] = t_; FMAC_BC(yr0, rq2, t_, 4); MUL_BC(u_, wq2, SI[36], 4); FMAC_BC(u_, bq2, sai, 4); SI[36] = u_; FMAC_BC(yi0, rq2, u_, 4); } \
    { float t_, u_; MUL_BC(t_, wq2, SR[37], 5); FMAC_BC(t_, bq2, sar, 5); FMAC_BC(t_, kq2, vcur, 5); SR[37] = t_; FMAC_BC(yr1, rq2, t_, 5); MUL_BC(u_, wq2, SI[37], 5); FMAC_BC(u_, bq2, sai, 5); SI[37] = u_; FMAC_BC(yi1, rq2, u_, 5); } \
    { float t_, u_; MUL_BC(t_, wq2, SR[38], 6); FMAC_BC(t_, bq2, sar, 6); FMAC_BC(t_, kq2, vcur, 6); SR[38] = t_; FMAC_BC(yr2, rq2, t_, 6); MUL_BC(u_, wq2, SI[38], 6); FMAC_BC(u_, bq2, sai, 6); SI[38] = u_; FMAC_BC(yi2, rq2, u_, 6); } \
    { float t_, u_; MUL_BC(t_, wq2, SR[39], 7); FMAC_BC(t_, bq2, sar, 7); FMAC_BC(t_, kq2, vcur, 7); SR[39] = t_; FMAC_BC(yr3, rq2, t_, 7); MUL_BC(u_, wq2, SI[39], 7); FMAC_BC(u_, bq2, sai, 7); SI[39] = u_; FMAC_BC(yi3, rq2, u_, 7); } \
    { float t_, u_; MUL_BC(t_, wq2, SR[40], 8); FMAC_BC(t_, bq2, sar, 8); FMAC_BC(t_, kq2, vcur, 8); SR[40] = t_; FMAC_BC(yr0, rq2, t_, 8); MUL_BC(u_, wq2, SI[40], 8); FMAC_BC(u_, bq2, sai, 8); SI[40] = u_; FMAC_BC(yi0, rq2, u_, 8); } \
    { float t_, u_; MUL_BC(t_, wq2, SR[41], 9); FMAC_BC(t_, bq2, sar, 9); FMAC_BC(t_, kq2, vcur, 9); SR[41] = t_; FMAC_BC(yr1, rq2, t_, 9); MUL_BC(u_, wq2, SI[41], 9); FMAC_BC(u_, bq2, sai, 9); SI[41] = u_; FMAC_BC(yi1, rq2, u_, 9); } \
    { float t_, u_; MUL_BC(t_, wq2, SR[42], 10); FMAC_BC(t_, bq2, sar, 10); FMAC_BC(t_, kq2, vcur, 10); SR[42] = t_; FMAC_BC(yr2, rq2, t_, 10); MUL_BC(u_, wq2, SI[42], 10); FMAC_BC(u_, bq2, sai, 10); SI[42] = u_; FMAC_BC(yi2, rq2, u_, 10); } \
    { float t_, u_; MUL_BC(t_, wq2, SR[43], 11); FMAC_BC(t_, bq2, sar, 11); FMAC_BC(t_, kq2, vcur, 11); SR[43] = t_; FMAC_BC(yr3, rq2, t_, 11); MUL_BC(u_, wq2, SI[43], 11); FMAC_BC(u_, bq2, sai, 11); SI[43] = u_; FMAC_BC(yi3, rq2, u_, 11); } \
    { float t_, u_; MUL_BC(t_, wq2, SR[44], 12); FMAC_BC(t_, bq2, sar, 12); FMAC_BC(t_, kq2, vcur, 12); SR[44] = t_; FMAC_BC(yr0, rq2, t_, 12); MUL_BC(u_, wq2, SI[44], 12); FMAC_BC(u_, bq2, sai, 12); SI[44] = u_; FMAC_BC(yi0, rq2, u_, 12); } \
    { float t_, u_; MUL_BC(t_, wq2, SR[45], 13); FMAC_BC(t_, bq2, sar, 13); FMAC_BC(t_, kq2, vcur, 13); SR[45] = t_; FMAC_BC(yr1, rq2, t_, 13); MUL_BC(u_, wq2, SI[45], 13); FMAC_BC(u_, bq2, sai, 13); SI[45] = u_; FMAC_BC(yi1, rq2, u_, 13); } \
    { float t_, u_; MUL_BC(t_, wq2, SR[46], 14); FMAC_BC(t_, bq2, sar, 14); FMAC_BC(t_, kq2, vcur, 14); SR[46] = t_; FMAC_BC(yr2, rq2, t_, 14); MUL_BC(u_, wq2, SI[46], 14); FMAC_BC(u_, bq2, sai, 14); SI[46] = u_; FMAC_BC(yi2, rq2, u_, 14); } \
    { float t_, u_; MUL_BC(t_, wq2, SR[47], 15); FMAC_BC(t_, bq2, sar, 15); FMAC_BC(t_, kq2, vcur, 15); SR[47] = t_; FMAC_BC(yr3, rq2, t_, 15); MUL_BC(u_, wq2, SI[47], 15); FMAC_BC(u_, bq2, sai, 15); SI[47] = u_; FMAC_BC(yi3, rq2, u_, 15); } \
    { float t_, u_; MUL_BC(t_, wq3, SR[48], 0); FMAC_BC(t_, bq3, sar, 0); FMAC_BC(t_, kq3, vcur, 0); SR[48] = t_; FMAC_BC(yr0, rq3, t_, 0); MUL_BC(u_, wq3, SI[48], 0); FMAC_BC(u_, bq3, sai, 0); SI[48] = u_; FMAC_BC(yi0, rq3, u_, 0); } \
    { float t_, u_; MUL_BC(t_, wq3, SR[49], 1); FMAC_BC(t_, bq3, sar, 1); FMAC_BC(t_, kq3, vcur, 1); SR[49] = t_; FMAC_BC(yr1, rq3, t_, 1); MUL_BC(u_, wq3, SI[49], 1); FMAC_BC(u_, bq3, sai, 1); SI[49] = u_; FMAC_BC(yi1, rq3, u_, 1); } \
    { float t_, u_; MUL_BC(t_, wq3, SR[50], 2); FMAC_BC(t_, bq3, sar, 2); FMAC_BC(t_, kq3, vcur, 2); SR[50] = t_; FMAC_BC(yr2, rq3, t_, 2); MUL_BC(u_, wq3, SI[50], 2); FMAC_BC(u_, bq3, sai, 2); SI[50] = u_; FMAC_BC(yi2, rq3, u_, 2); } \
    { float t_, u_; MUL_BC(t_, wq3, SR[51], 3); FMAC_BC(t_, bq3, sar, 3); FMAC_BC(t_, kq3, vcur, 3); SR[51] = t_; FMAC_BC(yr3, rq3, t_, 3); MUL_BC(u_, wq3, SI[51], 3); FMAC_BC(u_, bq3, sai, 3); SI[51] = u_; FMAC_BC(yi3, rq3, u_, 3); } \
    { float t_, u_; MUL_BC(t_, wq3, SR[52], 4); FMAC_BC(t_, bq3, sar, 4); FMAC_BC(t_, kq3, vcur, 4); SR[52] = t_; FMAC_BC(yr0, rq3, t_, 4); MUL_BC(u_, wq3, SI[52], 4); FMAC_BC(u_, bq3, sai, 4); SI[52] = u_; FMAC_BC(yi0, rq3, u_, 4); } \
    { float t_, u_; MUL_BC(t_, wq3, SR[53], 5); FMAC_BC(t_, bq3, sar, 5); FMAC_BC(t_, kq3, vcur, 5); SR[53] = t_; FMAC_BC(yr1, rq3, t_, 5); MUL_BC(u_, wq3, SI[53], 5); FMAC_BC(u_, bq3, sai, 5); SI[53] = u_; FMAC_BC(yi1, rq3, u_, 5); } \
    { float t_, u_; MUL_BC(t_, wq3, SR[54], 6); FMAC_BC(t_, bq3, sar, 6); FMAC_BC(t_, kq3, vcur, 6); SR[54] = t_; FMAC_BC(yr2, rq3, t_, 6); MUL_BC(u_, wq3, SI[54], 6); FMAC_BC(u_, bq3, sai, 6); SI[54] = u_; FMAC_BC(yi2, rq3, u_, 6); } \
    { float t_, u_; MUL_BC(t_, wq3, SR[55], 7); FMAC_BC(t_, bq3, sar, 7); FMAC_BC(t_, kq3, vcur, 7); SR[55] = t_; FMAC_BC(yr3, rq3, t_, 7); MUL_BC(u_, wq3, SI[55], 7); FMAC_BC(u_, bq3, sai, 7); SI[55] = u_; FMAC_BC(yi3, rq3, u_, 7); } \
    { float t_, u_; MUL_BC(t_, wq3, SR[56], 8); FMAC_BC(t_, bq3, sar, 8); FMAC_BC(t_, kq3, vcur, 8); SR[56] = t_; FMAC_BC(yr0, rq3, t_, 8); MUL_BC(u_, wq3, SI[56], 8); FMAC_BC(u_, bq3, sai, 8); SI[56] = u_; FMAC_BC(yi0, rq3, u_, 8); } \
    { float t_, u_; MUL_BC(t_, wq3, SR[57], 9); FMAC_BC(t_, bq3, sar, 9); FMAC_BC(t_, kq3, vcur, 9); SR[57] = t_; FMAC_BC(yr1, rq3, t_, 9); MUL_BC(u_, wq3, SI[57], 9); FMAC_BC(u_, bq3, sai, 9); SI[57] = u_; FMAC_BC(yi1, rq3, u_, 9); } \
    { float t_, u_; MUL_BC(t_, wq3, SR[58], 10); FMAC_BC(t_, bq3, sar, 10); FMAC_BC(t_, kq3, vcur, 10); SR[58] = t_; FMAC_BC(yr2, rq3, t_, 10); MUL_BC(u_, wq3, SI[58], 10); FMAC_BC(u_, bq3, sai, 10); SI[58] = u_; FMAC_BC(yi2, rq3, u_, 10); } \
    { float t_, u_; MUL_BC(t_, wq3, SR[59], 11); FMAC_BC(t_, bq3, sar, 11); FMAC_BC(t_, kq3, vcur, 11); SR[59] = t_; FMAC_BC(yr3, rq3, t_, 11); MUL_BC(u_, wq3, SI[59], 11); FMAC_BC(u_, bq3, sai, 11); SI[59] = u_; FMAC_BC(yi3, rq3, u_, 11); } \
    { float t_, u_; MUL_BC(t_, wq3, SR[60], 12); FMAC_BC(t_, bq3, sar, 12); FMAC_BC(t_, kq3, vcur, 12); SR[60] = t_; FMAC_BC(yr0, rq3, t_, 12); MUL_BC(u_, wq3, SI[60], 12); FMAC_BC(u_, bq3, sai, 12); SI[60] = u_; FMAC_BC(yi0, rq3, u_, 12); } \
    { float t_, u_; MUL_BC(t_, wq3, SR[61], 13); FMAC_BC(t_, bq3, sar, 13); FMAC_BC(t_, kq3, vcur, 13); SR[61] = t_; FMAC_BC(yr1, rq3, t_, 13); MUL_BC(u_, wq3, SI[61], 13); FMAC_BC(u_, bq3, sai, 13); SI[61] = u_; FMAC_BC(yi1, rq3, u_, 13); } \
    { float t_, u_; MUL_BC(t_, wq3, SR[62], 14); FMAC_BC(t_, bq3, sar, 14); FMAC_BC(t_, kq3, vcur, 14); SR[62] = t_; FMAC_BC(yr2, rq3, t_, 14); MUL_BC(u_, wq3, SI[62], 14); FMAC_BC(u_, bq3, sai, 14); SI[62] = u_; FMAC_BC(yi2, rq3, u_, 14); } \
    { float t_, u_; MUL_BC(t_, wq3, SR[63], 15); FMAC_BC(t_, bq3, sar, 15); FMAC_BC(t_, kq3, vcur, 15); SR[63] = t_; FMAC_BC(yr3, rq3, t_, 15); MUL_BC(u_, wq3, SI[63], 15); FMAC_BC(u_, bq3, sai, 15); SI[63] = u_; FMAC_BC(yi3, rq3, u_, 15); }
#define L3_DOT FMAC_BC(a0, qq0, R[0], 0); \
    FMAC_BC(a1, qq0, R[1], 1); \
    FMAC_BC(a2, qq0, R[2], 2); \
    FMAC_BC(a3, qq0, R[3], 3); \
    FMAC_BC(a0, qq0, R[4], 4); \
    FMAC_BC(a1, qq0, R[5], 5); \
    FMAC_BC(a2, qq0, R[6], 6); \
    FMAC_BC(a3, qq0, R[7], 7); \
    FMAC_BC(a0, qq0, R[8], 8); \
    FMAC_BC(a1, qq0, R[9], 9); \
    FMAC_BC(a2, qq0, R[10], 10); \
    FMAC_BC(a3, qq0, R[11], 11); \
    FMAC_BC(a0, qq0, R[12], 12); \
    FMAC_BC(a1, qq0, R[13], 13); \
    FMAC_BC(a2, qq0, R[14], 14); \
    FMAC_BC(a3, qq0, R[15], 15); \
    FMAC_BC(a0, qq1, R[16], 0); \
    FMAC_BC(a1, qq1, R[17], 1); \
    FMAC_BC(a2, qq1, R[18], 2); \
    FMAC_BC(a3, qq1, R[19], 3); \
    FMAC_BC(a0, qq1, R[20], 4); \
    FMAC_BC(a1, qq1, R[21], 5); \
    FMAC_BC(a2, qq1, R[22], 6); \
    FMAC_BC(a3, qq1, R[23], 7); \
    FMAC_BC(a0, qq1, R[24], 8); \
    FMAC_BC(a1, qq1, R[25], 9); \
    FMAC_BC(a2, qq1, R[26], 10); \
    FMAC_BC(a3, qq1, R[27], 11); \
    FMAC_BC(a0, qq1, R[28], 12); \
    FMAC_BC(a1, qq1, R[29], 13); \
    FMAC_BC(a2, qq1, R[30], 14); \
    FMAC_BC(a3, qq1, R[31], 15); \
    FMAC_BC(a0, qq2, R[32], 0); \
    FMAC_BC(a1, qq2, R[33], 1); \
    FMAC_BC(a2, qq2, R[34], 2); \
    FMAC_BC(a3, qq2, R[35], 3); \
    FMAC_BC(a0, qq2, R[36], 4); \
    FMAC_BC(a1, qq2, R[37], 5); \
    FMAC_BC(a2, qq2, R[38], 6); \
    FMAC_BC(a3, qq2, R[39], 7); \
    FMAC_BC(a0, qq2, R[40], 8); \
    FMAC_BC(a1, qq2, R[41], 9); \
    FMAC_BC(a2, qq2, R[42], 10); \
    FMAC_BC(a3, qq2, R[43], 11); \
    FMAC_BC(a0, qq2, R[44], 12); \
    FMAC_BC(a1, qq2, R[45], 13); \
    FMAC_BC(a2, qq2, R[46], 14); \
    FMAC_BC(a3, qq2, R[47], 15); \
    FMAC_BC(a0, qq3, R[48], 0); \
    FMAC_BC(a1, qq3, R[49], 1); \
    FMAC_BC(a2, qq3, R[50], 2); \
    FMAC_BC(a3, qq3, R[51], 3); \
    FMAC_BC(a0, qq3, R[52], 4); \
    FMAC_BC(a1, qq3, R[53], 5); \
    FMAC_BC(a2, qq3, R[54], 6); \
    FMAC_BC(a3, qq3, R[55], 7); \
    FMAC_BC(a0, qq3, R[56], 8); \
    FMAC_BC(a1, qq3, R[57], 9); \
    FMAC_BC(a2, qq3, R[58], 10); \
    FMAC_BC(a3, qq3, R[59], 11); \
    FMAC_BC(a0, qq3, R[60], 12); \
    FMAC_BC(a1, qq3, R[61], 13); \
    FMAC_BC(a2, qq3, R[62], 14); \
    FMAC_BC(a3, qq3, R[63], 15);

__device__ __forceinline__ ConvItem any_item(int it, ArgP A, unsigned char* ws, int layer) {
    if (it < 32 * 768) return moe_item(it, A->in[32] + (size_t)layer * 32 * 2048 * 512, A->in[33] + (size_t)layer * 32 * 2048 * 512, A->in[34] + (size_t)layer * 32 * 512 * 2048, A->in[3] + layer * D, (bf16*)(ws + WS_WGU), (bf16*)(ws + WS_WD));
    it -= 32 * 768;
    if (it < 32 * 101) return ConvItem{A->in[5], (bf16*)(ws + WS_WIN) + (size_t)PPITCH * D, A->in[2] + D, 6464, 64 * (it / 101), 64 * (it % 101), 6464, D, 3392, 0, 192, 0};
    it -= 32 * 101;
    if (it < 2048) { const int l = it >> 10, q = it & 1023; return ConvItem{A->in[27] + (size_t)l * D * D, (bf16*)(ws + WS_WOUT) + (size_t)l * D * D, nullptr, D, 64 * (q >> 5), 64 * (q & 31), D, D, 1 << 30, 0, 0, 0}; }
    it -= 2048;
    if (it < 2048) { const int l = it >> 10, q = it & 1023; return ConvItem{A->in[35] + (size_t)l * D * D, (bf16*)(ws + WS_WPG) + (size_t)l * D * D, nullptr, D, 64 * (q >> 5), 64 * (q & 31), D, D, 1 << 30, 0, 0, 0}; }
    it -= 2048;
    { const int l = it >> 7, q = it & 127; return ConvItem{A->in[37] + (size_t)l * 256 * D, (bf16*)(ws + WS_WPP) + (size_t)l * D * 256, nullptr, D, 64 * (q >> 5), 64 * (q & 31), D, 256, 1 << 30, 0, 0, 0}; }
}
constexpr int N_CONV_L0 = 32 * 768 + 32 * 101 + 2048 + 2048 + 256, N_CONV_L1 = 32 * 768;
__device__ __forceinline__ void tp_level1_producer(Frame& F, ArgP A, int layer) {
    unsigned char* ws = F.ws;
    const int lane = F.lane, slot = F.wave & 3; const bool producer = F.wave >= 4;
    constexpr int BUFB = TP_TB * 1280 + TP_TB * 256, NB = TP_LC / TP_TB;
    LAS unsigned char* wl = F.lds + RING_OFF + slot * (2 * BUFB); LAS int* fl = (LAS int*)(F.lds + L1FLAG_OFF);
    const int nconv = layer ? N_CONV_L1 : N_CONV_L0; int cit = F.vcu * 4 + slot; const int cstep = F.G * 4;
    const int nrounds = (32 * TP_NC + F.G * 4 - 1) / (F.G * 4);
#pragma unroll 1
    for (int rd = 0; rd < nrounds; ++rd) {
        const int u = (rd * F.G + F.vcu) * 4 + slot; const bool act = u < 32 * TP_NC;
        __syncthreads(); if (F.tid < 8) fl[F.tid] = 0; __syncthreads();
        const int bh = act ? (u >> 5) : 0, c = u & 31, b = bh >> 4, h = bh & 15; const size_t m0 = (size_t)b * T + (size_t)c * TP_LC; const int col = h * 64, ch = col + lane;
            const bf16* proj = (const bf16*)(ws + WS_PROJ); const bf16* lo = (const bf16*)(ws + WS_LORAO); float* SV = (float*)(ws + WS_SV); float* vfirst = (float*)(ws + WS_VFIRST); float* bonus = (float*)(ws + WS_BONUS);
            const float* mu = layer ? A->in[7] : A->in[6];
            const float p_w0 = A->in[8][layer * C + ch], p_a0 = A->in[10][layer * C + ch], p_v0 = layer ? A->in[13][ch] : 0.f, p_kk = A->in[15][layer * C + ch], p_ka = A->in[16][layer * C + ch], p_rk = A->in[17][layer * C + ch];
            const float mu_r = mu[ch], mu_k = mu[1024 + ch], mu_v = mu[2048 + ch];
#define L1_LOADRAW(blk, raw, vfr) do { _Pragma("unroll") for (int s2 = 0; s2 < TP_TB; ++s2) { const size_t m = m0 + (size_t)(blk) * TP_TB + s2; const bool hp = (m & (T - 1)) != 0; const bf16* pr = proj + m * PPITCH + ch; \
                    raw[s2][0] = pr[PC_R]; raw[s2][1] = pr[PC_K]; raw[s2][2] = pr[PC_V]; raw[s2][3] = hp ? pr[PC_R - PPITCH] : (bf16)0; raw[s2][4] = hp ? pr[PC_K - PPITCH] : (bf16)0; raw[s2][5] = hp ? pr[PC_V - PPITCH] : (bf16)0; \
                    raw[s2][6] = lo[m * 4096 + ch]; raw[s2][7] = lo[m * 4096 + 1024 + ch]; raw[s2][8] = lo[m * 4096 + 3072 + ch]; vfr[s2] = layer ? vfirst[m * C + ch] : 0.f; } } while (0)
#define L1_PRODUCE(blk, raw, vfr) do { LAS unsigned char* lw_ = wl + ((blk) & 1) * BUFB; \
                _Pragma("unroll") for (int s2 = 0; s2 < TP_TB; ++s2) { const size_t m = m0 + (size_t)(blk) * TP_TB + s2; \
                    const float r_c = bflo((unsigned)raw[s2][0]), k_c = bflo((unsigned)raw[s2][1]), v_c = bflo((unsigned)raw[s2][2]), r_p = bflo((unsigned)raw[s2][3]), k_p = bflo((unsigned)raw[s2][4]), v_p = bflo((unsigned)raw[s2][5]); \
                    const float lw = bflo((unsigned)raw[s2][6]), la = bflo((unsigned)raw[s2][7]), lv = bflo((unsigned)raw[s2][8]); const float vf = vfr[s2]; \
                    const float xr = r_c + (r_p - r_c) * mu_r, xk = k_c + (k_p - k_c) * mu_k, xv = v_c + (v_p - v_c) * mu_v; \
                    const float zz = -(p_w0 + lw); const float sp = fmaxf(zz, 0.f) + log1pf(__expf(-fabsf(zz))); const float dec = __expf(-__expf(-sp - 0.5f)); \
                    const float av = sigmoidf_(p_a0 + la); const float vv = layer ? xv + (vf - xv) * sigmoidf_(p_v0 + lv) : xv; \
                    const float kkn = xk * p_kk; const float k2 = xk * (1.0f + (av - 1.0f) * p_ka); \
                    const float ssq = wave_bcast63(wave_total63(kkn * kkn)), bs = wave_bcast63(wave_total63(xr * k2 * p_rk)); \
                    const float kn = kkn * (1.0f / fmaxf(sqrtf(ssq), 1e-12f)); \
                    LAS float* ls_ = (LAS float*)(lw_ + s2 * 1280) + lane; ls_[0] = -kn; ls_[64] = dec; ls_[128] = kn * av; ls_[192] = k2; ls_[256] = xr; \
                    ((LAS float*)(lw_ + TP_TB * 1280 + s2 * 256))[lane] = vv; \
                    SV[m * C + ch] = vv; if (!layer) vfirst[m * C + ch] = xv; if (lane == 0) bonus[m * 16 + h] = bs; __builtin_amdgcn_sched_barrier(0); } } while (0)
            bf16 rawa[TP_TB][9], rawb[TP_TB][9]; float vfa[TP_TB], vfb[TP_TB];
#define L1_ITER(n_, RC, VC, RN, VN) do { f32x4 cv[16]; ConvItem it; const bool hc = cit < nconv; \
                if (hc) { it = any_item(cit, A, ws, layer); conv_load(it, lane, cv); }        \
                if (act) { if ((n_) + 1 < NB) L1_LOADRAW((n_) + 1, RN, VN); __builtin_amdgcn_sched_barrier(0); \
                    if ((n_) >= 2) { while (*(volatile LAS int*)(fl + 4 + slot) < (n_) - 1) __builtin_amdgcn_s_sleep(2); asm volatile("" ::: "memory"); } \
                    L1_PRODUCE(n_, RC, VC); \
                    asm volatile("s_waitcnt lgkmcnt(0)" ::: "memory"); if (lane == 0) *(volatile LAS int*)(fl + slot) = (n_) + 1; } \
                if (hc) { conv_store(it, lane, cv); cit += cstep; } } while (0)
            if (act) L1_LOADRAW(0, rawa, vfa);
#pragma unroll 1
            for (int n = 0; n < NB; n += 2) { L1_ITER(n, rawa, vfa, rawb, vfb); L1_ITER(n + 1, rawb, vfb, rawa, vfa); }
#undef L1_ITER
#undef L1_LOADRAW
#undef L1_PRODUCE
    }
    { for (; cit < nconv; cit += cstep) { const ConvItem it = any_item(cit, A, ws, layer); conv_half(it, lane, 0); conv_half(it, lane, 1); }
        if (!layer) { bf16* w1 = (bf16*)(ws + WS_WIN) + (size_t)PPITCH * D; const size_t n16 = (size_t)(3584 - 3392) * D / 8; GAS v4u* p = (GAS v4u*)(w1 + (size_t)3392 * D);
            for (size_t i = (size_t)(F.vcu * 4 + slot) * 64 + lane; i < n16; i += (size_t)cstep * 64) p[i] = (v4u){0u, 0u, 0u, 0u}; } }
}

__device__ __forceinline__ void tp_level1_consumer(Frame& F, ArgP A, int layer) {
    unsigned char* ws = F.ws;
    const int lane = F.lane, slot = F.wave & 3; const bool producer = F.wave >= 4;
    constexpr int BUFB = TP_TB * 1280 + TP_TB * 256, NB = TP_LC / TP_TB;
    LAS unsigned char* wl = F.lds + RING_OFF + slot * (2 * BUFB); LAS int* fl = (LAS int*)(F.lds + L1FLAG_OFF);
    const int nconv = layer ? N_CONV_L1 : N_CONV_L0; int cit = F.vcu * 4 + slot; const int cstep = F.G * 4;
    const int nrounds = (32 * TP_NC + F.G * 4 - 1) / (F.G * 4);
#pragma unroll 1
    for (int rd = 0; rd < nrounds; ++rd) {
        const int u = (rd * F.G + F.vcu) * 4 + slot; const bool act = u < 32 * TP_NC;
        __syncthreads(); if (F.tid < 8) fl[F.tid] = 0; __syncthreads();
        const int bh = act ? (u >> 5) : 0, c = u & 31, b = bh >> 4, h = bh & 15; const size_t m0 = (size_t)b * T + (size_t)c * TP_LC; const int col = h * 64, ch = col + lane;
            float* Yout = (float*)(ws + WS_Y); float* Qout = (float*)(ws + (layer ? WS_TPQ1 : WS_TPQ0)); float* Zout = (float*)(ws + WS_TPZ); float* Pout = (float*)(ws + WS_TPP);
            float SR[64], SI[64]; int ln = lane; asm volatile("" : "+v"(ln));
#pragma unroll
            for (int k = 0; k < 64; ++k) { SR[k] = 0.f; SI[k] = (k == ln) ? 1.f : 0.f; }
            const int l16 = (lane & 15) * 4;
#pragma unroll 1
            for (int n = 0; n < NB; ++n) {
                if (act) { const size_t mb = m0 + (size_t)n * TP_TB; const LAS unsigned char* lb = wl + (n & 1) * BUFB;
                    while (*(volatile LAS int*)(fl + slot) < n + 1) __builtin_amdgcn_s_sleep(2);
                    asm volatile("" ::: "memory");
#pragma unroll
                    for (int s2 = 0; s2 < TP_TB; ++s2) {
                        const LAS unsigned char* ls = lb + s2 * 1280 + l16;
#define LDQ(arr, q) (*(const LAS float*)(ls + (arr) * 256 + (q) * 64))
                        const float aq0 = LDQ(0, 0), aq1 = LDQ(0, 1), aq2 = LDQ(0, 2), aq3 = LDQ(0, 3), wq0 = LDQ(1, 0), wq1 = LDQ(1, 1), wq2 = LDQ(1, 2), wq3 = LDQ(1, 3);
                        const float bq0 = LDQ(2, 0), bq1 = LDQ(2, 1), bq2 = LDQ(2, 2), bq3 = LDQ(2, 3), kq0 = LDQ(3, 0), kq1 = LDQ(3, 1), kq2 = LDQ(3, 2), kq3 = LDQ(3, 3);
                        const float rq0 = LDQ(4, 0), rq1 = LDQ(4, 1), rq2 = LDQ(4, 2), rq3 = LDQ(4, 3);
#undef LDQ
                        const float vcur = *(const LAS float*)(lb + TP_TB * 1280 + s2 * 256 + lane * 4);
                        float sar0 = 0.f, sar1 = 0.f, sar2 = 0.f, sar3 = 0.f, sai0 = 0.f, sai1 = 0.f, sai2 = 0.f, sai3 = 0.f;
                        L1_PASS1
                        const float sar = (sar0 + sar1) + (sar2 + sar3), sai = (sai0 + sai1) + (sai2 + sai3);
                        float yr0 = 0.f, yr1 = 0.f, yr2 = 0.f, yr3 = 0.f, yi0 = 0.f, yi1 = 0.f, yi2 = 0.f, yi3 = 0.f;
                        L1_PASS2
                        Yout[(mb + s2) * C + col + lane] = (yr0 + yr1) + (yr2 + yr3);
                        Qout[((size_t)bh * T + (size_t)c * TP_LC + n * TP_TB + s2) * 64 + lane] = (yi0 + yi1) + (yi2 + yi3);
                    }
                    asm volatile("s_waitcnt lgkmcnt(0)" ::: "memory"); if (lane == 0) *(volatile LAS int*)(fl + 4 + slot) = n + 1; } }
            if (act) {
#pragma unroll
                for (int k = 0; k < 64; ++k) { const size_t zo = (((size_t)bh * TP_NC + c) * 64 + k) * 64 + lane;
                    Zout[zo] = SR[k]; Pout[zo] = SI[k]; } }
    }
}

__device__ __forceinline__ void tp_level1_fused(Frame& F, ArgP A, int layer) {
    if (F.wave >= 4) tp_level1_producer(F, A, layer); else tp_level1_consumer(F, A, layer);
}

__device__ __forceinline__ void tp_level2(Frame& F, int layer) {
    unsigned char* ws = F.ws; const float* TPP = (const float*)(ws + WS_TPP); const float* TPZ = (const float*)(ws + WS_TPZ); float* SC = (float*)(ws + WS_TPS + (layer ? 16 * MiB : 0));
    LAS float* PL = (LAS float*)(F.lds + RING_OFF);
    for (int u = F.vcu; u < 256; u += F.G) { const int bh = u >> 3, v = (u & 7) * 8 + F.wave;
        float S = 0.f; SC[(((size_t)bh * TP_NC + 0) * 64 + v) * 64 + F.lane] = 0.f;
        float pa[8], pb[8], za, zb;
#define L2_LOAD(P_, Z_, c_) do { Z_ = TPZ[(((size_t)bh * TP_NC + (c_)) * 64 + F.lane) * 64 + v]; \
            _Pragma("unroll") for (int q = 0; q < 8; ++q) P_[q] = TPP[((size_t)bh * TP_NC + (c_)) * 4096 + F.tid + 512 * q]; } while (0)
#define L2_STEP(P_, Z_, c_) do { LAS float* Pc = PL + ((c_) & 1) * (64 * 65); \
            _Pragma("unroll") for (int q = 0; q < 8; ++q) { const int idx = F.tid + 512 * q; Pc[(idx >> 6) * 65 + (idx & 63)] = P_[q]; } \
            const float z = Z_; \
            __syncthreads(); \
            if ((c_) + 2 < TP_NC - 1) L2_LOAD(P_, Z_, (c_) + 2); \
            float a0 = z, a1 = 0.f, a2 = 0.f, a3 = 0.f; const LAS float* prow = Pc + F.lane * 65; \
            _Pragma("unroll") for (int i = 0; i < 64; i += 4) { \
                a0 = fmaf(__int_as_float(__builtin_amdgcn_readlane(__float_as_int(S), i)), prow[i], a0); a1 = fmaf(__int_as_float(__builtin_amdgcn_readlane(__float_as_int(S), i + 1)), prow[i + 1], a1); \
                a2 = fmaf(__int_as_float(__builtin_amdgcn_readlane(__float_as_int(S), i + 2)), prow[i + 2], a2); a3 = fmaf(__int_as_float(__builtin_amdgcn_readlane(__float_as_int(S), i + 3)), prow[i + 3], a3); } \
            S = (a0 + a1) + (a2 + a3); SC[(((size_t)bh * TP_NC + (c_) + 1) * 64 + v) * 64 + F.lane] = S; } while (0)
        L2_LOAD(pa, za, 0); L2_LOAD(pb, zb, 1);
#pragma unroll 1
        for (int c = 0; c + 1 < TP_NC; c += 2) { L2_STEP(pa, za, c); if (c + 2 < TP_NC) L2_STEP(pb, zb, c + 1); }
#undef L2_LOAD
#undef L2_STEP
        __syncthreads();
    }
}
__device__ __forceinline__ void tp_level3_post(Frame& F, ArgP A, int layer) {
    unsigned char* ws = F.ws; const float* SC = (const float*)(ws + WS_TPS + (layer ? 16 * MiB : 0)); const float* Q = (const float*)(ws + (layer ? WS_TPQ1 : WS_TPQ0)); const float* Y = (const float*)(ws + WS_Y);
    const float* SV = (const float*)(ws + WS_SV); const bf16* lo = (const bf16*)(ws + WS_LORAO); const float* bonus = (const float*)(ws + WS_BONUS); bf16* cc = (bf16*)(ws + WS_CONCAT);
    const float* gng = A->in[18] + layer * C; const float* gnb = A->in[19] + layer * C;
    const int lane = F.lane; constexpr int TB3 = 8, NB3 = 64 / TB3;
    LAS unsigned char* wl = F.lds + RING_OFF + F.wave * (2 * TB3 * 256);
    const int half = F.wave >> 2;
#pragma unroll 1
    for (int u = F.vcu * 4 + (F.wave & 3); u < 32 * TP_NC; u += F.G * 4) { const int bh = u >> 5, c = u & 31; const bool corr = c != 0;
        float R[64];
        if (corr) { const f32x4* rp = (const f32x4*)(SC + (((size_t)bh * TP_NC + c) * 64 + lane) * 64);
#pragma unroll
            for (int i = 0; i < 16; ++i) { const f32x4 x = rp[i]; R[4 * i] = x[0]; R[4 * i + 1] = x[1]; R[4 * i + 2] = x[2]; R[4 * i + 3] = x[3]; } }
        else {
#pragma unroll
            for (int i = 0; i < 64; ++i) R[i] = 0.f; }
        const int l16 = (lane & 15) * 4;
        const int b = bh >> 4, h = bh & 15, col = h * 64 + lane; const size_t m0 = (size_t)b * T + (size_t)c * TP_LC + half * 64; const float* qb = Q + ((size_t)bh * T + (size_t)c * TP_LC + half * 64) * 64;
        const float gg = gng[col], gb = gnb[col];
        int vz; asm volatile("v_mov_b32 %0, 0" : "=v"(vz));
        float ya[TB3], va[TB3], ga[TB3], ba[TB3], yb[TB3], vb[TB3], gbv[TB3], bb[TB3];
#define L3_LOADV(Y_, V_, G_, B_, n_) do { _Pragma("unroll") for (int s2 = 0; s2 < TB3; ++s2) { const size_t m = m0 + (size_t)(n_) * TB3 + s2; Y_[s2] = Y[m * C + col]; V_[s2] = SV[m * C + col]; G_[s2] = bflo((unsigned)lo[m * 4096 + 2048 + col]); B_[s2] = bonus[m * 16 + h + vz]; } } while (0)
#define L3_DMA(n_) do { LAS unsigned char* lw_ = wl + ((n_) & 1) * (TB3 * 256); _Pragma("unroll") for (int i = 0; i < 2; ++i) __builtin_amdgcn_global_load_lds((const unsigned*)(qb + (size_t)(n_) * TB3 * 64 + i * 256 + lane * 4), (LAS unsigned*)(lw_ + i * 1024), 16, 0, 0); } while (0)
#define L3_BLOCK(Y_, V_, G_, B_, Yn_, Vn_, Gn_, Bn_, n_) do { \
            if ((n_) + 1 < NB3) L3_LOADV(Yn_, Vn_, Gn_, Bn_, (n_) + 1); \
              \
            if ((n_) == 0) asm volatile("s_waitcnt vmcnt(32)" ::: "memory"); else if ((n_) + 1 < NB3) asm volatile("s_waitcnt vmcnt(40)" ::: "memory"); else asm volatile("s_waitcnt vmcnt(8)" ::: "memory"); \
            if ((n_) + 1 < NB3) L3_DMA((n_) + 1); \
            const LAS unsigned char* lb = wl + ((n_) & 1) * (TB3 * 256); const size_t mb = m0 + (size_t)(n_) * TB3; \
            _Pragma("unroll") for (int s2 = 0; s2 < TB3; ++s2) { const LAS unsigned char* lq_ = lb + s2 * 256 + l16; float a0 = 0.f, a1 = 0.f, a2 = 0.f, a3 = 0.f; \
                if (corr) { const float qq0 = *(const LAS float*)(lq_), qq1 = *(const LAS float*)(lq_ + 64), qq2 = *(const LAS float*)(lq_ + 128), qq3 = *(const LAS float*)(lq_ + 192); L3_DOT } \
                const float y = Y_[s2] + ((a0 + a1) + (a2 + a3)); \
                const float mean = wave_bcast63(wave_total63(y)) * (1.0f / 64.0f); const float d = y - mean; const float var = wave_bcast63(wave_total63(d * d)) * (1.0f / 64.0f); const float rs = rsqrtf(var + 64e-5f); \
                const float o = (d * rs * gg + gb + B_[s2] * V_[s2]) * G_[s2]; \
                cc[(mb + s2) * 2048 + col] = (bf16)f2bf(o); } } while (0)
        asm volatile("s_waitcnt vmcnt(0)" ::: "memory");
        L3_LOADV(ya, va, ga, ba, 0); L3_DMA(0);
#pragma unroll 1
        for (int n = 0; n < NB3; n += 2) { L3_BLOCK(ya, va, ga, ba, yb, vb, gbv, bb, n); L3_BLOCK(yb, vb, gbv, bb, ya, va, ga, ba, n + 1); }
#undef L3_LOADV
#undef L3_DMA
#undef L3_BLOCK
    }
}
__device__ __forceinline__ f32x4 ld_bf4(const bf16* p) { const v2u r = *(const GAS v2u*)p; return (f32x4){bflo(r.x), bfhi(r.x), bflo(r.y), bfhi(r.y)}; }
__device__ __forceinline__ void post_attn(Frame& F, ArgP A, int layer) {
    unsigned char* ws = F.ws; bf16* cc = (bf16*)(ws + WS_CONCAT); const bf16* ob = (const bf16*)(ws + WS_OB); const float* sg = A->in[26] + layer * 128;
    const float lam_init = layer ? (0.8f - 0.6f * 0.74081822068171788f) : 0.2f;
    const float s1 = red64(A->in[22][layer * 64 + F.lane] * A->in[23][layer * 64 + F.lane]), s2 = red64(A->in[24][layer * 64 + F.lane] * A->in[25][layer * 64 + F.lane]);
    const float lam = expf(s1) - expf(s2) + lam_init;
    const int gw = F.vcu * NWAVES + F.wave, NGW = F.G * NWAVES;
    for (int m = gw; m < NTOK; m += NGW) {
#pragma unroll
        for (int j = 0; j < 4; ++j) { const int hd = j * 2 + (F.lane >> 5), e0 = (F.lane & 31) * 4; const size_t o = (size_t)m * 1024 + hd * 128 + e0;
            const f32x4 o0 = ld_bf4(ob + o), o1 = ld_bf4(ob + (size_t)NTOK * 1024 + o); const f32x4 d = o0 - o1 * lam;
            const float ss = red32((d[0] * d[0] + d[1] * d[1]) + (d[2] * d[2] + d[3] * d[3])); const float rs = rsqrtf(ss * (1.0f / 128.0f) + 1e-6f) * (1.0f - lam_init);
            const f32x4 gv = *(const f32x4*)(sg + e0);
            *(GAS v2u*)(cc + (size_t)m * 2048 + 1024 + hd * 128 + e0) = (v2u){pk2(d[0] * rs * gv[0], d[1] * rs * gv[1]), pk2(d[2] * rs * gv[2], d[3] * rs * gv[3])}; }
    }
}

__device__ __forceinline__ void attn_phase_all(Frame& F, char* ldsc) {
    unsigned char* ws = F.ws; const attn_body::bf16* proj = (const attn_body::bf16*)(ws + WS_PROJ); attn_body::bf16* ob = (attn_body::bf16*)(ws + WS_OB);
    const int per = (F.G == 256) ? 4 : 0;
    for (int i = 0;; ++i) { int inst, qb;
        if (per) { if (i >= 4) break; const int s = F.vcu & 3; inst = F.vcu >> 2; qb = (i == 0) ? 15 - s : (i == 1) ? 8 + s : (i == 2) ? 7 - s : s; }
        else { const int L = i * F.G + F.vcu; if (L >= 1024) break; inst = L >> 4; qb = 15 - (L & 15); }
        const int b = inst >> 5, h = (inst >> 2) & 7, c = (inst >> 1) & 1, e = inst & 1;
        attn_body::attn_unit<8>(b, qb, proj + PC_Q + h * 128 + c * 64, proj + PC_KA + h * 128 + c * 64, proj + PC_VA + h * 128 + e * 64, ob + (size_t)c * NTOK * 1024 + h * 128 + e * 64, ldsc);
    }
}

typedef float f32x16 __attribute__((ext_vector_type(16)));
__device__ __forceinline__ void router_phase(Frame& F, ArgP A, int layer, const bf16* hcur) {
    unsigned char* ws = F.ws;
    const float* rw = (const float*)(ws + WS_RW) + (size_t)layer * 36 * D; const float* brg = A->in[29] + layer * 4; const float* bre = A->in[31] + layer * 32;
    int* toks = (int*)(ws + WS_TOKS); int* ecnt = (int*)(ws + WS_ECNT) + layer * 32; int* etok = (int*)(ws + WS_MOETAB); float* ers = (float*)(ws + WS_MOETAB + 1 * MiB); float* ewt = (float*)(ws + WS_MOETAB + 2 * MiB);
    LAS int* lbase = (LAS int*)(F.lds + RING_OFF + 100 * 1024);
    constexpr int ST = 260;
    LAS float* HS = (LAS float*)(F.lds + RING_OFF);
    LAS float* WT = (LAS float*)(F.lds + RING_OFF + 33280);
    LAS float* RED = (LAS float*)(F.lds + RING_OFF);
    LAS float* GRED = (LAS float*)(F.lds + RING_OFF + 73728);
    LAS float* lg = (LAS float*)(F.lds + RING_OFF + 90 * 1024);
    const int tok = F.tid & 31, ks = F.tid >> 5, r32 = F.lane & 31, hi = F.lane >> 5;
    for (int tile = F.vcu; tile < NTOK / 32; tile += F.G) { const int m0 = tile * 32;
        f32x16 acc = (f32x16){0.f, 0.f, 0.f, 0.f, 0.f, 0.f, 0.f, 0.f, 0.f, 0.f, 0.f, 0.f, 0.f, 0.f, 0.f, 0.f}; float g0 = 0.f, g1 = 0.f, g2 = 0.f, g3 = 0.f, ssq = 0.f;
        v2u ph[4]; f32x4 pw[5];
#define RT_LOAD(kc_) do { const int k0_ = (kc_) * 256; \
            _Pragma("unroll") for (int q = 0; q < 4; ++q) { const int idx = F.tid + 512 * q, row = idx >> 6, c4 = idx & 63; ph[q] = *(const GAS v2u*)(hcur + (size_t)(m0 + row) * D + k0_ + c4 * 4); } \
            _Pragma("unroll") for (int q = 0; q < 5; ++q) { const int idx = F.tid + 512 * q; if (idx < 36 * 64) { const int row = idx >> 6, c4 = idx & 63; pw[q] = *(const f32x4*)(rw + (size_t)row * D + k0_ + c4 * 4); } } } while (0)
        RT_LOAD(0);
#pragma unroll 1
        for (int kc = 0; kc < 8; ++kc) {
            __syncthreads();
#pragma unroll
            for (int q = 0; q < 4; ++q) { const int idx = F.tid + 512 * q, row = idx >> 6, c4 = idx & 63; *(LAS f32x4*)(HS + row * ST + c4 * 4) = (f32x4){bflo(ph[q].x), bfhi(ph[q].x), bflo(ph[q].y), bfhi(ph[q].y)}; }
#pragma unroll
            for (int q = 0; q < 5; ++q) { const int idx = F.tid + 512 * q; if (idx < 36 * 64) { const int row = idx >> 6, c4 = idx & 63; *(LAS f32x4*)(WT + row * ST + c4 * 4) = pw[q]; } }
            __syncthreads();
            if (kc + 1 < 8) RT_LOAD(kc + 1);
#pragma unroll
            for (int q = 0; q < 4; ++q) { const int kb = 32 * F.wave + 8 * q + 4 * hi; const f32x4 a4 = *(const LAS f32x4*)(HS + r32 * ST + kb), b4 = *(const LAS f32x4*)(WT + r32 * ST + kb);
#pragma unroll
                for (int e = 0; e < 4; ++e) acc = __builtin_amdgcn_mfma_f32_32x32x2f32(a4[e], b4[e], acc, 0, 0, 0); }
#pragma unroll
            for (int q = 0; q < 4; ++q) { const int kb = 16 * ks + 4 * q; const f32x4 x4 = *(const LAS f32x4*)(HS + tok * ST + kb);
                const f32x4 w0 = *(const LAS f32x4*)(WT + 32 * ST + kb), w1 = *(const LAS f32x4*)(WT + 33 * ST + kb), w2 = *(const LAS f32x4*)(WT + 34 * ST + kb), w3 = *(const LAS f32x4*)(WT + 35 * ST + kb);
#pragma unroll
                for (int e = 0; e < 4; ++e) { g0 = fmaf(x4[e], w0[e], g0); g1 = fmaf(x4[e], w1[e], g1); g2 = fmaf(x4[e], w2[e], g2); g3 = fmaf(x4[e], w3[e], g3); ssq = fmaf(x4[e], x4[e], ssq); } }
        }
#undef RT_LOAD
        __syncthreads();
#pragma unroll
        for (int r = 0; r < 16; ++r) RED[(F.wave * 32 + (r & 3) + 8 * (r >> 2) + 4 * hi) * 33 + r32] = acc[r];
        { LAS float* gp = GRED + (ks * 32 + tok) * 5; gp[0] = g0; gp[1] = g1; gp[2] = g2; gp[3] = g3; gp[4] = ssq; }
        __syncthreads();
        for (int idx = F.tid; idx < 1024; idx += 512) { const int i = idx >> 5, j = idx & 31; float sum = 0.f;
#pragma unroll
            for (int w = 0; w < 8; ++w) sum += RED[(w * 32 + i) * 33 + j];
            lg[i * 40 + 4 + j] = sum; }
        if (F.tid < 160) { const int tk = F.tid / 5, c = F.tid % 5; float sum = 0.f;
#pragma unroll
            for (int q = 0; q < 16; ++q) sum += GRED[(q * 32 + tk) * 5 + c];
            lg[tk * 40 + (c < 4 ? c : 36)] = sum; }
        __syncthreads();
        if (F.wave == 0) { const bool act = F.lane < 32; const int tk = F.lane & 31; const int m = m0 + tk;
            const float rs = rsqrtf(lg[tk * 40 + 36] * (1.0f / 2048.0f) + 1e-6f);
            float l0 = lg[tk * 40 + 0] * rs + brg[0], l1 = lg[tk * 40 + 1] * rs + brg[1], l2 = lg[tk * 40 + 2] * rs + brg[2], l3 = lg[tk * 40 + 3] * rs + brg[3];
            int grp = 0; float lm = l0; if (l1 > lm) { lm = l1; grp = 1; } if (l2 > lm) { lm = l2; grp = 2; } if (l3 > lm) { lm = l3; grp = 3; }
            const float gp = 1.0f / (__expf(l0 - lm) + __expf(l1 - lm) + __expf(l2 - lm) + __expf(l3 - lm));
            int i1 = 0, i2 = 0; float b1 = -3.0e38f, b2 = -3.0e38f;
#pragma unroll
            for (int q = 0; q < 8; ++q) { const float v = lg[tk * 40 + 4 + grp * 8 + q] * rs + bre[grp * 8 + q];
                if (v > b1) { b2 = b1; i2 = i1; b1 = v; i1 = q; } else if (v > b2) { b2 = v; i2 = q; } }
            const float ex = __expf(b2 - b1); const float p1 = 1.0f / (1.0f + ex), p2 = ex / (1.0f + ex);
            const int e1 = grp * 8 + i1, e2 = grp * 8 + i2; int r1 = 0, r2 = 0, mycnt = 0;
            const unsigned long long lt = (1ull << tk) - 1ull;
#pragma unroll 1
            for (int e = 0; e < 32; ++e) { const unsigned long long bm = __ballot(act && (e1 == e || e2 == e)) & 0xffffffffull;
                if (e1 == e) r1 = __popcll(bm & lt); if (e2 == e) r2 = __popcll(bm & lt); if (tk == e) mycnt = __popcll(bm); }
            int mybase = 0; if (act && mycnt > 0) mybase = atomicAdd(ecnt + tk, mycnt);
            if (act) lbase[tk] = mybase; asm volatile("s_waitcnt lgkmcnt(0)" ::: "memory");
            if (act) { const int x1 = e1 * ECAP + lbase[e1] + r1, x2 = e2 * ECAP + lbase[e2] + r2;
                toks[m * 2] = x1; toks[m * 2 + 1] = x2; etok[x1] = m; etok[x2] = m; ers[x1] = rs; ers[x2] = rs; ewt[x1] = gp * p1; ewt[x2] = gp * p2; }
        }
    }
}

__device__ __forceinline__ void moe_meta(Frame& F, int layer) {
    LAS int* meta = (LAS int*)(F.lds + META_OFF); LAS int* tot = meta, *tbase = meta + 32, *tile_e = meta + 97, *ntl = meta + 193;
    const int* ecnt = (const int*)(F.ws + WS_ECNT) + layer * 32;
    __syncthreads();
    if (F.tid < 32) tot[F.tid] = ecnt[F.tid];
    __syncthreads();
    if (F.tid == 0) { int nt = 0; for (int e = 0; e < 32; ++e) { tbase[e] = nt; const int np = (tot[e] + 255) >> 8; for (int q = 0; q < np; ++q) tile_e[nt++] = e; } tbase[32] = nt; *ntl = nt; }
    __syncthreads();
}
__device__ __forceinline__ void combine_phase(Frame& F, const bf16* hsrc, bf16* hbdst, int layer) {
    moe_meta(F, layer);
    unsigned char* ws = F.ws; const int* toks = (const int*)(ws + WS_TOKS); const bf16* os = (const bf16*)(ws + WS_OSLOT); LAS int* tbase = (LAS int*)(F.lds + META_OFF) + 32;
    const int gw = F.vcu * NWAVES + F.wave, NGW = F.G * NWAVES;
    for (int m = gw; m < NTOK; m += NGW) { const int x0 = toks[m * 2], x1 = toks[m * 2 + 1]; const int s0 = tbase[x0 / ECAP] * 256 + (x0 % ECAP), s1 = tbase[x1 / ECAP] * 256 + (x1 % ECAP);
#pragma unroll
        for (int p = 0; p < 4; ++p) { const int c0 = (F.lane + 64 * p) * 8; const v4u a = *(const GAS v4u*)(os + (size_t)s0 * D + c0), b = *(const GAS v4u*)(os + (size_t)s1 * D + c0), g = *(const GAS v4u*)(hsrc + (size_t)m * D + c0);
            *(GAS v4u*)(hbdst + (size_t)m * D + c0) = (v4u){pk2(bflo(g.x) + (bflo(a.x) + bflo(b.x)), bfhi(g.x) + (bfhi(a.x) + bfhi(b.x))), pk2(bflo(g.y) + (bflo(a.y) + bflo(b.y)), bfhi(g.y) + (bfhi(a.y) + bfhi(b.y))),
                                                             pk2(bflo(g.z) + (bflo(a.z) + bflo(b.z)), bfhi(g.z) + (bfhi(a.z) + bfhi(b.z))), pk2(bflo(g.w) + (bflo(a.w) + bflo(b.w)), bfhi(g.w) + (bfhi(a.w) + bfhi(b.w)))}; } }
}

#ifndef PHMASK
#define PHMASK 0x1FFF
#endif
#define PHBIT(k) ((k) == 0 ? 0 : (((k) - 1) % NPH_LAYER) + 1)
#define IN(k) (lo <= (k) && (k) < hi && ((PHMASK >> PHBIT(k)) & 1))
#define SEAM(k) do { if (IN(k) && IN((k) + 1)) { ArgP A_ = get_args(); XcdBarrier b_; b_.bar = (unsigned*)(A_->ws + WS_CTL) + CW_BAR; b_.x = xb_xcc_id(); b_.st = (volatile LAS unsigned*)((LAS unsigned char*)lds_dyn + MISC_OFF) + 8; xcd_barrier(b_); } } while (0)
#define PHASE_BEGIN ArgP A = get_args(); unsigned char* ws = A->ws; Frame F = mk_frame(ws);
#ifndef PROBE_SET
#define PROBE_SET 0
#endif
#ifndef PROBE_MULT
#define PROBE_MULT 4
#endif
#define PRB_ON(bit) ((PROBE_SET >> (bit)) & 1)
#define PRB_T0(bit) unsigned long long prb_t0_ = 0; if (PRB_ON(bit)) prb_t0_ = __builtin_amdgcn_s_memrealtime();
#define PRB_T1(bit) if (PRB_ON(bit)) prb_acc += __builtin_amdgcn_s_memrealtime() - prb_t0_;

template <int layer> __device__ __forceinline__ void run_layer(const int lo, const int hi, unsigned long long& prb_acc) {
        const int pb = 1 + layer * NPH_LAYER;
        { PRB_T0(1)
        if (IN(pb + 0)) { PHASE_BEGIN bf16* hb_in = (bf16*)(ws + (layer ? WS_HBB : WS_HBA));
            pg8::Gemm g{hb_in, (const bf16*)(ws + WS_WIN) + (size_t)layer * PPITCH * D, NTOK, PPITCH, D, D}; pg8::WinMainOrder S; S.init(NTOK, PPITCH - 512, F.G, (int)blockIdx.x);
            LAS float* rstab = (LAS float*)(F.lds + RSTAB_OFF);
            { const float* part = (const float*)(ws + WS_PART); pg8::Unit uu;
              for (int i = 0; i < 4 && S.next(i, uu); ++i) { if (F.tid < 256) { const f32x4* pp = (const f32x4*)(part + (size_t)(uu.pm * 256 + F.tid) * 32); f32x4 sm = pp[0];
#pragma unroll
                      for (int j = 1; j < 8; ++j) sm = sm + pp[j];
                      rstab[i * 256 + F.tid] = rsqrtf(((sm[0] + sm[1]) + (sm[2] + sm[3])) * (1.0f / 2048.0f) + 1e-6f); } }
              __syncthreads(); }
            pg8::EpiProj E{(bf16*)(ws + WS_PROJ), PPITCH, (const PG8_LAS float*)rstab, (float*)(ws + WS_RSTD1)};
            pg8::gemm_phase<pg8::EpiProj, pg8::WinMainOrder, PG8_ALIGN, PG8_SP2>(F.lds + RING_OFF, g, S, E); }
        if (IN(pb + 0)) { PHASE_BEGIN bf16* hb_in = (bf16*)(ws + (layer ? WS_HBB : WS_HBA));
            pg8::Gemm g{hb_in, (const bf16*)(ws + WS_WIN) + (size_t)layer * PPITCH * D, NTOK, 512, 512, D}; pg8::WinLoraOrder S; S.G = F.G; S.c = F.vcu;
            pg8::EpiPartF32 E{(float*)(ws + WS_LORAO), NTOK};
            pg8::gemm_phase<pg8::EpiPartF32, pg8::WinLoraOrder, PG8_ALIGN, PG8_SP2>(F.lds + RING_OFF, g, S, E); }
        SEAM(pb + 0); PRB_T1(1) }
        { PRB_T0(2)
        if (IN(pb + 1)) { PHASE_BEGIN prep1_phase(F, A, layer); }
        SEAM(pb + 1); PRB_T1(2) }
        { PRB_T0(3)
        if (IN(pb + 2)) { PHASE_BEGIN pg8::Gemm g{(const bf16*)(ws + WS_LORAA), (const bf16*)(ws + WS_WL2) + (size_t)layer * 4096 * LK, NTOK, 4096, 256, LK}; pg8::Lora2Order S; S.init(NTOK, 4096, F.G, (int)blockIdx.x);
            pg8::EpiBf16s E{(bf16*)(ws + WS_LORAO), 4096};
            pg8::gemm_phase<pg8::EpiBf16s, pg8::Lora2Order, PG8_ALIGN, PG8_SP2>(F.lds + RING_OFF, g, S, E); }
        SEAM(pb + 2); PRB_T1(3) }
        { PRB_T0(4)
#ifndef NOSCAN
        if (IN(pb + 3)) { PRB_T0(16) { PHASE_BEGIN tp_level1_fused(F, A, layer); __syncthreads(); } PRB_T1(16) }
#endif
#ifndef NOATTN
        if (IN(pb + 3)) { PRB_T0(17) { PHASE_BEGIN attn_phase_all(F, (char*)lds_dyn + RING_OFF); } PRB_T1(17) }
#endif
        SEAM(pb + 3); PRB_T1(4) }
        { PRB_T0(5)
        if (IN(pb + 4)) { PHASE_BEGIN tp_level2(F, layer); }
        SEAM(pb + 4); PRB_T1(5) }
        { PRB_T0(6)
        if (IN(pb + 5)) { PRB_T0(18) { PHASE_BEGIN tp_level3_post(F, A, layer); __syncthreads(); } PRB_T1(18) } if (IN(pb + 5)) { PRB_T0(19) { PHASE_BEGIN post_attn(F, A, layer); } PRB_T1(19) }
        SEAM(pb + 5); PRB_T1(6) }
        { PRB_T0(7)
        if (IN(pb + 6)) { PHASE_BEGIN bf16* hb_mid = (bf16*)(ws + (layer ? WS_HBA : WS_HBB));
            pg8::Gemm g{(const bf16*)(ws + WS_CONCAT), (const bf16*)(ws + WS_WOUT) + (size_t)layer * D * D, NTOK, D, D, D}; pg8::StaticOrder S; S.init(NTOK, D, F.G, (int)blockIdx.x);
            pg8::EpiResid E{layer ? (const float*)nullptr : A->in[0], (const bf16*)(ws + (layer ? WS_HBB : WS_HBA)), hb_mid};
            pg8::gemm_phase<pg8::EpiResid, pg8::StaticOrder, PG8_ALIGN, PG8_SP2>(F.lds + RING_OFF, g, S, E); }
        SEAM(pb + 6); PRB_T1(7) }
        { PRB_T0(8)
        if (IN(pb + 7)) { PHASE_BEGIN router_phase(F, A, layer, (const bf16*)(ws + (layer ? WS_HBA : WS_HBB))); __syncthreads(); }
        if (IN(pb + 7)) { PHASE_BEGIN
            pg8::Gemm g{(const bf16*)(ws + WS_PB) + (size_t)layer * NTOK * 256, (const bf16*)(ws + WS_WPP) + (size_t)layer * D * 256, NTOK, D, 256, 256}; pg8::StaticOrder S; S.init(NTOK, D, F.G, (int)blockIdx.x);
            pg8::EpiBf16s E{(bf16*)(ws + WS_PPB), D};
            pg8::gemm_phase<pg8::EpiBf16s, pg8::StaticOrder, PG8_ALIGN, PG8_SP2>(F.lds + RING_OFF, g, S, E); }
        SEAM(pb + 7); PRB_T1(8) }
        { PRB_T0(9)
        if (IN(pb + 8)) { PHASE_BEGIN moe_meta(F, layer); LAS int* meta = (LAS int*)(F.lds + META_OFF); const int nt = __builtin_amdgcn_readfirstlane(meta[193]);
            pg8::Gemm g{(const bf16*)(ws + (layer ? WS_HBA : WS_HBB)), (const bf16*)(ws + WS_WGU), nt * 256, 1024, D, D}; pg8::MoeUpOrder S; S.init(nt, 2, F.G, F.vcu); S.tile_e = (const PG8_LAS int*)(meta + 97); S.NE = 1024; S.etok = (const int*)(ws + WS_MOETAB); S.tot = (const PG8_LAS int*)meta; S.tbase = (const PG8_LAS int*)(meta + 32);
            S.cnt = (unsigned*)(ws + WS_JCNT) + layer * 96 * 16; S.lcnt = (PG8_LAS unsigned*)(F.lds + JDONE_OFF);
            pg8::EpiGLU E{(bf16*)(ws + WS_HG), (const float*)(ws + WS_MOETAB + 1 * MiB), (const float*)(ws + WS_MOETAB + 2 * MiB), (const PG8_LAS int*)(meta + 97), (const PG8_LAS int*)(meta + 32)};
            pg8::gemm_phase<pg8::EpiGLU, pg8::MoeUpOrder, PG8_ALIGN, PG8_SP2>(F.lds + RING_OFF, g, S, E); }
#ifdef BISECT_BARRIER
        if (IN(pb + 8)) { ArgP A_ = get_args(); XcdBarrier b_; b_.bar = (unsigned*)(A_->ws + WS_CTL) + CW_BAR; b_.x = xb_xcc_id(); b_.st = (volatile LAS unsigned*)((LAS unsigned char*)lds_dyn + MISC_OFF) + 8; xcd_barrier(b_); }
#endif
        if (IN(pb + 8)) { PHASE_BEGIN LAS int* meta = (LAS int*)(F.lds + META_OFF); const int nt = __builtin_amdgcn_readfirstlane(meta[193]);
            pg8::Gemm g{(const bf16*)(ws + WS_HG), (const bf16*)(ws + WS_WD), nt * 256, D, DEXP, DEXP}; pg8::MoeDownOrder S; S.init2(nt, F.G, F.vcu); S.tile_e = (const PG8_LAS int*)(meta + 97); S.NE = D; S.etok = nullptr; S.tot = (const PG8_LAS int*)meta; S.tbase = (const PG8_LAS int*)(meta + 32);
            S.cnt = (const unsigned*)(ws + WS_JCNT) + layer * 96 * 16;
            pg8::EpiBf16s E{(bf16*)(ws + WS_OSLOT), D};
            pg8::gemm_phase<pg8::EpiBf16s, pg8::MoeDownOrder, PG8_ALIGN, PG8_SP2>(F.lds + RING_OFF, g, S, E); }
        SEAM(pb + 8); PRB_T1(9) }
        { PRB_T0(10)
        if (IN(pb + 9)) { PHASE_BEGIN combine_phase(F, (const bf16*)(ws + (layer ? WS_HBA : WS_HBB)), (bf16*)(ws + (layer ? WS_HBB : WS_HBA)), layer); }
        SEAM(pb + 9); PRB_T1(10) }
        { PRB_T0(11)
        if (IN(pb + 10)) { PHASE_BEGIN bf16* hb_in = (bf16*)(ws + (layer ? WS_HBB : WS_HBA)); bf16* hb_mid = (bf16*)(ws + (layer ? WS_HBA : WS_HBB));
            pg8::Gemm g{hb_in, (const bf16*)(ws + WS_WPG) + (size_t)layer * D * D, NTOK, D, D, D}; pg8::StaticOrder S; S.init(NTOK, D, F.G, (int)blockIdx.x);
            pg8::EpiPLE E{hb_in, hb_mid, layer ? A->out : (float*)nullptr, (const bf16*)(ws + WS_PPB), A->in[36] + layer * D, layer ? (float*)nullptr : (float*)(ws + WS_PART)};
            pg8::gemm_phase<pg8::EpiPLE, pg8::StaticOrder, PG8_ALIGN, PG8_SP2>(F.lds + RING_OFF, g, S, E); }
        SEAM(pb + 10); PRB_T1(11) }
    }

__global__ void __launch_bounds__(NWAVES * 64, 2) mk_fwd(Args args_unused) {
    { LAS unsigned char* l = (LAS unsigned char*)lds_dyn; const int t0 = threadIdx.x;
      for (int u = t0; u < (LDS_BYTES - LDSCTL_OFF) / 4; u += NWAVES * 64) ((LAS unsigned*)(l + LDSCTL_OFF))[u] = 0u; }
    __syncthreads();
    int lo, hi; { ArgP A = get_args(); lo = A->ph_lo; hi = A->ph_hi; }
    if (hi - lo > 1) { ArgP A = get_args(); (void)xcd_barrier_post((unsigned*)(A->ws + WS_CTL) + CW_BAR, (volatile LAS unsigned*)((LAS unsigned char*)lds_dyn + MISC_OFF) + 8); }
    unsigned long long prb_acc = 0ull;
    { PRB_T0(0) if (IN(0)) { PHASE_BEGIN p0_prologue(F, A); }
    SEAM(0); PRB_T1(0) }
    run_layer<0>(lo, hi, prb_acc);
    run_layer<1>(lo, hi, prb_acc);
    if (PROBE_SET) { const unsigned long long te = __builtin_amdgcn_s_memrealtime(); while (__builtin_amdgcn_s_memrealtime() - te < (unsigned long long)PROBE_MULT * prb_acc) __builtin_amdgcn_s_sleep(8); }
#undef IN
#undef SEAM
}

#ifndef MK_PER_PHASE
#define MK_PER_PHASE 0
#endif
extern "C" void kernel_launch(void* const* d_in, const int* in_sizes, int n_in, void* d_out, int out_size, void* d_ws, size_t ws_size, hipStream_t stream) {
    static int grid = 0;
    if (grid == 0) {
        if (n_in != 38 || out_size != NTOK * D || ws_size < WS_END) { fprintf(stderr, "kernel_launch: unexpected shapes (n_in %d out %d ws %zu need %zu)\n", n_in, out_size, ws_size, (size_t)WS_END); grid = -1; return; }
        int dev = 0, cus = 0, per_cu = 0;
        if (hipGetDevice(&dev) != hipSuccess || hipDeviceGetAttribute(&cus, hipDeviceAttributeMultiprocessorCount, dev) != hipSuccess) { grid = -1; return; }
        if (hipFuncSetAttribute((const void*)mk_fwd, hipFuncAttributeMaxDynamicSharedMemorySize, LDS_BYTES) != hipSuccess) { grid = -1; return; }
        if (hipOccupancyMaxActiveBlocksPerMultiprocessor(&per_cu, (const void*)mk_fwd, NWAVES * 64, LDS_BYTES) != hipSuccess || per_cu < 1) fprintf(stderr, "kernel_launch: occupancy query says %d\n", per_cu);
        (void)hipGetLastError();
        grid = cus;
    }
    if (grid < 0) return;
    if (hipMemsetAsync((char*)d_ws + WS_CTL, 0, CTL_ZERO_BYTES, stream) != hipSuccess) return;
    Args a{};
    for (int i = 0; i < 38; ++i) a.in[i] = (const float*)d_in[i];
    a.out = (float*)d_out; a.ws = (unsigned char*)d_ws;
#if MK_PER_PHASE
    for (int ph = 0; ph < NPHASES; ++ph) { a.ph_lo = ph; a.ph_hi = ph + 1; hipLaunchKernelGGL(mk_fwd, dim3(grid), dim3(NWAVES * 64), LDS_BYTES, stream, a); }
#else
    a.ph_lo = 0; a.ph_hi = NPHASES;
    hipLaunchKernelGGL(mk_fwd, dim3(grid), dim3(NWAVES * 64), LDS_BYTES, stream, a);
#endif
}
```
